# Optimizing an MI355X kernel written in HIP

```python
import jax, jax.numpy as jnp
from jax import lax
import numpy as np


D_MODEL = 1024
BATCH = 4
SEQ = 8192
DEPTH = 1

MLA_HEADS = 8
MLA_NOPE = 64
MLA_ROPE = 32
MLA_QK = MLA_NOPE + MLA_ROPE
MLA_V = 64
MLA_W = MLA_HEADS * MLA_V
MLA_Q_RANK = 256
MLA_KV_RANK = 128
ROPE_THETA = 10000.0
Q_BLOCK = 128

RWKV_HEADS = 8
RWKV_N = 64
RWKV_W = RWKV_HEADS * RWKV_N
DECAY_LORA = 64
AAA_LORA = 64
GATE_LORA = 128

MIX_W = MLA_W + RWKV_W
MLA_IN = MLA_Q_RANK + MLA_KV_RANK + MLA_ROPE
RWKV_IN = 3 * RWKV_W + DECAY_LORA + AAA_LORA + GATE_LORA
IN_W = MLA_IN + RWKV_IN

N_GROUPS = 4
EXPERTS_PER_GROUP = 8
N_EXPERTS = N_GROUPS * EXPERTS_PER_GROUP
TOP_K = 2
D_EXPERT = 256

NORM_EPS = 1e-6
LNX_EPS = 64e-5

kernel_name = 'hymba_mla_rwkv7_hier_moe_block'


def rms_norm(x, g, eps=NORM_EPS):
    xf = x.astype(jnp.float32)
    y = xf * lax.rsqrt(jnp.mean(xf * xf, axis=-1, keepdims=True) + eps)
    return (y * g.astype(jnp.float32)).astype(x.dtype)


def rope_tables(positions):
    half = MLA_ROPE // 2
    inv_freq = 1.0 / (ROPE_THETA ** (jnp.arange(half, dtype=jnp.float32) / half))
    ang = positions.astype(jnp.float32)[..., None] * inv_freq
    return jnp.cos(ang)[:, :, None, :], jnp.sin(ang)[:, :, None, :]


def apply_rope(x, cos, sin):
    half = MLA_ROPE // 2
    xf = x.astype(jnp.float32)
    x1, x2 = xf[..., :half], xf[..., half:]
    return jnp.concatenate([x1 * cos - x2 * sin, x2 * cos + x1 * sin], axis=-1).astype(x.dtype)


def mla_group(c_q, c_kv, k_rope, positions, g_cq, w_uq, g_ckv, w_uk, w_uv, g_qn, g_kn):
    bsz, s, _ = c_q.shape
    q = jnp.einsum('bsr,rhd->bshd', rms_norm(c_q, g_cq), w_uq)
    ckv = rms_norm(c_kv, g_ckv)
    k_nope = jnp.einsum('bsr,rhd->bshd', ckv, w_uk)
    v = jnp.einsum('bsr,rhd->bshd', ckv, w_uv)
    k_rope_h = jnp.broadcast_to(k_rope[:, :, None, :], (bsz, s, MLA_HEADS, MLA_ROPE))
    k = jnp.concatenate([k_nope, k_rope_h], axis=-1)
    q = rms_norm(q, g_qn)
    k = rms_norm(k, g_kn)
    cos, sin = rope_tables(positions)
    q = jnp.concatenate([q[..., :MLA_NOPE], apply_rope(q[..., MLA_NOPE:], cos, sin)], axis=-1)
    k = jnp.concatenate([k[..., :MLA_NOPE], apply_rope(k[..., MLA_NOPE:], cos, sin)], axis=-1)
    scale = MLA_QK ** -0.5
    outs = []
    for blk in range(s // Q_BLOCK):
        q0 = blk * Q_BLOCK
        kend = q0 + Q_BLOCK
        scores = jnp.einsum('bqhd,bkhd->bhqk', q[:, q0:kend], k[:, :kend]).astype(jnp.float32) * scale
        causal = (q0 + jnp.arange(Q_BLOCK))[:, None] >= jnp.arange(kend)[None, :]
        scores = jnp.where(causal, scores, -jnp.inf)
        probs = jax.nn.softmax(scores, axis=-1).astype(v.dtype)
        outs.append(jnp.einsum('bhqk,bkhd->bqhd', probs, v[:, :kend]))
    return jnp.concatenate(outs, axis=1).reshape(bsz, s, MLA_W)


def rwkv7_group(feat, mu, w0, w2, a0, a2, g2, k_k, k_a, r_k, lnx_g, lnx_b):
    bsz, s, _ = feat.shape
    prev = jnp.pad(feat, ((0, 0), (1, 0), (0, 0)))[:, :-1]
    feat = feat + (prev - feat) * mu
    splits = np.cumsum([RWKV_W, RWKV_W, RWKV_W, DECAY_LORA, AAA_LORA]).tolist()
    r, k, v, wl, al, gl = jnp.split(feat, splits, axis=-1)
    w = -jax.nn.softplus(-(w0 + jnp.tanh(wl) @ w2)) - 0.5
    a = jax.nn.sigmoid(a0 + al @ a2)
    g = jax.nn.sigmoid(gl) @ g2
    heads = lambda t: t.reshape(bsz, s, RWKV_HEADS, RWKV_N).astype(jnp.float32)
    kk = heads(k * k_k)
    kk = kk * lax.rsqrt(jnp.sum(kk * kk, axis=-1, keepdims=True) + 1e-12)
    k = k * (1.0 + (a - 1.0) * k_a)
    rh, kh, vh, ah = heads(r), heads(k), heads(v), heads(a)
    decay = jnp.exp(-jnp.exp(heads(w)))

    def step(state, inp):
        r_t, k_t, v_t, kk_t, b_t, d_t = inp
        sa = jnp.einsum('bhvk,bhk->bhv', state, -kk_t)
        state = (state * d_t[:, :, None, :] + sa[..., None] * b_t[:, :, None, :]
                 + v_t[..., None] * k_t[:, :, None, :])
        return state, jnp.einsum('bhvk,bhk->bhv', state, r_t)

    tm = lambda t: jnp.swapaxes(t, 0, 1)
    state0 = jnp.zeros((bsz, RWKV_HEADS, RWKV_N, RWKV_N), jnp.float32)
    _, y = lax.scan(step, state0, (tm(rh), tm(kh), tm(vh), tm(kk), tm(kk * ah), tm(decay)))
    y = tm(y)
    mean = jnp.mean(y, axis=-1, keepdims=True)
    var = jnp.mean(jnp.square(y - mean), axis=-1, keepdims=True)
    y = ((y - mean) * lax.rsqrt(var + LNX_EPS)).reshape(bsz, s, RWKV_W)
    y = y * lnx_g.astype(jnp.float32) + lnx_b.astype(jnp.float32)
    bonus = jnp.sum(rh * kh * r_k.astype(jnp.float32), axis=-1, keepdims=True) * vh
    y = y + bonus.reshape(bsz, s, RWKV_W)
    return (y * g.astype(jnp.float32)).astype(feat.dtype)


def hier_moe(h, w_group, b_group, w_expert, b_expert, w_gate, w_up, w_down):
    bsz, s, d = h.shape
    t = h.reshape(bsz * s, d)
    n = t.shape[0]
    rows = jnp.arange(n)
    group_logits = (t @ w_group).astype(jnp.float32) + b_group.astype(jnp.float32)
    group_probs = jax.nn.softmax(group_logits, axis=-1)
    _, gsel = lax.top_k(group_logits, 1)
    gsel = gsel[:, 0]
    expert_logits = ((t @ w_expert).astype(jnp.float32) + b_expert.astype(jnp.float32)).reshape(
        n, N_GROUPS, EXPERTS_PER_GROUP)
    in_group = expert_logits[rows, gsel]
    top_vals, top_idx = lax.top_k(in_group, TOP_K)
    weights = jax.nn.softmax(top_vals, axis=-1) * group_probs[rows, gsel][:, None]
    expert_ids = gsel[:, None] * EXPERTS_PER_GROUP + top_idx
    combine = jnp.sum(jax.nn.one_hot(expert_ids, N_EXPERTS, dtype=jnp.float32) * weights[..., None],
                      axis=1).astype(t.dtype)
    y = jnp.zeros_like(t)
    for e in range(N_EXPERTS):
        hidden = jax.nn.silu(t @ w_gate[e]) * (t @ w_up[e])
        y = y + combine[:, e:e + 1] * (hidden @ w_down[e])
    return y.reshape(bsz, s, d)


def hybrid_layer(x, positions, g_mix, w_in, g_cq, w_uq, g_ckv, w_uk, w_uv, g_qn, g_kn, g_mla_out,
                 rw_mu, rw_w0, rw_w2, rw_a0, rw_a2, rw_g2, rw_k_k, rw_k_a, rw_r_k, rw_lnx_g, rw_lnx_b,
                 w_o, g_ffn, w_group, b_group, w_expert, b_expert, w_gate, w_up, w_down):
    h = rms_norm(x, g_mix)
    proj = h @ w_in
    c_q = proj[..., :MLA_Q_RANK]
    c_kv = proj[..., MLA_Q_RANK:MLA_Q_RANK + MLA_KV_RANK]
    k_rope = proj[..., MLA_Q_RANK + MLA_KV_RANK:MLA_IN]
    feat = proj[..., MLA_IN:]
    mla_out = rms_norm(mla_group(c_q, c_kv, k_rope, positions, g_cq, w_uq, g_ckv, w_uk, w_uv, g_qn, g_kn),
                       g_mla_out)
    rw_out = rwkv7_group(feat, rw_mu, rw_w0, rw_w2, rw_a0, rw_a2, rw_g2, rw_k_k, rw_k_a, rw_r_k,
                         rw_lnx_g, rw_lnx_b)
    x = x + jnp.concatenate([mla_out, rw_out], axis=-1) @ w_o
    x = x + hier_moe(rms_norm(x, g_ffn), w_group, b_group, w_expert, b_expert, w_gate, w_up, w_down)
    return x


def setup_inputs(seed: int = 0) -> dict:
    key = jax.random.key(seed)
    ks = iter(jax.random.split(key, 40))
    L = DEPTH

    def nrm(shape, scale):
        return jax.random.normal(next(ks), shape, jnp.float32) * scale

    def gain(shape):
        return 1.0 + nrm(shape, 0.02)

    x = nrm((BATCH, SEQ, D_MODEL), 1.0)
    positions = (jnp.arange(SEQ, dtype=jnp.int32)[None, :]
                 + jax.random.randint(next(ks), (BATCH, 1), 0, 1024, jnp.int32))
    return {
        'x': x,
        'positions': positions,
        'g_mix': gain((L, D_MODEL)),
        'w_in': nrm((L, D_MODEL, IN_W), D_MODEL ** -0.5),
        'g_cq': gain((L, MLA_Q_RANK)),
        'w_uq': nrm((L, MLA_Q_RANK, MLA_HEADS, MLA_QK), MLA_Q_RANK ** -0.5),
        'g_ckv': gain((L, MLA_KV_RANK)),
        'w_uk': nrm((L, MLA_KV_RANK, MLA_HEADS, MLA_NOPE), MLA_KV_RANK ** -0.5),
        'w_uv': nrm((L, MLA_KV_RANK, MLA_HEADS, MLA_V), MLA_KV_RANK ** -0.5),
        'g_qn': gain((L, MLA_QK)),
        'g_kn': gain((L, MLA_QK)),
        'g_mla_out': gain((L, MLA_W)),
        'rw_mu': jax.random.uniform(next(ks), (L, RWKV_IN), jnp.float32, 0.0, 1.0),
        'rw_w0': jax.random.uniform(next(ks), (L, RWKV_W), jnp.float32, -4.0, 2.0),
        'rw_w2': nrm((L, DECAY_LORA, RWKV_W), 0.5 * DECAY_LORA ** -0.5),
        'rw_a0': nrm((L, RWKV_W), 0.1),
        'rw_a2': nrm((L, AAA_LORA, RWKV_W), 0.5 * AAA_LORA ** -0.5),
        'rw_g2': nrm((L, GATE_LORA, RWKV_W), GATE_LORA ** -0.5),
        'rw_k_k': 0.85 + nrm((L, RWKV_W), 0.02),
        'rw_k_a': 1.0 + nrm((L, RWKV_W), 0.02),
        'rw_r_k': nrm((L, RWKV_HEADS, RWKV_N), 0.1),
        'rw_lnx_g': gain((L, RWKV_W)),
        'rw_lnx_b': nrm((L, RWKV_W), 0.01),
        'w_o': nrm((L, MIX_W, D_MODEL), MIX_W ** -0.5),
        'g_ffn': gain((L, D_MODEL)),
        'w_group': nrm((L, D_MODEL, N_GROUPS), D_MODEL ** -0.5),
        'b_group': nrm((L, N_GROUPS), 0.01),
        'w_expert': nrm((L, D_MODEL, N_EXPERTS), D_MODEL ** -0.5),
        'b_expert': nrm((L, N_EXPERTS), 0.01),
        'w_gate': nrm((L, N_EXPERTS, D_MODEL, D_EXPERT), D_MODEL ** -0.5),
        'w_up': nrm((L, N_EXPERTS, D_MODEL, D_EXPERT), D_MODEL ** -0.5),
        'w_down': nrm((L, N_EXPERTS, D_EXPERT, D_MODEL), D_EXPERT ** -0.5),
    }


def reference(x, positions, g_mix, w_in, g_cq, w_uq, g_ckv, w_uk, w_uv, g_qn, g_kn, g_mla_out,
              rw_mu, rw_w0, rw_w2, rw_a0, rw_a2, rw_g2, rw_k_k, rw_k_a, rw_r_k, rw_lnx_g, rw_lnx_b,
              w_o, g_ffn, w_group, b_group, w_expert, b_expert, w_gate, w_up, w_down):
    for l in range(DEPTH):
        x = hybrid_layer(x, positions, g_mix[l], w_in[l], g_cq[l], w_uq[l], g_ckv[l], w_uk[l], w_uv[l],
                         g_qn[l], g_kn[l], g_mla_out[l], rw_mu[l], rw_w0[l], rw_w2[l], rw_a0[l],
                         rw_a2[l], rw_g2[l], rw_k_k[l], rw_k_a[l], rw_r_k[l], rw_lnx_g[l], rw_lnx_b[l],
                         w_o[l], g_ffn[l], w_group[l], b_group[l], w_expert[l], b_expert[l],
                         w_gate[l], w_up[l], w_down[l])
    return x
```

```cpp
#include <hip/hip_runtime.h>
#include <stdint.h>
#include <math.h>

typedef unsigned short bf16_t;
constexpr int NB = 4, S = 8192, D = 1024, T = NB * S;
constexpr int H = 8, NOPE = 64, ROPE = 32, QK = 96, VD = 64, MLAW = 512, QR = 256, KVR = 128;
constexpr int RH = 8, RN = 64, RW = 512;
constexpr int MLA_IN = 416, RWKV_IN = 1792, INW = 2208;
constexpr int NG = 4, EPG = 8, NE = 32, DE = 256;

__device__ __forceinline__ float bf2f(bf16_t v) { return __uint_as_float(((unsigned)v) << 16); }
__device__ __forceinline__ bf16_t f2bf(float f) { unsigned u = __float_as_uint(f); return (bf16_t)((u + 0x7fffu + ((u >> 16) & 1u)) >> 16); }
__device__ __forceinline__ float ldf(const float* p) { return *p; }
__device__ __forceinline__ float ldf(const bf16_t* p) { return bf2f(*p); }
__device__ __forceinline__ void stf(float* p, float v) { *p = v; }
__device__ __forceinline__ void stf(bf16_t* p, float v) { *p = f2bf(v); }

template <class TI> __global__ void __launch_bounds__(256) rowstat_k(const TI* in, int ld, int col0, int n, float eps, float* rstd) {
    int row = blockIdx.x * 4 + threadIdx.x / 64, lane = threadIdx.x % 64;
    const TI* p = in + (size_t)row * ld + col0;
    float s = 0.f;
    for (int c = lane; c < n; c += 64) { float v = ldf(p + c); s += v * v; }
    for (int o = 32; o > 0; o >>= 1) s += __shfl_xor(s, o);
    if (lane == 0) rstd[row] = rsqrtf(s / n + eps);
}

template <class TA, class TC> __global__ void __launch_bounds__(256) gemm_k(const TA* A, int lda, const float* rowscale, const float* kgain, const float* Bm, int ldb,
                                                                          TC* C, int ldc, int M, int N, int K, const float* R, int ldr) {
    __shared__ float As[16][68];
    __shared__ float Bs[16][68];
    const int tid = threadIdx.x, tx = tid % 16, ty = tid / 16;
    const int m0 = blockIdx.y * 64, n0 = blockIdx.x * 64;
    float acc[4][4];
    _Pragma("unroll") for (int i = 0; i < 4; ++i) _Pragma("unroll") for (int j = 0; j < 4; ++j) acc[i][j] = 0.f;
    const int ar = tid / 4, ac = (tid % 4) * 4;
    const int br = tid / 16, bc = (tid % 16) * 4;
    const float rs = rowscale ? rowscale[m0 + ar] : 1.f;
    for (int k0 = 0; k0 < K; k0 += 16) {
        _Pragma("unroll") for (int i = 0; i < 4; ++i) { float v = ldf(A + (size_t)(m0 + ar) * lda + k0 + ac + i) * rs; if (kgain) v *= kgain[k0 + ac + i]; As[ac + i][ar] = v; }
        _Pragma("unroll") for (int i = 0; i < 4; ++i) { int n = n0 + bc + i; Bs[br][bc + i] = (n < N) ? Bm[(size_t)(k0 + br) * ldb + n] : 0.f; }
        __syncthreads();
        _Pragma("unroll") for (int k = 0; k < 16; ++k) {
            float a[4], b[4];
            _Pragma("unroll") for (int i = 0; i < 4; ++i) a[i] = As[k][ty * 4 + i];
            _Pragma("unroll") for (int j = 0; j < 4; ++j) b[j] = Bs[k][tx * 4 + j];
            _Pragma("unroll") for (int i = 0; i < 4; ++i) _Pragma("unroll") for (int j = 0; j < 4; ++j) acc[i][j] += a[i] * b[j];
        }
        __syncthreads();
    }
    _Pragma("unroll") for (int i = 0; i < 4; ++i) _Pragma("unroll") for (int j = 0; j < 4; ++j) {
        int m = m0 + ty * 4 + i, n = n0 + tx * 4 + j;
        if (n < N) { float v = acc[i][j]; if (R) v += R[(size_t)m * ldr + n]; stf(C + (size_t)m * ldc + n, v); }
    }
}

__global__ void __launch_bounds__(256) qk_prep_k(bf16_t* Q, const bf16_t* KNOPE, const bf16_t* PROJ, const int* pos, const float* g_qn, const float* g_kn, bf16_t* K) {
    int idx = blockIdx.x * blockDim.x + threadIdx.x; if (idx >= T * H) return;
    int t = idx / H, h = idx % H;
    float p = (float)pos[t];
    float q[QK], k[QK];
    float sq = 0.f, sk = 0.f;
    _Pragma("unroll") for (int d = 0; d < QK; ++d) { q[d] = bf2f(Q[(size_t)t * 768 + h * QK + d]); sq += q[d] * q[d]; }
    _Pragma("unroll") for (int d = 0; d < NOPE; ++d) k[d] = bf2f(KNOPE[(size_t)t * 512 + h * NOPE + d]);
    _Pragma("unroll") for (int d = 0; d < ROPE; ++d) k[NOPE + d] = bf2f(PROJ[(size_t)t * INW + 384 + d]);
    _Pragma("unroll") for (int d = 0; d < QK; ++d) sk += k[d] * k[d];
    float rq = rsqrtf(sq / QK + 1e-6f), rk = rsqrtf(sk / QK + 1e-6f);
    _Pragma("unroll") for (int d = 0; d < QK; ++d) { q[d] = q[d] * rq * g_qn[d]; k[d] = k[d] * rk * g_kn[d]; }
    _Pragma("unroll") for (int i = 0; i < 16; ++i) {
        float inv_freq = 1.0f / powf(10000.0f, (float)i / 16.0f);
        float ang = p * inv_freq, c = cosf(ang), s = sinf(ang);
        float x1 = q[64 + i], x2 = q[80 + i]; q[64 + i] = x1 * c - x2 * s; q[80 + i] = x2 * c + x1 * s;
        x1 = k[64 + i]; x2 = k[80 + i]; k[64 + i] = x1 * c - x2 * s; k[80 + i] = x2 * c + x1 * s;
    }
    _Pragma("unroll") for (int d = 0; d < QK; ++d) { Q[(size_t)t * 768 + h * QK + d] = f2bf(q[d]); K[(size_t)t * 768 + h * QK + d] = f2bf(k[d]); }
}

__global__ void __launch_bounds__(64) attn_k(const bf16_t* Q, const bf16_t* K, const bf16_t* V, bf16_t* O  , int ldo) {
    __shared__ float Ks[32][QK];
    __shared__ float Vs[32][VD];
    const int qt = blockIdx.x, bh = blockIdx.y, b = bh / H, h = bh % H, lane = threadIdx.x;
    const int qi = qt * 64 + lane; const size_t trow = (size_t)b * S + qi;
    float q[QK], o[VD];
    const float scale = 0.10206207261596577f;
    _Pragma("unroll") for (int d = 0; d < QK; ++d) q[d] = bf2f(Q[trow * 768 + h * QK + d]) * scale;
    _Pragma("unroll") for (int d = 0; d < VD; ++d) o[d] = 0.f;
    float m = -INFINITY, l = 0.f;
    const int nkt = (qt * 64 + 64) / 32;
    for (int kt = 0; kt < nkt; ++kt) {
        __syncthreads();
        for (int i = lane; i < 32 * QK; i += 64) { int r = i / QK, c = i % QK; Ks[r][c] = bf2f(K[((size_t)b * S + kt * 32 + r) * 768 + h * QK + c]); }
        for (int i = lane; i < 32 * VD; i += 64) { int r = i / VD, c = i % VD; Vs[r][c] = bf2f(V[((size_t)b * S + kt * 32 + r) * 512 + h * VD + c]); }
        __syncthreads();
        float sc[32]; float tm = -INFINITY;
        _Pragma("unroll") for (int j = 0; j < 32; ++j) {
            float s = 0.f;
            _Pragma("unroll") for (int d = 0; d < QK; ++d) s += q[d] * Ks[j][d];
            if (kt * 32 + j > qi) s = -INFINITY;
            sc[j] = s; tm = fmaxf(tm, s);
        }
        float mn = fmaxf(m, tm);
        float alpha = expf(m - mn);
        l *= alpha;
        _Pragma("unroll") for (int d = 0; d < VD; ++d) o[d] *= alpha;
        _Pragma("unroll") for (int j = 0; j < 32; ++j) {
            float p = expf(sc[j] - mn); l += p;
            _Pragma("unroll") for (int d = 0; d < VD; ++d) o[d] += p * Vs[j][d];
        }
        m = mn;
    }
    float inv = 1.f / l;
    _Pragma("unroll") for (int d = 0; d < VD; ++d) O[trow * ldo + h * VD + d] = f2bf(o[d] * inv);
}

__global__ void __launch_bounds__(256) mla_norm_k(bf16_t* MIX, const float* g) {
    int row = blockIdx.x * 4 + threadIdx.x / 64, lane = threadIdx.x % 64;
    bf16_t* p = MIX + (size_t)row * 1024;
    float v[8]; float s = 0.f;
    _Pragma("unroll") for (int i = 0; i < 8; ++i) { v[i] = bf2f(p[lane + 64 * i]); s += v[i] * v[i]; }
    for (int o = 32; o > 0; o >>= 1) s += __shfl_xor(s, o);
    float r = rsqrtf(s / 512.f + 1e-6f);
    _Pragma("unroll") for (int i = 0; i < 8; ++i) p[lane + 64 * i] = f2bf(v[i] * r * g[lane + 64 * i]);
}

__global__ void __launch_bounds__(256) rw_prep1_k(const bf16_t* PROJ, const float* mu, bf16_t* R, bf16_t* K1, bf16_t* V1, float* LIN) {
    size_t idx = (size_t)blockIdx.x * blockDim.x + threadIdx.x; if (idx >= (size_t)T * RWKV_IN) return;
    int t = (int)(idx / RWKV_IN), c = (int)(idx % RWKV_IN); int s = t % S;
    float f = bf2f(PROJ[(size_t)t * INW + MLA_IN + c]);
    float p = (s > 0) ? bf2f(PROJ[(size_t)(t - 1) * INW + MLA_IN + c]) : 0.f;
    float v = f + (p - f) * mu[c];
    if (c < 512) R[(size_t)t * 512 + c] = f2bf(v);
    else if (c < 1024) K1[(size_t)t * 512 + c - 512] = f2bf(v);
    else if (c < 1536) V1[(size_t)t * 512 + c - 1024] = f2bf(v);
    else if (c < 1600) LIN[(size_t)t * 256 + c - 1536] = tanhf(v);
    else if (c < 1664) LIN[(size_t)t * 256 + c - 1536] = v;
    else LIN[(size_t)t * 256 + c - 1536] = 1.f / (1.f + expf(-v));
}

__global__ void __launch_bounds__(256) rw_prep2_k(bf16_t* K1, const float* WPRE, const float* APRE, const float* w0, const float* a0, const float* k_k, const float* k_a,
                           float* KK, float* BB, float* DEC) {
    int idx = blockIdx.x * blockDim.x + threadIdx.x; if (idx >= T * RH) return;
    int t = idx / RH, h = idx % RH; size_t base = (size_t)t * 512 + h * 64;
    float ss = 0.f;
    _Pragma("unroll") for (int j = 0; j < 64; ++j) { float kv = bf2f(K1[base + j]) * k_k[h * 64 + j]; ss += kv * kv; }
    float inv = rsqrtf(ss + 1e-12f);
    _Pragma("unroll") for (int j = 0; j < 64; ++j) {
        int c = h * 64 + j;
        float kv = bf2f(K1[base + j]);
        float a = 1.f / (1.f + expf(-(a0[c] + APRE[base + j])));
        float z = w0[c] + WPRE[base + j];
        float w = -log1pf(expf(-z)) - 0.5f;
        float dec = expf(-expf(w));
        float kk = kv * k_k[c] * inv;
        KK[base + j] = kk; BB[base + j] = kk * a; DEC[base + j] = dec;
        K1[base + j] = f2bf(kv * (1.f + (a - 1.f) * k_a[c]));
    }
}

__global__ void __launch_bounds__(64) rw_scan_k(const bf16_t* R, const bf16_t* K1, const bf16_t* V1, const float* KK, const float* BB, const float* DEC, float* Y) {
    __shared__ float sh[2][5][64];
    const int bh = blockIdx.x, b = bh / RH, h = bh % RH, lane = threadIdx.x;
    float st[64];
    _Pragma("unroll") for (int j = 0; j < 64; ++j) st[j] = 0.f;
    size_t base = ((size_t)b * S) * 512 + h * 64 + lane;
    float nr = bf2f(R[base]), nk = bf2f(K1[base]), nkk = KK[base], nb = BB[base], nd = DEC[base], nv = bf2f(V1[base]);
    for (int s = 0; s < S; ++s) {
        const int buf = s & 1;
        sh[buf][0][lane] = nr; sh[buf][1][lane] = nk; sh[buf][2][lane] = nkk; sh[buf][3][lane] = nb; sh[buf][4][lane] = nd;
        const float vv = nv;
        if (s + 1 < S) { size_t nb_ = base + (size_t)(s + 1) * 512; nr = bf2f(R[nb_]); nk = bf2f(K1[nb_]); nkk = KK[nb_]; nb = BB[nb_]; nd = DEC[nb_]; nv = bf2f(V1[nb_]); }
        __syncthreads();
        float sa = 0.f;
        _Pragma("unroll") for (int j = 0; j < 64; ++j) sa += st[j] * sh[buf][2][j];
        sa = -sa;
        float y = 0.f;
        _Pragma("unroll") for (int j = 0; j < 64; ++j) { st[j] = st[j] * sh[buf][4][j] + sa * sh[buf][3][j] + vv * sh[buf][1][j]; y += st[j] * sh[buf][0][j]; }
        Y[((size_t)b * S + s) * 512 + h * 64 + lane] = y;
    }
}

__global__ void __launch_bounds__(256) rw_post_k(const float* Y, const bf16_t* R, const bf16_t* K1, const bf16_t* V1, const float* G, const float* r_k, const float* lnx_g, const float* lnx_b, bf16_t* MIX) {
    int idx = blockIdx.x * blockDim.x + threadIdx.x; if (idx >= T * RH) return;
    int t = idx / RH, h = idx % RH; size_t base = (size_t)t * 512 + h * 64;
    float mean = 0.f; _Pragma("unroll") for (int j = 0; j < 64; ++j) mean += Y[base + j]; mean /= 64.f;
    float var = 0.f; _Pragma("unroll") for (int j = 0; j < 64; ++j) { float d = Y[base + j] - mean; var += d * d; } var /= 64.f;
    float rs = rsqrtf(var + 64e-5f);
    float bonus = 0.f; _Pragma("unroll") for (int j = 0; j < 64; ++j) bonus += bf2f(R[base + j]) * bf2f(K1[base + j]) * r_k[h * 64 + j];
    _Pragma("unroll") for (int j = 0; j < 64; ++j) {
        int c = h * 64 + j;
        float y = (Y[base + j] - mean) * rs * lnx_g[c] + lnx_b[c] + bonus * bf2f(V1[base + j]);
        MIX[(size_t)t * 1024 + 512 + c] = f2bf(y * G[base + j]);
    }
}

__global__ void __launch_bounds__(256) route_k(const float* X1, const float* g_ffn, const float* w_group, const float* b_group, const float* w_expert, const float* b_expert, int* EID, float* EW, float* RSF) {
    int t = blockIdx.x * 4 + threadIdx.x / 64, lane = threadIdx.x % 64;
    const float* x = X1 + (size_t)t * D;
    float ss = 0.f, acc[36];
    _Pragma("unroll") for (int i = 0; i < 36; ++i) acc[i] = 0.f;
    for (int k = lane; k < D; k += 64) {
        float v = x[k]; ss += v * v; float tv = v * g_ffn[k];
        _Pragma("unroll") for (int g = 0; g < 4; ++g) acc[g] += tv * w_group[k * 4 + g];
        _Pragma("unroll") for (int e = 0; e < 32; ++e) acc[4 + e] += tv * w_expert[k * 32 + e];
    }
    for (int o = 32; o > 0; o >>= 1) { ss += __shfl_xor(ss, o); _Pragma("unroll") for (int i = 0; i < 36; ++i) acc[i] += __shfl_xor(acc[i], o); }
    if (lane == 0) {
        float rs = rsqrtf(ss / D + 1e-6f);
        float gl[4]; int gs = 0; float gm = -INFINITY;
        _Pragma("unroll") for (int g = 0; g < 4; ++g) { gl[g] = acc[g] * rs + b_group[g]; if (gl[g] > gm) { gm = gl[g]; gs = g; } }
        float den = 0.f; _Pragma("unroll") for (int g = 0; g < 4; ++g) den += expf(gl[g] - gm);
        float gp = 1.f / den;
        float el[8];
        _Pragma("unroll") for (int e = 0; e < 8; ++e) { float v = acc[4 + e]; _Pragma("unroll") for (int g = 1; g < 4; ++g) v = (gs == g) ? acc[4 + g * 8 + e] : v; el[e] = v; }
        float bsel = 0.f; _Pragma("unroll") for (int e = 0; e < 8; ++e) el[e] = el[e] * rs;
        (void)bsel;
        _Pragma("unroll") for (int e = 0; e < 8; ++e) el[e] += b_expert[gs * 8 + e];
        int i1 = 0; float v1 = el[0];
        _Pragma("unroll") for (int e = 1; e < 8; ++e) if (el[e] > v1) { v1 = el[e]; i1 = e; }
        int i2 = -1; float v2 = -INFINITY;
        _Pragma("unroll") for (int e = 0; e < 8; ++e) if (e != i1 && el[e] > v2) { v2 = el[e]; i2 = e; }
        float e2 = expf(v2 - v1); float w1 = 1.f / (1.f + e2), w2 = e2 / (1.f + e2);
        EID[t * 2] = gs * 8 + i1; EID[t * 2 + 1] = gs * 8 + i2; EW[t * 2] = w1 * gp; EW[t * 2 + 1] = w2 * gp; RSF[t] = rs;
    }
}

__global__ void __launch_bounds__(256) moe_k(float* OUT  , const float* g_ffn, const float* RSF, const int* EID, const float* EW,
                                             const float* w_gate, const float* w_up, const float* w_down) {
    __shared__ float tn[D];
    __shared__ float hid[DE];
    const int t = blockIdx.x, j = threadIdx.x;
    float* x = OUT + (size_t)t * D;
    const float rs = RSF[t];
    float xv[4];
    _Pragma("unroll") for (int i = 0; i < 4; ++i) { xv[i] = x[j + 256 * i]; tn[j + 256 * i] = xv[i] * rs * g_ffn[j + 256 * i]; }
    float y[4] = {0.f, 0.f, 0.f, 0.f};
    for (int sl = 0; sl < 2; ++sl) {
        const int e = EID[t * 2 + sl]; const float w = EW[t * 2 + sl];
        __syncthreads();
        const float* wg = w_gate + (size_t)e * D * DE; const float* wu = w_up + (size_t)e * D * DE;
        float hg = 0.f, hu = 0.f;
        for (int k = 0; k < D; ++k) { float tv = tn[k]; hg += tv * wg[(size_t)k * DE + j]; hu += tv * wu[(size_t)k * DE + j]; }
        hid[j] = hg / (1.f + expf(-hg)) * hu;
        __syncthreads();
        const float* wd = w_down + (size_t)e * DE * D;
        float a[4] = {0.f, 0.f, 0.f, 0.f};
        for (int k = 0; k < DE; ++k) { float hv = hid[k]; _Pragma("unroll") for (int i = 0; i < 4; ++i) a[i] += hv * wd[(size_t)k * D + j + 256 * i]; }
        _Pragma("unroll") for (int i = 0; i < 4; ++i) y[i] += w * a[i];
    }
    _Pragma("unroll") for (int i = 0; i < 4; ++i) x[j + 256 * i] = xv[i] + y[i];
}

extern "C" void kernel_launch(void* const* d_in, const int* in_sizes, int n_in, void* d_out, int out_size, void* d_ws, size_t ws_size, hipStream_t stream) {
    const float* x = (const float*)d_in[0]; const int* pos = (const int*)d_in[1];
    const float* g_mix = (const float*)d_in[2]; const float* w_in = (const float*)d_in[3];
    const float* g_cq = (const float*)d_in[4]; const float* w_uq = (const float*)d_in[5];
    const float* g_ckv = (const float*)d_in[6]; const float* w_uk = (const float*)d_in[7]; const float* w_uv = (const float*)d_in[8];
    const float* g_qn = (const float*)d_in[9]; const float* g_kn = (const float*)d_in[10]; const float* g_mla_out = (const float*)d_in[11];
    const float* rw_mu = (const float*)d_in[12]; const float* rw_w0 = (const float*)d_in[13]; const float* rw_w2 = (const float*)d_in[14];
    const float* rw_a0 = (const float*)d_in[15]; const float* rw_a2 = (const float*)d_in[16]; const float* rw_g2 = (const float*)d_in[17];
    const float* rw_k_k = (const float*)d_in[18]; const float* rw_k_a = (const float*)d_in[19]; const float* rw_r_k = (const float*)d_in[20];
    const float* rw_lnx_g = (const float*)d_in[21]; const float* rw_lnx_b = (const float*)d_in[22];
    const float* w_o = (const float*)d_in[23]; const float* g_ffn = (const float*)d_in[24];
    const float* w_group = (const float*)d_in[25]; const float* b_group = (const float*)d_in[26];
    const float* w_expert = (const float*)d_in[27]; const float* b_expert = (const float*)d_in[28];
    const float* w_gate = (const float*)d_in[29]; const float* w_up = (const float*)d_in[30]; const float* w_down = (const float*)d_in[31];
    float* out = (float*)d_out;
    char* ws = (char*)d_ws;
    const size_t MB = 1u << 20;
    if (ws_size < 500 * MB) return;
    bf16_t* PROJ = (bf16_t*)(ws + 0);
    bf16_t* MIX = (bf16_t*)(ws + 140 * MB);
    char* RX = ws + 206 * MB;
    bf16_t* Qb = (bf16_t*)(RX);
    bf16_t* Kb = (bf16_t*)(RX + 48 * MB);
    bf16_t* KN = (bf16_t*)(RX + 96 * MB);
    bf16_t* Vb = (bf16_t*)(RX + 128 * MB);
    bf16_t* Rb = (bf16_t*)(RX);
    bf16_t* K1 = (bf16_t*)(RX + 32 * MB);
    bf16_t* V1 = (bf16_t*)(RX + 64 * MB);
    float* KK = (float*)(RX + 96 * MB);
    float* BB = (float*)(RX + 160 * MB);
    float* DEC = (float*)(RX + 224 * MB);
    float* small = (float*)(ws + 496 * MB);
    float* RS_X = small; float* RS_CQ = small + T; float* RS_CKV = small + 2 * T; float* RSF = small + 3 * T;
    float* EW = small + 4 * T; int* EID = (int*)(small + 6 * T);

    rowstat_k<float><<<T / 4, 256, 0, stream>>>(x, D, 0, D, 1e-6f, RS_X);
    gemm_k<float, bf16_t><<<dim3((INW + 63) / 64, T / 64), 256, 0, stream>>>(x, D, RS_X, g_mix, w_in, INW, PROJ, INW, T, INW, D, nullptr, 0);
    rowstat_k<bf16_t><<<T / 4, 256, 0, stream>>>(PROJ, INW, 0, QR, 1e-6f, RS_CQ);
    rowstat_k<bf16_t><<<T / 4, 256, 0, stream>>>(PROJ, INW, QR, KVR, 1e-6f, RS_CKV);
    gemm_k<bf16_t, bf16_t><<<dim3(768 / 64, T / 64), 256, 0, stream>>>(PROJ, INW, RS_CQ, g_cq, w_uq, 768, Qb, 768, T, 768, QR, nullptr, 0);
    gemm_k<bf16_t, bf16_t><<<dim3(512 / 64, T / 64), 256, 0, stream>>>(PROJ + QR, INW, RS_CKV, g_ckv, w_uk, 512, KN, 512, T, 512, KVR, nullptr, 0);
    gemm_k<bf16_t, bf16_t><<<dim3(512 / 64, T / 64), 256, 0, stream>>>(PROJ + QR, INW, RS_CKV, g_ckv, w_uv, 512, Vb, 512, T, 512, KVR, nullptr, 0);
    qk_prep_k<<<T * H / 256, 256, 0, stream>>>(Qb, KN, PROJ, pos, g_qn, g_kn, Kb);
    attn_k<<<dim3(S / 64, NB * H), 64, 0, stream>>>(Qb, Kb, Vb, MIX, 1024);
    mla_norm_k<<<T / 4, 256, 0, stream>>>(MIX, g_mla_out);
    float* LIN = out;
    float* G = out + (size_t)T * 256;
    rw_prep1_k<<<(unsigned)(((size_t)T * RWKV_IN + 255) / 256), 256, 0, stream>>>(PROJ, rw_mu, Rb, K1, V1, LIN);
    float* WPRE = (float*)(ws + 0); float* APRE = (float*)(ws + 64 * MB);
    gemm_k<float, float><<<dim3(512 / 64, T / 64), 256, 0, stream>>>(LIN, 256, nullptr, nullptr, rw_w2, 512, WPRE, 512, T, 512, 64, nullptr, 0);
    gemm_k<float, float><<<dim3(512 / 64, T / 64), 256, 0, stream>>>(LIN + 64, 256, nullptr, nullptr, rw_a2, 512, APRE, 512, T, 512, 64, nullptr, 0);
    gemm_k<float, float><<<dim3(512 / 64, T / 64), 256, 0, stream>>>(LIN + 128, 256, nullptr, nullptr, rw_g2, 512, G, 512, T, 512, 128, nullptr, 0);
    rw_prep2_k<<<T * RH / 256, 256, 0, stream>>>(K1, WPRE, APRE, rw_w0, rw_a0, rw_k_k, rw_k_a, KK, BB, DEC);
    float* Y = (float*)(ws + 0);
    rw_scan_k<<<NB * RH, 64, 0, stream>>>(Rb, K1, V1, KK, BB, DEC, Y);
    rw_post_k<<<T * RH / 256, 256, 0, stream>>>(Y, Rb, K1, V1, G, rw_r_k, rw_lnx_g, rw_lnx_b, MIX);
    gemm_k<bf16_t, float><<<dim3(D / 64, T / 64), 256, 0, stream>>>(MIX, 1024, nullptr, nullptr, w_o, D, out, D, T, D, D, x, D);
    route_k<<<T / 4, 256, 0, stream>>>(out, g_ffn, w_group, b_group, w_expert, b_expert, EID, EW, RSF);
    moe_k<<<T, 256, 0, stream>>>(out, g_ffn, RSF, EID, EW, w_gate, w_up, w_down);
}
```

```cpp
#include <hip/hip_runtime.h>
#include <stdint.h>
#include <math.h>
#include <cstdio>

#ifndef MK_PER_PHASE
#define MK_PER_PHASE 0
#endif

typedef unsigned short bf16_t;
constexpr int NB = 4, S = 8192, D = 1024, T = NB * S;
constexpr int H = 8, NOPE = 64, ROPE = 32, QK = 96, VD = 64, MLAW = 512, QR = 256, KVR = 128;
constexpr int RH = 8, RN = 64, RW = 512;
constexpr int MLA_IN = 416, RWKV_IN = 1792, INW = 2208;
constexpr int NG = 4, EPG = 8, NE = 32, DE = 256;
constexpr int NTHR = 512, LDS_BYTES = 147456;

#define LAS __attribute__((address_space(3)))
#define WAVE_SYNC() asm volatile("s_waitcnt lgkmcnt(0)" ::: "memory")

__device__ __forceinline__ float bf2f(bf16_t v) { return __uint_as_float(((unsigned)v) << 16); }
__device__ __forceinline__ bf16_t f2bf(float f) { unsigned u = __float_as_uint(f); return (bf16_t)((u + 0x7fffu + ((u >> 16) & 1u)) >> 16); }
__device__ __forceinline__ float ldf(const float* p) { return *p; }
__device__ __forceinline__ float ldf(const bf16_t* p) { return bf2f(*p); }
__device__ __forceinline__ void stf(float* p, float v) { *p = v; }
__device__ __forceinline__ void stf(bf16_t* p, float v) { *p = f2bf(v); }

#define XB_TMO      128
#define XB_XCNT(j)  (256  + 64 * (j))
#define XB_XSUB(j)  (1280 + 64 * (j))
#define XB_XGEN(j)  (2304 + 64 * (j))
#define XB_TOP      3328
#define XB_TOPGEN   3392
#define XCD_BAR_WORDS 3456
#define XB_SPIN_CAP (1u << 18)
__device__ __forceinline__ unsigned xb_ld(unsigned* p)              { return __hip_atomic_load(p, __ATOMIC_RELAXED, __HIP_MEMORY_SCOPE_AGENT); }
__device__ __forceinline__ unsigned xb_add(unsigned* p, unsigned v) { return __hip_atomic_fetch_add(p, v, __ATOMIC_RELAXED, __HIP_MEMORY_SCOPE_AGENT); }
__device__ __forceinline__ unsigned xb_xcc_id() { return (unsigned)__builtin_amdgcn_s_getreg((3 << 11) | 20) & 0xFu; }
#define XB_SPIN(cond, bar) do { unsigned _sp = 0; while (cond) { __builtin_amdgcn_s_sleep(1); \
    if ((++_sp & 255u) == 0u) { if (xb_ld(&(bar)[XB_TMO])) break; if (_sp > XB_SPIN_CAP) { atomicAdd(&(bar)[XB_TMO], 1u); break; } } } } while (0)
struct XcdBarrier { unsigned* bar; unsigned x; volatile LAS unsigned* st; };
__device__ __forceinline__ XcdBarrier xcd_barrier_post(unsigned* bar, volatile LAS unsigned* st) {
    XcdBarrier b; b.bar = bar; b.x = xb_xcc_id(); b.st = st;
    if (threadIdx.x == 0) (void)xb_add(&bar[XB_XCNT(b.x)], 1u);
    return b;
}
__device__ __forceinline__ void xcd_barrier_complete(unsigned* bar, unsigned x, unsigned& nloc, unsigned& nx) {
    const unsigned G = gridDim.x * gridDim.y * gridDim.z;
    unsigned sum, cnt, mine, sp = 0u;
    for (;;) {
        sum = 0u; cnt = 0u; mine = 0u;
#pragma unroll
        for (unsigned j = 0; j < 16; ++j) { const unsigned c = xb_ld(&bar[XB_XCNT(j)]); sum += c; cnt += (c > 0u) ? 1u : 0u; mine = (j == x) ? c : mine; }
        if (sum == G) break;
        __builtin_amdgcn_s_sleep(1);
        if ((++sp & 255u) == 0u) { if (xb_ld(&bar[XB_TMO])) break; if (sp > XB_SPIN_CAP) { atomicAdd(&bar[XB_TMO], 1u); break; } }
    }
    nloc = mine > 0u ? mine : 1u; nx = cnt > 0u ? cnt : 1u;
}
__device__ __forceinline__ void xcd_barrier(const XcdBarrier& b) {
    asm volatile("s_waitcnt vmcnt(0)" ::: "memory");
    __syncthreads();
    if (threadIdx.x == 0) {
        unsigned* bar = b.bar;
        __builtin_amdgcn_s_waitcnt(0);
        unsigned nloc = b.st[0], nx = b.st[1];
        if (nloc == 0u) { xcd_barrier_complete(bar, b.x, nloc, nx); b.st[0] = nloc; b.st[1] = nx; }
        const unsigned old = xb_add(&bar[XB_XSUB(b.x)], 1u);
        const unsigned gen = old / nloc;
        if (old + 1u == (gen + 1u) * nloc) {
            __builtin_amdgcn_fence(__ATOMIC_RELEASE, "agent");
            asm volatile("s_waitcnt vmcnt(0)" ::: "memory");
            const unsigned og = xb_add(&bar[XB_TOP], 1u);
            const unsigned tg = og / nx;
            if (og + 1u == (tg + 1u) * nx) xb_add(&bar[XB_TOPGEN], 1u);
            else XB_SPIN(xb_ld(&bar[XB_TOPGEN]) == tg, bar);
            __builtin_amdgcn_fence(__ATOMIC_ACQUIRE, "agent");
            xb_add(&bar[XB_XGEN(b.x)], 1u);
            asm volatile("s_waitcnt vmcnt(0)" ::: "memory");
        } else {
            XB_SPIN(xb_ld(&bar[XB_XGEN(b.x)]) == gen, bar);
            __builtin_amdgcn_fence(__ATOMIC_ACQUIRE, "agent");
            asm volatile("s_waitcnt vmcnt(0)" ::: "memory");
        }
    }
    __syncthreads();
}

struct Params {
    const float* x; const int* pos;
    const float *g_mix, *w_in, *g_cq, *w_uq, *g_ckv, *w_uk, *w_uv, *g_qn, *g_kn, *g_mla_out;
    const float *rw_mu, *rw_w0, *rw_w2, *rw_a0, *rw_a2, *rw_g2, *rw_k_k, *rw_k_a, *rw_r_k, *rw_lnx_g, *rw_lnx_b;
    const float *w_o, *g_ffn, *w_group, *b_group, *w_expert, *b_expert, *w_gate, *w_up, *w_down;
    float* out; unsigned char* ws;
    int ph_lo, ph_hi;
};
constexpr size_t MiB = 1u << 20;
constexpr size_t WS_CTL = 0, CTL_ZERO_BYTES = 1 * MiB;
constexpr size_t WS_SMALL = 1 * MiB;
constexpr size_t WS_PROJ = 4 * MiB;
constexpr size_t WS_MIX = 144 * MiB;
constexpr size_t WS_RX = 208 * MiB;
constexpr int CW_BAR = 4096;

template <class TI> __device__ __forceinline__ void ph_rowstat(const TI* in, int ld, int col0, int n, float eps, float* rstd) {
    const int lane = threadIdx.x & 63, gw = blockIdx.x * 8 + (threadIdx.x >> 6), NGW = gridDim.x * 8;
    for (int row = gw; row < T; row += NGW) {
        const TI* p = in + (size_t)row * ld + col0;
        float s = 0.f;
        for (int c = lane; c < n; c += 64) { float v = ldf(p + c); s += v * v; }
        for (int o = 32; o > 0; o >>= 1) s += __shfl_xor(s, o);
        if (lane == 0) rstd[row] = rsqrtf(s / n + eps);
    }
}

template <class TA, class TC> __device__ __forceinline__ void ph_gemm(LAS unsigned char* lds, const TA* A, int lda, const float* rowscale, const float* kgain, const float* Bm, int ldb,
                                                                     TC* C, int ldc, int M, int N, int K, const float* R, int ldr) {
    const int sub = threadIdx.x >> 8, tid = threadIdx.x & 255, tx = tid % 16, ty = tid / 16;
    LAS float (*As)[68] = (LAS float (*)[68])(lds + sub * 16384);
    LAS float (*Bs)[68] = (LAS float (*)[68])(lds + sub * 16384 + 8192);
    const int ntn = (N + 63) / 64, ntiles = ntn * (M / 64);
    const int ar = tid / 4, ac = (tid % 4) * 4, br = tid / 16, bc = (tid % 16) * 4;
    for (int vb = blockIdx.x * 2 + sub; vb < ntiles; vb += gridDim.x * 2) {
        const int m0 = (vb / ntn) * 64, n0 = (vb % ntn) * 64;
        float acc[4][4];
        _Pragma("unroll") for (int i = 0; i < 4; ++i) _Pragma("unroll") for (int j = 0; j < 4; ++j) acc[i][j] = 0.f;
        const float rs = rowscale ? rowscale[m0 + ar] : 1.f;
        for (int k0 = 0; k0 < K; k0 += 16) {
            _Pragma("unroll") for (int i = 0; i < 4; ++i) { float v = ldf(A + (size_t)(m0 + ar) * lda + k0 + ac + i) * rs; if (kgain) v *= kgain[k0 + ac + i]; As[ac + i][ar] = v; }
            _Pragma("unroll") for (int i = 0; i < 4; ++i) { int n = n0 + bc + i; Bs[br][bc + i] = (n < N) ? Bm[(size_t)(k0 + br) * ldb + n] : 0.f; }
            __syncthreads();
            _Pragma("unroll") for (int k = 0; k < 16; ++k) {
                float a[4], b[4];
                _Pragma("unroll") for (int i = 0; i < 4; ++i) a[i] = As[k][ty * 4 + i];
                _Pragma("unroll") for (int j = 0; j < 4; ++j) b[j] = Bs[k][tx * 4 + j];
                _Pragma("unroll") for (int i = 0; i < 4; ++i) _Pragma("unroll") for (int j = 0; j < 4; ++j) acc[i][j] += a[i] * b[j];
            }
            __syncthreads();
        }
        _Pragma("unroll") for (int i = 0; i < 4; ++i) _Pragma("unroll") for (int j = 0; j < 4; ++j) {
            int m = m0 + ty * 4 + i, n = n0 + tx * 4 + j;
            if (n < N) { float v = acc[i][j]; if (R) v += R[(size_t)m * ldr + n]; stf(C + (size_t)m * ldc + n, v); }
        }
    }
}

__device__ __forceinline__ void ph_qk_prep(bf16_t* Q, const bf16_t* KNOPE, const bf16_t* PROJ, const int* pos, const float* g_qn, const float* g_kn, bf16_t* K) {
    for (int idx = blockIdx.x * NTHR + threadIdx.x; idx < T * H; idx += gridDim.x * NTHR) {
        const int t = idx / H, h = idx % H;
        const float p = (float)pos[t];
        bf16_t* qp = Q + (size_t)t * 768 + h * QK; bf16_t* kp = K + (size_t)t * 768 + h * QK;
        const bf16_t* knp = KNOPE + (size_t)t * 512 + h * NOPE; const bf16_t* krp = PROJ + (size_t)t * INW + 384;
        float sq = 0.f, sk = 0.f;
#pragma unroll 4
        for (int d = 0; d < QK; ++d) { float v = bf2f(qp[d]); sq += v * v; }
#pragma unroll 4
        for (int d = 0; d < NOPE; ++d) { float v = bf2f(knp[d]); sk += v * v; }
#pragma unroll 4
        for (int d = 0; d < ROPE; ++d) { float v = bf2f(krp[d]); sk += v * v; }
        const float rq = rsqrtf(sq / QK + 1e-6f), rk = rsqrtf(sk / QK + 1e-6f);
#pragma unroll 4
        for (int d = 0; d < NOPE; ++d) { qp[d] = f2bf(bf2f(qp[d]) * rq * g_qn[d]); kp[d] = f2bf(bf2f(knp[d]) * rk * g_kn[d]); }
#pragma unroll 1
        for (int i = 0; i < 16; ++i) {
            const float inv_freq = 1.0f / powf(10000.0f, (float)i / 16.0f);
            const float ang = p * inv_freq, c = cosf(ang), s = sinf(ang);
            float x1 = bf2f(qp[64 + i]) * rq * g_qn[64 + i], x2 = bf2f(qp[80 + i]) * rq * g_qn[80 + i];
            qp[64 + i] = f2bf(x1 * c - x2 * s); qp[80 + i] = f2bf(x2 * c + x1 * s);
            x1 = bf2f(krp[i]) * rk * g_kn[64 + i]; x2 = bf2f(krp[16 + i]) * rk * g_kn[80 + i];
            kp[64 + i] = f2bf(x1 * c - x2 * s); kp[80 + i] = f2bf(x2 * c + x1 * s);
        }
    }
}

__device__ __forceinline__ void ph_attn(LAS unsigned char* lds, const bf16_t* Q, const bf16_t* K, const bf16_t* V, bf16_t* O, int ldo) {
    const int lane = threadIdx.x & 63, wid = threadIdx.x >> 6;
    LAS float (*Ks)[QK] = (LAS float (*)[QK])(lds + wid * 16384);
    LAS float (*Vs)[VD] = (LAS float (*)[VD])(lds + wid * 16384 + 16 * QK * 4);
    const int ntask = (S / 64) * NB * H;
    for (int task = blockIdx.x * 8 + wid; task < ntask; task += gridDim.x * 8) {
        const int qt = (S / 64 - 1) - task / (NB * H), bh = task % (NB * H), b = bh / H, h = bh % H;
        const int qi = qt * 64 + lane; const size_t trow = (size_t)b * S + qi;
        float q[QK], o[VD];
        const float scale = 0.10206207261596577f;
        _Pragma("unroll") for (int d = 0; d < QK; ++d) q[d] = bf2f(Q[trow * 768 + h * QK + d]) * scale;
        _Pragma("unroll") for (int d = 0; d < VD; ++d) o[d] = 0.f;
        float m = -INFINITY, l = 0.f;
        const int nkt = (qt * 64 + 64) / 16;
        for (int kt = 0; kt < nkt; ++kt) {
            WAVE_SYNC();
            for (int i = lane; i < 16 * QK; i += 64) { int r = i / QK, c = i % QK; Ks[r][c] = bf2f(K[((size_t)b * S + kt * 16 + r) * 768 + h * QK + c]); }
            for (int i = lane; i < 16 * VD; i += 64) { int r = i / VD, c = i % VD; Vs[r][c] = bf2f(V[((size_t)b * S + kt * 16 + r) * 512 + h * VD + c]); }
            WAVE_SYNC();
#pragma unroll 1
            for (int j = 0; j < 16; ++j) {
                if (kt * 16 + j > qi) continue;
                float s = 0.f;
                _Pragma("unroll") for (int d = 0; d < QK; ++d) s += q[d] * Ks[j][d];
                const float mn = fmaxf(m, s), alpha = expf(m - mn), pe = expf(s - mn);
                l = l * alpha + pe;
                _Pragma("unroll") for (int d = 0; d < VD; ++d) o[d] = o[d] * alpha + pe * Vs[j][d];
                m = mn;
            }
        }
        float inv = 1.f / l;
        _Pragma("unroll") for (int d = 0; d < VD; ++d) O[trow * ldo + h * VD + d] = f2bf(o[d] * inv);
    }
}

__device__ __forceinline__ void ph_mla_norm(bf16_t* MIX, const float* g) {
    const int lane = threadIdx.x & 63, gw = blockIdx.x * 8 + (threadIdx.x >> 6), NGW = gridDim.x * 8;
    for (int row = gw; row < T; row += NGW) {
        bf16_t* p = MIX + (size_t)row * 1024;
        float v[8]; float s = 0.f;
        _Pragma("unroll") for (int i = 0; i < 8; ++i) { v[i] = bf2f(p[lane + 64 * i]); s += v[i] * v[i]; }
        for (int o = 32; o > 0; o >>= 1) s += __shfl_xor(s, o);
        float r = rsqrtf(s / 512.f + 1e-6f);
        _Pragma("unroll") for (int i = 0; i < 8; ++i) p[lane + 64 * i] = f2bf(v[i] * r * g[lane + 64 * i]);
    }
}

__device__ __forceinline__ void ph_rw_prep1(const bf16_t* PROJ, const float* mu, bf16_t* R, bf16_t* K1, bf16_t* V1, float* LIN) {
    const size_t total = (size_t)T * RWKV_IN;
    for (size_t idx = (size_t)blockIdx.x * NTHR + threadIdx.x; idx < total; idx += (size_t)gridDim.x * NTHR) {
        int t = (int)(idx / RWKV_IN), c = (int)(idx % RWKV_IN); int s = t % S;
        float f = bf2f(PROJ[(size_t)t * INW + MLA_IN + c]);
        float p = (s > 0) ? bf2f(PROJ[(size_t)(t - 1) * INW + MLA_IN + c]) : 0.f;
        float v = f + (p - f) * mu[c];
        if (c < 512) R[(size_t)t * 512 + c] = f2bf(v);
        else if (c < 1024) K1[(size_t)t * 512 + c - 512] = f2bf(v);
        else if (c < 1536) V1[(size_t)t * 512 + c - 1024] = f2bf(v);
        else if (c < 1600) LIN[(size_t)t * 256 + c - 1536] = tanhf(v);
        else if (c < 1664) LIN[(size_t)t * 256 + c - 1536] = v;
        else LIN[(size_t)t * 256 + c - 1536] = 1.f / (1.f + expf(-v));
    }
}

__device__ __forceinline__ void ph_rw_prep2(bf16_t* K1, const float* WPRE, const float* APRE, const float* w0, const float* a0, const float* k_k, const float* k_a,
                                            float* KK, float* BB, float* DEC) {
    for (int idx = blockIdx.x * NTHR + threadIdx.x; idx < T * RH; idx += gridDim.x * NTHR) {
        int t = idx / RH, h = idx % RH; size_t base = (size_t)t * 512 + h * 64;
        float ss = 0.f;
        for (int j = 0; j < 64; ++j) { float kv = bf2f(K1[base + j]) * k_k[h * 64 + j]; ss += kv * kv; }
        float inv = rsqrtf(ss + 1e-12f);
        for (int j = 0; j < 64; ++j) {
            int c = h * 64 + j;
            float kv = bf2f(K1[base + j]);
            float a = 1.f / (1.f + expf(-(a0[c] + APRE[base + j])));
            float z = w0[c] + WPRE[base + j];
            float w = -log1pf(expf(-z)) - 0.5f;
            float dec = expf(-expf(w));
            float kk = kv * k_k[c] * inv;
            KK[base + j] = kk; BB[base + j] = kk * a; DEC[base + j] = dec;
            K1[base + j] = f2bf(kv * (1.f + (a - 1.f) * k_a[c]));
        }
    }
}

__device__ __forceinline__ void ph_rw_scan(LAS unsigned char* lds, const bf16_t* R, const bf16_t* K1, const bf16_t* V1, const float* KK, const float* BB, const float* DEC, float* Y) {
    const int lane = threadIdx.x & 63, wid = threadIdx.x >> 6;
    const int bh = blockIdx.x * 8 + wid;
    if (bh >= NB * RH) return;
    LAS float (*sh)[5][64] = (LAS float (*)[5][64])(lds + wid * 4096);
    const int b = bh / RH, h = bh % RH;
    float st[64];
    _Pragma("unroll") for (int j = 0; j < 64; ++j) st[j] = 0.f;
    size_t base = ((size_t)b * S) * 512 + h * 64 + lane;
    float nr = bf2f(R[base]), nk = bf2f(K1[base]), nkk = KK[base], nb = BB[base], nd = DEC[base], nv = bf2f(V1[base]);
    for (int s = 0; s < S; ++s) {
        const int buf = s & 1;
        sh[buf][0][lane] = nr; sh[buf][1][lane] = nk; sh[buf][2][lane] = nkk; sh[buf][3][lane] = nb; sh[buf][4][lane] = nd;
        const float vv = nv;
        if (s + 1 < S) { size_t nb_ = base + (size_t)(s + 1) * 512; nr = bf2f(R[nb_]); nk = bf2f(K1[nb_]); nkk = KK[nb_]; nb = BB[nb_]; nd = DEC[nb_]; nv = bf2f(V1[nb_]); }
        WAVE_SYNC();
        float sa = 0.f;
        _Pragma("unroll") for (int j = 0; j < 64; ++j) sa += st[j] * sh[buf][2][j];
        sa = -sa;
        float y = 0.f;
        _Pragma("unroll") for (int j = 0; j < 64; ++j) { st[j] = st[j] * sh[buf][4][j] + sa * sh[buf][3][j] + vv * sh[buf][1][j]; y += st[j] * sh[buf][0][j]; }
        Y[((size_t)b * S + s) * 512 + h * 64 + lane] = y;
        WAVE_SYNC();
    }
}

__device__ __forceinline__ void ph_rw_post(const float* Y, const bf16_t* R, const bf16_t* K1, const bf16_t* V1, const float* G, const float* r_k, const float* lnx_g, const float* lnx_b, bf16_t* MIX) {
    for (int idx = blockIdx.x * NTHR + threadIdx.x; idx < T * RH; idx += gridDim.x * NTHR) {
        int t = idx / RH, h = idx % RH; size_t base = (size_t)t * 512 + h * 64;
        float mean = 0.f; for (int j = 0; j < 64; ++j) mean += Y[base + j]; mean /= 64.f;
        float var = 0.f; for (int j = 0; j < 64; ++j) { float d = Y[base + j] - mean; var += d * d; } var /= 64.f;
        float rs = rsqrtf(var + 64e-5f);
        float bonus = 0.f; for (int j = 0; j < 64; ++j) bonus += bf2f(R[base + j]) * bf2f(K1[base + j]) * r_k[h * 64 + j];
        for (int j = 0; j < 64; ++j) {
            int c = h * 64 + j;
            float y = (Y[base + j] - mean) * rs * lnx_g[c] + lnx_b[c] + bonus * bf2f(V1[base + j]);
            MIX[(size_t)t * 1024 + 512 + c] = f2bf(y * G[base + j]);
        }
    }
}

__device__ __forceinline__ void ph_route(const float* X1, const float* g_ffn, const float* w_group, const float* b_group, const float* w_expert, const float* b_expert, int* EID, float* EW, float* RSF) {
    const int lane = threadIdx.x & 63, gw = blockIdx.x * 8 + (threadIdx.x >> 6), NGW = gridDim.x * 8;
    for (int t = gw; t < T; t += NGW) {
        const float* x = X1 + (size_t)t * D;
        float ss = 0.f, acc[36];
        _Pragma("unroll") for (int i = 0; i < 36; ++i) acc[i] = 0.f;
        for (int k = lane; k < D; k += 64) {
            float v = x[k]; ss += v * v; float tv = v * g_ffn[k];
            _Pragma("unroll") for (int g = 0; g < 4; ++g) acc[g] += tv * w_group[k * 4 + g];
            _Pragma("unroll") for (int e = 0; e < 32; ++e) acc[4 + e] += tv * w_expert[k * 32 + e];
        }
        for (int o = 32; o > 0; o >>= 1) { ss += __shfl_xor(ss, o); _Pragma("unroll") for (int i = 0; i < 36; ++i) acc[i] += __shfl_xor(acc[i], o); }
        if (lane == 0) {
            float rs = rsqrtf(ss / D + 1e-6f);
            float gl[4]; int gs = 0; float gm = -INFINITY;
            _Pragma("unroll") for (int g = 0; g < 4; ++g) { gl[g] = acc[g] * rs + b_group[g]; if (gl[g] > gm) { gm = gl[g]; gs = g; } }
            float den = 0.f; _Pragma("unroll") for (int g = 0; g < 4; ++g) den += expf(gl[g] - gm);
            float gp = 1.f / den;
            float el[8];
            _Pragma("unroll") for (int e = 0; e < 8; ++e) { float v = acc[4 + e]; _Pragma("unroll") for (int g = 1; g < 4; ++g) v = (gs == g) ? acc[4 + g * 8 + e] : v; el[e] = v * rs + b_expert[gs * 8 + e]; }
            int i1 = 0; float v1 = el[0];
            _Pragma("unroll") for (int e = 1; e < 8; ++e) if (el[e] > v1) { v1 = el[e]; i1 = e; }
            int i2 = -1; float v2 = -INFINITY;
            _Pragma("unroll") for (int e = 0; e < 8; ++e) if (e != i1 && el[e] > v2) { v2 = el[e]; i2 = e; }
            float e2 = expf(v2 - v1); float w1 = 1.f / (1.f + e2), w2 = e2 / (1.f + e2);
            EID[t * 2] = gs * 8 + i1; EID[t * 2 + 1] = gs * 8 + i2; EW[t * 2] = w1 * gp; EW[t * 2 + 1] = w2 * gp; RSF[t] = rs;
        }
    }
}

__device__ __forceinline__ void ph_moe(LAS unsigned char* lds, float* OUT, const float* g_ffn, const float* RSF, const int* EID, const float* EW,
                                       const float* w_gate, const float* w_up, const float* w_down) {
    const int sub = threadIdx.x >> 8, j = threadIdx.x & 255;
    LAS float* tn = (LAS float*)(lds + sub * 8192);
    LAS float* hid = (LAS float*)(lds + sub * 8192 + 4096);
    for (int t = blockIdx.x * 2 + sub; t < T; t += gridDim.x * 2) {
        float* x = OUT + (size_t)t * D;
        const float rs = RSF[t];
        float xv[4];
        __syncthreads();
        _Pragma("unroll") for (int i = 0; i < 4; ++i) { xv[i] = x[j + 256 * i]; tn[j + 256 * i] = xv[i] * rs * g_ffn[j + 256 * i]; }
        float y[4] = {0.f, 0.f, 0.f, 0.f};
        for (int sl = 0; sl < 2; ++sl) {
            const int e = EID[t * 2 + sl]; const float w = EW[t * 2 + sl];
            __syncthreads();
            const float* wg = w_gate + (size_t)e * D * DE; const float* wu = w_up + (size_t)e * D * DE;
            float hg = 0.f, hu = 0.f;
            for (int k = 0; k < D; ++k) { float tv = tn[k]; hg += tv * wg[(size_t)k * DE + j]; hu += tv * wu[(size_t)k * DE + j]; }
            hid[j] = hg / (1.f + expf(-hg)) * hu;
            __syncthreads();
            const float* wd = w_down + (size_t)e * DE * D;
            float a[4] = {0.f, 0.f, 0.f, 0.f};
            for (int k = 0; k < DE; ++k) { float hv = hid[k]; _Pragma("unroll") for (int i = 0; i < 4; ++i) a[i] += hv * wd[(size_t)k * D + j + 256 * i]; }
            _Pragma("unroll") for (int i = 0; i < 4; ++i) y[i] += w * a[i];
        }
        _Pragma("unroll") for (int i = 0; i < 4; ++i) x[j + 256 * i] = xv[i] + y[i];
    }
}

constexpr int N_PHASES = 14;
__global__ void __launch_bounds__(NTHR, 2) mk_fwd(Params p) {
    extern __shared__ __attribute__((aligned(16))) unsigned char lds_raw[];
    LAS unsigned char* lds = (LAS unsigned char*)lds_raw;
    volatile LAS unsigned* MISC = (volatile LAS unsigned*)(lds + 131072 + 320);
    for (int u = threadIdx.x; u < (LDS_BYTES - 131072) / 4; u += NTHR) ((LAS unsigned*)(lds + 131072))[u] = 0u;
    __syncthreads();
    unsigned* ctl = (unsigned*)(p.ws + WS_CTL);
    XcdBarrier bar; bar.bar = ctl + CW_BAR; bar.x = 0; bar.st = nullptr;
    if (!MK_PER_PHASE) bar = xcd_barrier_post(ctl + CW_BAR, MISC + 8);
#define GRID_BAR() do { if (!MK_PER_PHASE) xcd_barrier(bar); } while (0)
#define IN(k) (p.ph_lo <= (k) && (k) < p.ph_hi)
#define BOTH(k) (IN(k) && IN((k) + 1))
    unsigned char* ws = p.ws;
    float* small = (float*)(ws + WS_SMALL);
    float* RS_X = small; float* RS_CQ = small + T; float* RS_CKV = small + 2 * T; float* RSF = small + 3 * T;
    float* EW = small + 4 * T; int* EID = (int*)(small + 6 * T);
    bf16_t* PROJ = (bf16_t*)(ws + WS_PROJ);
    bf16_t* MIX = (bf16_t*)(ws + WS_MIX);
    unsigned char* RX = ws + WS_RX;
    bf16_t* Qb = (bf16_t*)(RX); bf16_t* Kb = (bf16_t*)(RX + 48 * MiB); bf16_t* KN = (bf16_t*)(RX + 96 * MiB); bf16_t* Vb = (bf16_t*)(RX + 128 * MiB);
    bf16_t* Rb = (bf16_t*)(RX); bf16_t* K1 = (bf16_t*)(RX + 32 * MiB); bf16_t* V1 = (bf16_t*)(RX + 64 * MiB);
    float* KK = (float*)(RX + 96 * MiB); float* BB = (float*)(RX + 160 * MiB); float* DEC = (float*)(RX + 224 * MiB);
    float* LIN = p.out; float* G = p.out + (size_t)T * 256;
    float* WPRE = (float*)(ws + WS_PROJ); float* APRE = (float*)(ws + WS_PROJ + 64 * MiB); float* Y = (float*)(ws + WS_PROJ);

    if (IN(0)) { ph_rowstat<float>(p.x, D, 0, D, 1e-6f, RS_X); if (BOTH(0)) GRID_BAR(); }
    if (IN(1)) { ph_gemm<float, bf16_t>(lds, p.x, D, RS_X, p.g_mix, p.w_in, INW, PROJ, INW, T, INW, D, nullptr, 0); if (BOTH(1)) GRID_BAR(); }
    if (IN(2)) { ph_rowstat<bf16_t>(PROJ, INW, 0, QR, 1e-6f, RS_CQ); ph_rowstat<bf16_t>(PROJ, INW, QR, KVR, 1e-6f, RS_CKV); if (BOTH(2)) GRID_BAR(); }
    if (IN(3)) {
        ph_gemm<bf16_t, bf16_t>(lds, PROJ, INW, RS_CQ, p.g_cq, p.w_uq, 768, Qb, 768, T, 768, QR, nullptr, 0);
        ph_gemm<bf16_t, bf16_t>(lds, PROJ + QR, INW, RS_CKV, p.g_ckv, p.w_uk, 512, KN, 512, T, 512, KVR, nullptr, 0);
        ph_gemm<bf16_t, bf16_t>(lds, PROJ + QR, INW, RS_CKV, p.g_ckv, p.w_uv, 512, Vb, 512, T, 512, KVR, nullptr, 0);
        if (BOTH(3)) GRID_BAR(); }
    if (IN(4)) { ph_qk_prep(Qb, KN, PROJ, p.pos, p.g_qn, p.g_kn, Kb); if (BOTH(4)) GRID_BAR(); }
    if (IN(5)) { ph_attn(lds, Qb, Kb, Vb, MIX, 1024); if (BOTH(5)) GRID_BAR(); }
    if (IN(6)) { ph_mla_norm(MIX, p.g_mla_out); ph_rw_prep1(PROJ, p.rw_mu, Rb, K1, V1, LIN); if (BOTH(6)) GRID_BAR(); }
    if (IN(7)) {
        ph_gemm<float, float>(lds, LIN, 256, nullptr, nullptr, p.rw_w2, 512, WPRE, 512, T, 512, 64, nullptr, 0);
        ph_gemm<float, float>(lds, LIN + 64, 256, nullptr, nullptr, p.rw_a2, 512, APRE, 512, T, 512, 64, nullptr, 0);
        ph_gemm<float, float>(lds, LIN + 128, 256, nullptr, nullptr, p.rw_g2, 512, G, 512, T, 512, 128, nullptr, 0);
        if (BOTH(7)) GRID_BAR(); }
    if (IN(8)) { ph_rw_prep2(K1, WPRE, APRE, p.rw_w0, p.rw_a0, p.rw_k_k, p.rw_k_a, KK, BB, DEC); if (BOTH(8)) GRID_BAR(); }
    if (IN(9)) { ph_rw_scan(lds, Rb, K1, V1, KK, BB, DEC, Y); if (BOTH(9)) GRID_BAR(); }
    if (IN(10)) { ph_rw_post(Y, Rb, K1, V1, G, p.rw_r_k, p.rw_lnx_g, p.rw_lnx_b, MIX); if (BOTH(10)) GRID_BAR(); }
    if (IN(11)) { ph_gemm<bf16_t, float>(lds, MIX, 1024, nullptr, nullptr, p.w_o, D, p.out, D, T, D, D, p.x, D); if (BOTH(11)) GRID_BAR(); }
    if (IN(12)) { ph_route(p.out, p.g_ffn, p.w_group, p.b_group, p.w_expert, p.b_expert, EID, EW, RSF); if (BOTH(12)) GRID_BAR(); }
    if (IN(13)) { ph_moe(lds, p.out, p.g_ffn, RSF, EID, EW, p.w_gate, p.w_up, p.w_down); }
}

extern "C" void kernel_launch(void* const* d_in, const int* in_sizes, int n_in, void* d_out, int out_size, void* d_ws, size_t ws_size, hipStream_t stream) {
    static int grid = 0;
    if (grid == 0) {
        if (n_in != 32 || out_size != T * D || ws_size < 500 * MiB) { fprintf(stderr, "kernel_launch: unexpected shapes (n_in %d out %d ws %zu)\n", n_in, out_size, ws_size); grid = -1; return; }
        int dev = 0, cus = 0, per_cu = 0;
        if (hipGetDevice(&dev) != hipSuccess || hipDeviceGetAttribute(&cus, hipDeviceAttributeMultiprocessorCount, dev) != hipSuccess) { grid = -1; return; }
        if (hipFuncSetAttribute((const void*)mk_fwd, hipFuncAttributeMaxDynamicSharedMemorySize, LDS_BYTES) != hipSuccess) { fprintf(stderr, "kernel_launch: hipFuncSetAttribute failed\n"); grid = -1; return; }
        if (hipOccupancyMaxActiveBlocksPerMultiprocessor(&per_cu, (const void*)mk_fwd, NTHR, LDS_BYTES) != hipSuccess || per_cu < 1) { fprintf(stderr, "kernel_launch: occupancy query says %d blocks/CU\n", per_cu); grid = -1; (void)hipGetLastError(); return; }
        grid = cus;
    }
    if (grid < 0) return;
    (void)hipMemsetAsync((char*)d_ws + WS_CTL, 0, CTL_ZERO_BYTES, stream);
    Params p{};
    p.x = (const float*)d_in[0]; p.pos = (const int*)d_in[1];
    p.g_mix = (const float*)d_in[2]; p.w_in = (const float*)d_in[3]; p.g_cq = (const float*)d_in[4]; p.w_uq = (const float*)d_in[5];
    p.g_ckv = (const float*)d_in[6]; p.w_uk = (const float*)d_in[7]; p.w_uv = (const float*)d_in[8]; p.g_qn = (const float*)d_in[9];
    p.g_kn = (const float*)d_in[10]; p.g_mla_out = (const float*)d_in[11]; p.rw_mu = (const float*)d_in[12]; p.rw_w0 = (const float*)d_in[13];
    p.rw_w2 = (const float*)d_in[14]; p.rw_a0 = (const float*)d_in[15]; p.rw_a2 = (const float*)d_in[16]; p.rw_g2 = (const float*)d_in[17];
    p.rw_k_k = (const float*)d_in[18]; p.rw_k_a = (const float*)d_in[19]; p.rw_r_k = (const float*)d_in[20]; p.rw_lnx_g = (const float*)d_in[21];
    p.rw_lnx_b = (const float*)d_in[22]; p.w_o = (const float*)d_in[23]; p.g_ffn = (const float*)d_in[24]; p.w_group = (const float*)d_in[25];
    p.b_group = (const float*)d_in[26]; p.w_expert = (const float*)d_in[27]; p.b_expert = (const float*)d_in[28]; p.w_gate = (const float*)d_in[29];
    p.w_up = (const float*)d_in[30]; p.w_down = (const float*)d_in[31];
    p.out = (float*)d_out; p.ws = (unsigned char*)d_ws;
#if MK_PER_PHASE
    for (int k = 0; k < N_PHASES; ++k) { p.ph_lo = k; p.ph_hi = k + 1; hipLaunchKernelGGL(mk_fwd, dim3(grid), dim3(NTHR), LDS_BYTES, stream, p); }
#else
    p.ph_lo = 0; p.ph_hi = N_PHASES;
    hipLaunchKernelGGL(mk_fwd, dim3(grid), dim3(NTHR), LDS_BYTES, stream, p);
#endif
}
```

```cpp
#include <hip/hip_runtime.h>
#include <stdint.h>
#include <math.h>
#include <cstdio>

#ifndef MK_PER_PHASE
#define MK_PER_PHASE 0
#endif

typedef unsigned short bf16_t;
constexpr int NB = 4, S = 8192, D = 1024, T = NB * S;
constexpr int H = 8, NOPE = 64, ROPE = 32, QK = 96, VD = 64, MLAW = 512, QR = 256, KVR = 128;
constexpr int RH = 8, RN = 64, RW = 512;
constexpr int MLA_IN = 416, RWKV_IN = 1792, INW = 2208;
constexpr int NG = 4, EPG = 8, NE = 32, DE = 256;
constexpr int NTHR = 512, LDS_BYTES = 147456;

#define LAS __attribute__((address_space(3)))
#define WAVE_SYNC() asm volatile("s_waitcnt lgkmcnt(0)" ::: "memory")

__device__ __forceinline__ float bf2f(bf16_t v) { return __uint_as_float(((unsigned)v) << 16); }
__device__ __forceinline__ bf16_t f2bf(float f) { unsigned u = __float_as_uint(f); return (bf16_t)((u + 0x7fffu + ((u >> 16) & 1u)) >> 16); }
__device__ __forceinline__ float ldf(const float* p) { return *p; }
__device__ __forceinline__ float ldf(const bf16_t* p) { return bf2f(*p); }
__device__ __forceinline__ void stf(float* p, float v) { *p = v; }
__device__ __forceinline__ void stf(bf16_t* p, float v) { *p = f2bf(v); }

#define XB_TMO      128
#define XB_XCNT(j)  (256  + 64 * (j))
#define XB_XSUB(j)  (1280 + 64 * (j))
#define XB_XGEN(j)  (2304 + 64 * (j))
#define XB_TOP      3328
#define XB_TOPGEN   3392
#define XCD_BAR_WORDS 3456
#define XB_SPIN_CAP (1u << 18)
__device__ __forceinline__ unsigned xb_ld(unsigned* p)              { return __hip_atomic_load(p, __ATOMIC_RELAXED, __HIP_MEMORY_SCOPE_AGENT); }
__device__ __forceinline__ unsigned xb_add(unsigned* p, unsigned v) { return __hip_atomic_fetch_add(p, v, __ATOMIC_RELAXED, __HIP_MEMORY_SCOPE_AGENT); }
__device__ __forceinline__ unsigned xb_xcc_id() { return (unsigned)__builtin_amdgcn_s_getreg((3 << 11) | 20) & 0xFu; }
#define XB_SPIN(cond, bar) do { unsigned _sp = 0; while (cond) { __builtin_amdgcn_s_sleep(1); \
    if ((++_sp & 255u) == 0u) { if (xb_ld(&(bar)[XB_TMO])) break; if (_sp > XB_SPIN_CAP) { atomicAdd(&(bar)[XB_TMO], 1u); break; } } } } while (0)
struct XcdBarrier { unsigned* bar; unsigned x; volatile LAS unsigned* st; };
__device__ __forceinline__ XcdBarrier xcd_barrier_post(unsigned* bar, volatile LAS unsigned* st) {
    XcdBarrier b; b.bar = bar; b.x = xb_xcc_id(); b.st = st;
    if (threadIdx.x == 0) (void)xb_add(&bar[XB_XCNT(b.x)], 1u);
    return b;
}
__device__ __forceinline__ void xcd_barrier_complete(unsigned* bar, unsigned x, unsigned& nloc, unsigned& nx) {
    const unsigned G = gridDim.x * gridDim.y * gridDim.z;
    unsigned sum, cnt, mine, sp = 0u;
    for (;;) {
        sum = 0u; cnt = 0u; mine = 0u;
#pragma unroll
        for (unsigned j = 0; j < 16; ++j) { const unsigned c = xb_ld(&bar[XB_XCNT(j)]); sum += c; cnt += (c > 0u) ? 1u : 0u; mine = (j == x) ? c : mine; }
        if (sum == G) break;
        __builtin_amdgcn_s_sleep(1);
        if ((++sp & 255u) == 0u) { if (xb_ld(&bar[XB_TMO])) break; if (sp > XB_SPIN_CAP) { atomicAdd(&bar[XB_TMO], 1u); break; } }
    }
    nloc = mine > 0u ? mine : 1u; nx = cnt > 0u ? cnt : 1u;
}
__device__ __forceinline__ void xcd_barrier(const XcdBarrier& b) {
    asm volatile("s_waitcnt vmcnt(0)" ::: "memory");
    __syncthreads();
    if (threadIdx.x == 0) {
        unsigned* bar = b.bar;
        __builtin_amdgcn_s_waitcnt(0);
        unsigned nloc = b.st[0], nx = b.st[1];
        if (nloc == 0u) { xcd_barrier_complete(bar, b.x, nloc, nx); b.st[0] = nloc; b.st[1] = nx; }
        const unsigned old = xb_add(&bar[XB_XSUB(b.x)], 1u);
        const unsigned gen = old / nloc;
        if (old + 1u == (gen + 1u) * nloc) {
            __builtin_amdgcn_fence(__ATOMIC_RELEASE, "agent");
            asm volatile("s_waitcnt vmcnt(0)" ::: "memory");
            const unsigned og = xb_add(&bar[XB_TOP], 1u);
            const unsigned tg = og / nx;
            if (og + 1u == (tg + 1u) * nx) xb_add(&bar[XB_TOPGEN], 1u);
            else XB_SPIN(xb_ld(&bar[XB_TOPGEN]) == tg, bar);
            __builtin_amdgcn_fence(__ATOMIC_ACQUIRE, "agent");
            xb_add(&bar[XB_XGEN(b.x)], 1u);
            asm volatile("s_waitcnt vmcnt(0)" ::: "memory");
        } else {
            XB_SPIN(xb_ld(&bar[XB_XGEN(b.x)]) == gen, bar);
            __builtin_amdgcn_fence(__ATOMIC_ACQUIRE, "agent");
            asm volatile("s_waitcnt vmcnt(0)" ::: "memory");
        }
    }
    __syncthreads();
}

namespace pg8 {
#define PG8_LAS __attribute__((address_space(3)))
typedef unsigned short bf16_t;
typedef short bf16x8 __attribute__((ext_vector_type(8)));
typedef float f32x4 __attribute__((ext_vector_type(4)));
typedef unsigned u32x4 __attribute__((ext_vector_type(4)));
constexpr int BM = 256, BK = 64, HALF = 128, HTB = HALF * BK * 2  , STAGE_BYTES = 8 * HTB, NXCD = 8, WGM = 8;

__host__ __device__ __forceinline__ int lds_byte(int r, int c) { const int st = (r >> 4) * 2 + (c >> 5), rr = r & 15, cc = c & 31, ob = rr * 64 + cc * 2; return st * 1024 + (ob ^ (((ob >> 9) & 1) << 5)); }
__host__ __device__ __forceinline__ void stage_rc(int b, int& R, int& C) { const int st = b / 1024, sb = b % 1024, swz = sb ^ (((sb >> 9) & 1) << 5); R = (st >> 1) * 16 + swz / 64; C = (st & 1) * 32 + (swz % 64) / 2; }
__host__ __device__ __forceinline__ int perm32(int rho) { const int n = rho >> 4, i = rho & 15; return 8 * (i >> 2) + 4 * n + (i & 3); }

struct Unit { int pm, pn; };
struct Gemm { const bf16_t* A; const bf16_t* Bt; int M, N, K, lda, ldb; };

struct StaticOrder {
    int nM, nN, nwg, G, c;
    __host__ __device__ void init(int M, int N, int G_, int c_) { nM = M / BM; nN = N / BM; nwg = nM * nN; G = G_; c = c_; }
    __host__ __device__ bool next(int i, Unit& u) const {
        const long L = (long)i * G + c; if (L >= nwg) return false;
        int wgid = (int)L; { const int q = nwg / NXCD, r = nwg % NXCD, xcd = wgid % NXCD, off = wgid / NXCD; wgid = (xcd < r ? xcd * (q + 1) : r * (q + 1) + (xcd - r) * q) + off; }
        const int nig = WGM * nN, gid = wgid / nig, fm = gid * WGM, gsz = (nM - fm) < WGM ? (nM - fm) : WGM;
        u.pm = fm + ((wgid % nig) % gsz); u.pn = (wgid % nig) / gsz; return true;
    }
    __device__ __forceinline__ void a_ready(const Unit&) const {}
    __device__ __forceinline__ void done(const Unit&) const {}
};

__device__ __forceinline__ unsigned cvt_pk_bf16(float lo, float hi) { unsigned r; asm volatile("v_cvt_pk_bf16_f32 %0, %1, %2" : "=v"(r) : "v"(lo), "v"(hi)); return r; }
typedef float f32x2 __attribute__((ext_vector_type(2)));
__device__ __forceinline__ f32x2 gelu_pk(f32x2 v) {
    const f32x2 av = __builtin_elementwise_abs(v), d = av * 0.2316418882f + 1.0f;
    f32x2 t; t.x = __builtin_amdgcn_rcpf(d.x); t.y = __builtin_amdgcn_rcpf(d.y);
    f32x2 q = t * 0.5307027145f + (-0.7265760135f); q = q * t + 0.7107068705f; q = q * t + (-0.142248368f); q = q * t + 0.127414796f; q = q * t;
    const f32x2 s = (v * v) * (-0.72134752044f);
    f32x2 e; e.x = __builtin_amdgcn_exp2f(s.x); e.y = __builtin_amdgcn_exp2f(s.y);
    const f32x2 m = v * (q * e), r = v - m;
    f32x2 o; o.x = v.x < 0.f ? m.x : r.x; o.y = v.y < 0.f ? m.y : r.y; return o;
}

template <int ACT  > struct EpiBf16 {
    static constexpr bool PERM = true, AFTER_DRAIN = false; static_assert(ACT == 0 || ACT == 1, "EpiBf16: ACT is 0 (none) or 1 (gelu_pk)");
    bf16_t* O; int ldc; const float* bias; int split_cols; size_t split_stride; float scale0;
    __device__ __forceinline__ void operator()(const f32x4 (&acc)[2][2][4][2], const Unit& u, int wr, int wc, int fr, int fq) const {
        const int row0 = u.pm * BM + wr * 64 + fr; int colt = u.pn * BM; bf16_t* base = O;
        float sc = 1.f; if (split_cols) { const int t = colt / split_cols; base += (size_t)t * split_stride; colt -= t * split_cols; if (t == 0) sc = scale0; }
        const int col0 = colt + wc * 32 + 8 * fq, bcol0 = u.pn * BM + wc * 32 + 8 * fq;
        f32x4 bv[2][2];
#pragma unroll
        for (int bj = 0; bj < 2; ++bj)
#pragma unroll
            for (int n = 0; n < 2; ++n) bv[bj][n] = bias ? *(const f32x4*)(bias + bcol0 + bj * HALF + 4 * n) : (f32x4){0.f, 0.f, 0.f, 0.f};
#pragma unroll
        for (int ai = 0; ai < 2; ++ai)
#pragma unroll
            for (int m = 0; m < 4; ++m) { bf16_t* rowp = base + (size_t)(row0 + ai * HALF + m * 16) * ldc + col0;
#pragma unroll
                for (int bj = 0; bj < 2; ++bj) { f32x4 v0 = acc[ai][bj][m][0] + bv[bj][0], v1 = acc[ai][bj][m][1] + bv[bj][1];
                    if (ACT == 1) { f32x2 a = gelu_pk((f32x2){v0[0], v0[1]}), b = gelu_pk((f32x2){v0[2], v0[3]}), c = gelu_pk((f32x2){v1[0], v1[1]}), d = gelu_pk((f32x2){v1[2], v1[3]});
                        v0 = (f32x4){a.x, a.y, b.x, b.y}; v1 = (f32x4){c.x, c.y, d.x, d.y}; }
                    v0 = v0 * sc; v1 = v1 * sc; u32x4 w; w.x = cvt_pk_bf16(v0[0], v0[1]); w.y = cvt_pk_bf16(v0[2], v0[3]); w.z = cvt_pk_bf16(v1[0], v1[1]); w.w = cvt_pk_bf16(v1[2], v1[3]);
                    *(u32x4*)(rowp + bj * HALF) = w; } }
    }
};
template <class Epi, class Sched, bool ALIGN_EPI = false, bool SP2 = false>
__device__ __forceinline__ void gemm_phase(PG8_LAS unsigned char* lds, const Gemm g, const Sched& S, const Epi& E) {
    const int tid = threadIdx.x, wid = __builtin_amdgcn_readfirstlane(tid >> 6), lane = tid & 63, wr = wid >> 2, wc = wid & 3, fr = lane & 15, fq = lane >> 4;
    const int K = g.K, nt = K / BK;
    unsigned voffA[2], voffB[2];
#pragma unroll
    for (int i = 0; i < 2; ++i) { int R, C; stage_rc(tid * 16 + i * 8192, R, C); const int Rb = Epi::PERM ? ((R & ~31) + perm32(R & 31)) : R;
        voffA[i] = (unsigned)(R * g.lda + C) * 2u; voffB[i] = (unsigned)(Rb * g.ldb + C) * 2u; }
    const size_t kstep = (size_t)(BK * 2);
    const size_t hstepA = (size_t)HALF * g.lda * 2, hstepB = (size_t)HALF * g.ldb * 2;
    const size_t tstepA = 2 * hstepA, tstepB = 2 * hstepB;
    const unsigned ldsw = (unsigned)wid * 1024u;
    const int aoff = lds_byte(wr * 64 + fr, fq * 8), boff = lds_byte(wc * 32 + fr, fq * 8);
#define PG8_SA(b, h) (((b) * 2 + (h)) * HTB)
#define PG8_SB(b, h) ((4 + (b) * 2 + (h)) * HTB)
#define PG8_STAGE(bufoff, gbase, voff) do { _Pragma("unroll") for (int _i = 0; _i < 2; ++_i) \
        __builtin_amdgcn_global_load_lds((const unsigned*)((const char*)(gbase) + (voff)[_i]), (PG8_LAS unsigned*)(lds + (bufoff) + ldsw + _i * 8192), 16, 0, 0); } while (0)
#define PG8_LDA(dst, b, h) do { _Pragma("unroll") for (int m = 0; m < 4; ++m) _Pragma("unroll") for (int k = 0; k < 2; ++k) dst[m][k] = *(const PG8_LAS bf16x8*)(lds + PG8_SA(b, h) + aoff + m * 2048 + k * 1024); } while (0)
#define PG8_LDB(dst, b, h) do { _Pragma("unroll") for (int n = 0; n < 2; ++n) _Pragma("unroll") for (int k = 0; k < 2; ++k) dst[n][k] = *(const PG8_LAS bf16x8*)(lds + PG8_SB(b, h) + boff + n * 2048 + k * 1024); } while (0)
#define PG8_MMA(ai, bj, At, Bt) do { __builtin_amdgcn_s_setprio(1); _Pragma("unroll") for (int m = 0; m < 4; ++m) _Pragma("unroll") for (int n = 0; n < 2; ++n) _Pragma("unroll") for (int k = 0; k < 2; ++k) \
        acc[ai][bj][m][n] = __builtin_amdgcn_mfma_f32_16x16x32_bf16(Bt[n][k], At[m][k], acc[ai][bj][m][n], 0, 0, 0); __builtin_amdgcn_s_setprio(0); } while (0)
#define PG8_WAIT_V(n) asm volatile("s_waitcnt vmcnt(" #n ")" ::: "memory")
#define PG8_WAIT_L(n) asm volatile("s_waitcnt lgkmcnt(" #n ")" ::: "memory")
#define PG8_BAR __builtin_amdgcn_s_barrier()
#define PG8_SCHED __builtin_amdgcn_sched_barrier(0)
    Unit cur, nxt; int ui = 0;
    if (!S.next(0, cur)) return;
    f32x4 acc[2][2][4][2];
#pragma unroll
    for (int a = 0; a < 2; ++a)
#pragma unroll
        for (int b = 0; b < 2; ++b)
#pragma unroll
            for (int m = 0; m < 4; ++m)
#pragma unroll
                for (int n = 0; n < 2; ++n) acc[a][b][m][n] = (f32x4){0.f, 0.f, 0.f, 0.f};
    bf16x8 At[4][2], B0[2][2], B1[2][2];
    const char* cA = (const char*)g.A + (size_t)cur.pm * tstepA; const char* cB = (const char*)g.Bt + (size_t)cur.pn * tstepB;
    S.a_ready(cur);
    if constexpr (SP2) {
        PG8_STAGE(PG8_SB(0, 0), cB, voffB); PG8_STAGE(PG8_SB(0, 1), cB + hstepB, voffB); PG8_STAGE(PG8_SA(0, 0), cA, voffA); PG8_STAGE(PG8_SA(0, 1), cA + hstepA, voffA);
        if (wr == 1) PG8_BAR;
        PG8_WAIT_V(2); PG8_BAR;
        PG8_STAGE(PG8_SB(1, 0), cB + kstep, voffB); PG8_STAGE(PG8_SA(1, 0), cA + kstep, voffA); PG8_STAGE(PG8_SB(1, 1), cB + hstepB + kstep, voffB);
        PG8_WAIT_V(6); PG8_BAR;
    } else {
        PG8_STAGE(PG8_SB(0, 0), cB, voffB); PG8_STAGE(PG8_SA(0, 0), cA, voffA); PG8_STAGE(PG8_SB(0, 1), cB + hstepB, voffB); PG8_STAGE(PG8_SA(0, 1), cA + hstepA, voffA);
        if (wr == 1) PG8_BAR;
        PG8_WAIT_V(4); PG8_BAR;
        PG8_STAGE(PG8_SB(1, 0), cB + kstep, voffB); PG8_STAGE(PG8_SA(1, 0), cA + kstep, voffA); PG8_STAGE(PG8_SB(1, 1), cB + hstepB + kstep, voffB);
        PG8_WAIT_V(6); PG8_BAR;
    }
    for (;;) {
        const bool has_next = S.next(ui + 1, nxt);
        const char* nA = has_next ? (const char*)g.A + (size_t)nxt.pm * tstepA : cA; const char* nB = has_next ? (const char*)g.Bt + (size_t)nxt.pn * tstepB : cB;
        for (int t = 0; t < nt; t += 2) {
            const bool last = (t == nt - 2);
            const char* a1 = cA + (size_t)(t + 1) * kstep;
            const char* a2 = last ? nA : cA + (size_t)(t + 2) * kstep; const char* b2 = last ? nB : cB + (size_t)(t + 2) * kstep;
            const char* a3 = a2 + kstep; const char* b3 = b2 + kstep;
            if (last && has_next) S.a_ready(nxt);
            if constexpr (SP2) {
            PG8_LDB(B0, 0, 0); PG8_LDB(B1, 0, 1); PG8_SCHED; PG8_LDA(At, 0, 0); PG8_STAGE(PG8_SA(1, 1), a1 + hstepA, voffA);
            PG8_WAIT_V(8); PG8_WAIT_L(0); PG8_BAR; PG8_MMA(0, 0, At, B0); PG8_MMA(0, 1, At, B1); PG8_BAR; PG8_SCHED;
            PG8_LDA(At, 0, 1); PG8_STAGE(PG8_SB(0, 0), b2, voffB); PG8_STAGE(PG8_SB(0, 1), b2 + hstepB, voffB); PG8_STAGE(PG8_SA(0, 0), a2, voffA);
            PG8_WAIT_V(8); PG8_WAIT_L(0); PG8_BAR; PG8_MMA(1, 0, At, B0); PG8_MMA(1, 1, At, B1); PG8_BAR; PG8_SCHED;
            PG8_LDB(B0, 1, 0); PG8_LDB(B1, 1, 1); PG8_SCHED; PG8_LDA(At, 1, 0); PG8_STAGE(PG8_SA(0, 1), a2 + hstepA, voffA);
            PG8_WAIT_V(8); PG8_WAIT_L(0); PG8_BAR; PG8_MMA(0, 0, At, B0); PG8_MMA(0, 1, At, B1); PG8_BAR; PG8_SCHED;
            PG8_LDA(At, 1, 1); PG8_STAGE(PG8_SB(1, 0), b3, voffB); PG8_STAGE(PG8_SB(1, 1), b3 + hstepB, voffB); PG8_STAGE(PG8_SA(1, 0), a3, voffA);
            PG8_WAIT_V(8); PG8_WAIT_L(0); PG8_BAR; PG8_MMA(1, 0, At, B0); PG8_MMA(1, 1, At, B1); PG8_BAR; PG8_SCHED;
            } else {
            PG8_LDB(B0, 0, 0); PG8_SCHED; PG8_LDA(At, 0, 0); PG8_STAGE(PG8_SA(1, 1), a1 + hstepA, voffA);
            PG8_WAIT_L(8); PG8_BAR; PG8_WAIT_L(0); PG8_MMA(0, 0, At, B0); PG8_BAR; PG8_SCHED;
            PG8_LDB(B1, 0, 1); PG8_STAGE(PG8_SB(0, 0), b2, voffB);
            PG8_BAR; PG8_WAIT_L(0); PG8_MMA(0, 1, At, B1); PG8_BAR;
            PG8_LDA(At, 0, 1); PG8_STAGE(PG8_SA(0, 0), a2, voffA);
            PG8_BAR; PG8_WAIT_L(0); PG8_MMA(1, 0, At, B0); PG8_BAR; PG8_SCHED;
            PG8_STAGE(PG8_SB(0, 1), b2 + hstepB, voffB);
            PG8_WAIT_V(6); PG8_BAR; PG8_MMA(1, 1, At, B1); PG8_BAR;
            PG8_LDB(B0, 1, 0); PG8_SCHED; PG8_LDA(At, 1, 0); PG8_STAGE(PG8_SA(0, 1), a2 + hstepA, voffA);
            PG8_WAIT_L(8); PG8_BAR; PG8_WAIT_L(0); PG8_MMA(0, 0, At, B0); PG8_BAR; PG8_SCHED;
            PG8_LDB(B1, 1, 1); PG8_STAGE(PG8_SB(1, 0), b3, voffB);
            PG8_BAR; PG8_WAIT_L(0); PG8_MMA(0, 1, At, B1); PG8_BAR;
            PG8_LDA(At, 1, 1); PG8_STAGE(PG8_SA(1, 0), a3, voffA);
            PG8_BAR; PG8_WAIT_L(0); PG8_MMA(1, 0, At, B0); PG8_BAR; PG8_SCHED;
            PG8_STAGE(PG8_SB(1, 1), b3 + hstepB, voffB);
            PG8_WAIT_V(6); PG8_BAR; PG8_MMA(1, 1, At, B1); PG8_BAR;
            }
        }
        if constexpr (ALIGN_EPI) { if (wr == 0) PG8_BAR; }
        if constexpr (!Epi::AFTER_DRAIN) { E(acc, cur, wr, wc, fr, fq); S.done(cur); }
        if (!has_next) break;
#pragma unroll
        for (int a = 0; a < 2; ++a)
#pragma unroll
            for (int b = 0; b < 2; ++b)
#pragma unroll
                for (int m = 0; m < 4; ++m)
#pragma unroll
                    for (int n = 0; n < 2; ++n) acc[a][b][m][n] = (f32x4){0.f, 0.f, 0.f, 0.f};
        cur = nxt; cA = nA; cB = nB; ++ui;
        if constexpr (ALIGN_EPI) { if (wr == 1) PG8_BAR; }
    }
    PG8_WAIT_V(0);
    if constexpr (!ALIGN_EPI) { if (wr == 0) PG8_BAR; }
    PG8_BAR;
    if constexpr (Epi::AFTER_DRAIN) { E.fused(acc, cur, wr, wc, fr, fq, lds, wid, lane); S.done(cur); }
#undef PG8_SA
#undef PG8_SB
#undef PG8_STAGE
#undef PG8_LDA
#undef PG8_LDB
#undef PG8_MMA
#undef PG8_WAIT_V
#undef PG8_WAIT_L
#undef PG8_BAR
#undef PG8_SCHED
}
}

namespace pg8 {
struct EpiF32Res {
    static constexpr bool PERM = false, AFTER_DRAIN = false;
    const float* base; float* out; int ldc;
    __device__ __forceinline__ void operator()(const f32x4 (&acc)[2][2][4][2], const Unit& u, int wr, int wc, int fr, int fq) const {
        const int col0 = u.pn * BM + wc * 32 + 4 * fq;
#pragma unroll
        for (int ai = 0; ai < 2; ++ai)
#pragma unroll
            for (int m = 0; m < 4; ++m) { const size_t off = (size_t)(u.pm * BM + ai * HALF + wr * 64 + m * 16 + fr) * ldc + col0;
#pragma unroll
                for (int bj = 0; bj < 2; ++bj)
#pragma unroll
                    for (int n = 0; n < 2; ++n) { const f32x4 bs = *(const f32x4*)(base + off + bj * HALF + n * 16); *(f32x4*)(out + off + bj * HALF + n * 16) = bs + acc[ai][bj][m][n]; } }
    }
};
}
#ifndef PG8_SP2
#define PG8_SP2 true
#endif
#ifndef PG8_ALIGN
#define PG8_ALIGN true
#endif

typedef unsigned v4u __attribute__((ext_vector_type(4)));
typedef float f32x4 __attribute__((ext_vector_type(4)));
#define GAS __attribute__((address_space(1)))
#define LDS_WAIT() asm volatile("s_waitcnt lgkmcnt(0)" ::: "memory")
__device__ __forceinline__ unsigned pk2(float lo, float hi) { return (unsigned)f2bf(lo) | ((unsigned)f2bf(hi) << 16); }
__device__ __forceinline__ void p0_transpose_item(const float* W, int ldw, int N, const float* kgain, bf16_t* WT, int ldt, int row_off, LAS float* scr, int item, int lane) {
    const int nblk = N / 32, kb = item / nblk, nb = item % nblk, k0 = 64 * kb, n0 = 32 * nb;
#pragma unroll 8
    for (int i = 0; i < 32; ++i) { const int kk = 2 * i + (lane >> 5); float v = W[(size_t)(k0 + kk) * ldw + n0 + (lane & 31)]; if (kgain) v *= kgain[k0 + kk]; scr[kk * 33 + (lane & 31)] = v; }
    LDS_WAIT(); asm volatile("" ::: "memory");
    const int c = lane & 7;
#pragma unroll
    for (int j = 0; j < 4; ++j) { const int n = (lane >> 3) + 8 * j; const LAS float* sp = scr + (8 * c) * 33 + n;
        v4u o; o.x = pk2(sp[0 * 33], sp[1 * 33]); o.y = pk2(sp[2 * 33], sp[3 * 33]); o.z = pk2(sp[4 * 33], sp[5 * 33]); o.w = pk2(sp[6 * 33], sp[7 * 33]);
        *(v4u*)(WT + (size_t)(row_off + n0 + n) * ldt + k0 + 8 * c) = o; }
    LDS_WAIT(); asm volatile("" ::: "memory");
}
__device__ __forceinline__ float wave_sum(float v) {
#pragma unroll
    for (int o = 1; o < 64; o <<= 1) v += __shfl_xor(v, o);
    return v;
}
__device__ __forceinline__ void rms_row_to_bf16(const float* xrow, bf16_t* orow, int lane) {
    const f32x4* xr = (const f32x4*)xrow + lane;
    f32x4 v[4]; float s = 0.f;
#pragma unroll
    for (int j = 0; j < 4; ++j) { v[j] = xr[64 * j]; s += (v[j].x * v[j].x + v[j].y * v[j].y) + (v[j].z * v[j].z + v[j].w * v[j].w); }
    const float rstd = rsqrtf(wave_sum(s) * (1.f / D) + 1e-6f);
    unsigned long long* o8 = (unsigned long long*)orow + lane;
#pragma unroll
    for (int j = 0; j < 4; ++j) o8[64 * j] = (unsigned long long)pk2(v[j].x * rstd, v[j].y * rstd) | ((unsigned long long)pk2(v[j].z * rstd, v[j].w * rstd) << 32);
}
constexpr int PW = 2304;
__device__ __forceinline__ void ph_prologue(LAS unsigned char* lds, const float* x, const float* w_in, const float* g_mix, const float* w_o, bf16_t* XN, bf16_t* W_in_t, bf16_t* W_o_t) {
    const int lane = threadIdx.x & 63, wave = threadIdx.x >> 6;
    LAS float* scr = (LAS float*)(lds + wave * 16384);
    const int gw = blockIdx.x * 8 + wave, NGW = gridDim.x * 8;
    constexpr int I_IN = (D / 64) * (INW / 32), I_O = (D / 64) * (D / 32);
    for (int it = gw; it < I_IN + I_O; it += NGW) {
        if (it < I_IN) p0_transpose_item(w_in, INW, INW, g_mix, W_in_t, D, 0, scr, it, lane);
        else p0_transpose_item(w_o, D, D, nullptr, W_o_t, D, 0, scr, it - I_IN, lane);
    }
    for (int i = blockIdx.x * NTHR + threadIdx.x; i < (PW - INW) * D / 8; i += gridDim.x * NTHR) ((v4u*)(W_in_t + (size_t)INW * D))[i] = (v4u){0u, 0u, 0u, 0u};
    for (int m = gw; m < T; m += NGW) rms_row_to_bf16(x + (size_t)m * D, XN + (size_t)m * D, lane);
}

struct Params {
    const float* x; const int* pos;
    const float *g_mix, *w_in, *g_cq, *w_uq, *g_ckv, *w_uk, *w_uv, *g_qn, *g_kn, *g_mla_out;
    const float *rw_mu, *rw_w0, *rw_w2, *rw_a0, *rw_a2, *rw_g2, *rw_k_k, *rw_k_a, *rw_r_k, *rw_lnx_g, *rw_lnx_b;
    const float *w_o, *g_ffn, *w_group, *b_group, *w_expert, *b_expert, *w_gate, *w_up, *w_down;
    float* out; unsigned char* ws;
    int ph_lo, ph_hi;
};
constexpr size_t MiB = 1u << 20;
constexpr size_t WS_CTL = 0, CTL_ZERO_BYTES = 1 * MiB;
constexpr size_t WS_SMALL = 1 * MiB;
constexpr size_t WS_PROJ = 4 * MiB;
constexpr size_t WS_MIX = 148 * MiB;
constexpr size_t WS_RX = 212 * MiB;
constexpr size_t WS_WO = 502 * MiB;
constexpr int CW_BAR = 4096;

template <class TI> __device__ __forceinline__ void ph_rowstat(const TI* in, int ld, int col0, int n, float eps, float* rstd) {
    const int lane = threadIdx.x & 63, gw = blockIdx.x * 8 + (threadIdx.x >> 6), NGW = gridDim.x * 8;
    for (int row = gw; row < T; row += NGW) {
        const TI* p = in + (size_t)row * ld + col0;
        float s = 0.f;
        for (int c = lane; c < n; c += 64) { float v = ldf(p + c); s += v * v; }
        for (int o = 32; o > 0; o >>= 1) s += __shfl_xor(s, o);
        if (lane == 0) rstd[row] = rsqrtf(s / n + eps);
    }
}

template <class TA, class TC> __device__ __forceinline__ void ph_gemm(LAS unsigned char* lds, const TA* A, int lda, const float* rowscale, const float* kgain, const float* Bm, int ldb,
                                                                     TC* C, int ldc, int M, int N, int K, const float* R, int ldr) {
    const int sub = threadIdx.x >> 8, tid = threadIdx.x & 255, tx = tid % 16, ty = tid / 16;
    LAS float (*As)[68] = (LAS float (*)[68])(lds + sub * 16384);
    LAS float (*Bs)[68] = (LAS float (*)[68])(lds + sub * 16384 + 8192);
    const int ntn = (N + 63) / 64, ntiles = ntn * (M / 64);
    const int ar = tid / 4, ac = (tid % 4) * 4, br = tid / 16, bc = (tid % 16) * 4;
    for (int vb = blockIdx.x * 2 + sub; vb < ntiles; vb += gridDim.x * 2) {
        const int m0 = (vb / ntn) * 64, n0 = (vb % ntn) * 64;
        float acc[4][4];
        _Pragma("unroll") for (int i = 0; i < 4; ++i) _Pragma("unroll") for (int j = 0; j < 4; ++j) acc[i][j] = 0.f;
        const float rs = rowscale ? rowscale[m0 + ar] : 1.f;
        for (int k0 = 0; k0 < K; k0 += 16) {
            _Pragma("unroll") for (int i = 0; i < 4; ++i) { float v = ldf(A + (size_t)(m0 + ar) * lda + k0 + ac + i) * rs; if (kgain) v *= kgain[k0 + ac + i]; As[ac + i][ar] = v; }
            _Pragma("unroll") for (int i = 0; i < 4; ++i) { int n = n0 + bc + i; Bs[br][bc + i] = (n < N) ? Bm[(size_t)(k0 + br) * ldb + n] : 0.f; }
            __syncthreads();
            _Pragma("unroll") for (int k = 0; k < 16; ++k) {
                float a[4], b[4];
                _Pragma("unroll") for (int i = 0; i < 4; ++i) a[i] = As[k][ty * 4 + i];
                _Pragma("unroll") for (int j = 0; j < 4; ++j) b[j] = Bs[k][tx * 4 + j];
                _Pragma("unroll") for (int i = 0; i < 4; ++i) _Pragma("unroll") for (int j = 0; j < 4; ++j) acc[i][j] += a[i] * b[j];
            }
            __syncthreads();
        }
        _Pragma("unroll") for (int i = 0; i < 4; ++i) _Pragma("unroll") for (int j = 0; j < 4; ++j) {
            int m = m0 + ty * 4 + i, n = n0 + tx * 4 + j;
            if (n < N) { float v = acc[i][j]; if (R) v += R[(size_t)m * ldr + n]; stf(C + (size_t)m * ldc + n, v); }
        }
    }
}

__device__ __forceinline__ void ph_qk_prep(bf16_t* Q, const bf16_t* KNOPE, const bf16_t* PROJ, const int* pos, const float* g_qn, const float* g_kn, bf16_t* K) {
    for (int idx = blockIdx.x * NTHR + threadIdx.x; idx < T * H; idx += gridDim.x * NTHR) {
        const int t = idx / H, h = idx % H;
        const float p = (float)pos[t];
        bf16_t* qp = Q + (size_t)t * 768 + h * QK; bf16_t* kp = K + (size_t)t * 768 + h * QK;
        const bf16_t* knp = KNOPE + (size_t)t * 512 + h * NOPE; const bf16_t* krp = PROJ + (size_t)t * PW + 384;
        float sq = 0.f, sk = 0.f;
#pragma unroll 4
        for (int d = 0; d < QK; ++d) { float v = bf2f(qp[d]); sq += v * v; }
#pragma unroll 4
        for (int d = 0; d < NOPE; ++d) { float v = bf2f(knp[d]); sk += v * v; }
#pragma unroll 4
        for (int d = 0; d < ROPE; ++d) { float v = bf2f(krp[d]); sk += v * v; }
        const float rq = rsqrtf(sq / QK + 1e-6f), rk = rsqrtf(sk / QK + 1e-6f);
#pragma unroll 4
        for (int d = 0; d < NOPE; ++d) { qp[d] = f2bf(bf2f(qp[d]) * rq * g_qn[d]); kp[d] = f2bf(bf2f(knp[d]) * rk * g_kn[d]); }
#pragma unroll 1
        for (int i = 0; i < 16; ++i) {
            const float inv_freq = 1.0f / powf(10000.0f, (float)i / 16.0f);
            const float ang = p * inv_freq, c = cosf(ang), s = sinf(ang);
            float x1 = bf2f(qp[64 + i]) * rq * g_qn[64 + i], x2 = bf2f(qp[80 + i]) * rq * g_qn[80 + i];
            qp[64 + i] = f2bf(x1 * c - x2 * s); qp[80 + i] = f2bf(x2 * c + x1 * s);
            x1 = bf2f(krp[i]) * rk * g_kn[64 + i]; x2 = bf2f(krp[16 + i]) * rk * g_kn[80 + i];
            kp[64 + i] = f2bf(x1 * c - x2 * s); kp[80 + i] = f2bf(x2 * c + x1 * s);
        }
    }
}

__device__ __forceinline__ void ph_attn(LAS unsigned char* lds, const bf16_t* Q, const bf16_t* K, const bf16_t* V, bf16_t* O, int ldo) {
    const int lane = threadIdx.x & 63, wid = threadIdx.x >> 6;
    LAS float (*Ks)[QK] = (LAS float (*)[QK])(lds + wid * 16384);
    LAS float (*Vs)[VD] = (LAS float (*)[VD])(lds + wid * 16384 + 16 * QK * 4);
    const int ntask = (S / 64) * NB * H;
    for (int task = blockIdx.x * 8 + wid; task < ntask; task += gridDim.x * 8) {
        const int qt = (S / 64 - 1) - task / (NB * H), bh = task % (NB * H), b = bh / H, h = bh % H;
        const int qi = qt * 64 + lane; const size_t trow = (size_t)b * S + qi;
        float q[QK], o[VD];
        const float scale = 0.10206207261596577f;
        _Pragma("unroll") for (int d = 0; d < QK; ++d) q[d] = bf2f(Q[trow * 768 + h * QK + d]) * scale;
        _Pragma("unroll") for (int d = 0; d < VD; ++d) o[d] = 0.f;
        float m = -INFINITY, l = 0.f;
        const int nkt = (qt * 64 + 64) / 16;
        for (int kt = 0; kt < nkt; ++kt) {
            WAVE_SYNC();
            for (int i = lane; i < 16 * QK; i += 64) { int r = i / QK, c = i % QK; Ks[r][c] = bf2f(K[((size_t)b * S + kt * 16 + r) * 768 + h * QK + c]); }
            for (int i = lane; i < 16 * VD; i += 64) { int r = i / VD, c = i % VD; Vs[r][c] = bf2f(V[((size_t)b * S + kt * 16 + r) * 512 + h * VD + c]); }
            WAVE_SYNC();
#pragma unroll 1
            for (int j = 0; j < 16; ++j) {
                if (kt * 16 + j > qi) continue;
                float s = 0.f;
                _Pragma("unroll") for (int d = 0; d < QK; ++d) s += q[d] * Ks[j][d];
                const float mn = fmaxf(m, s), alpha = expf(m - mn), pe = expf(s - mn);
                l = l * alpha + pe;
                _Pragma("unroll") for (int d = 0; d < VD; ++d) o[d] = o[d] * alpha + pe * Vs[j][d];
                m = mn;
            }
        }
        float inv = 1.f / l;
        _Pragma("unroll") for (int d = 0; d < VD; ++d) O[trow * ldo + h * VD + d] = f2bf(o[d] * inv);
    }
}

__device__ __forceinline__ void ph_mla_norm(bf16_t* MIX, const float* g) {
    const int lane = threadIdx.x & 63, gw = blockIdx.x * 8 + (threadIdx.x >> 6), NGW = gridDim.x * 8;
    for (int row = gw; row < T; row += NGW) {
        bf16_t* p = MIX + (size_t)row * 1024;
        float v[8]; float s = 0.f;
        _Pragma("unroll") for (int i = 0; i < 8; ++i) { v[i] = bf2f(p[lane + 64 * i]); s += v[i] * v[i]; }
        for (int o = 32; o > 0; o >>= 1) s += __shfl_xor(s, o);
        float r = rsqrtf(s / 512.f + 1e-6f);
        _Pragma("unroll") for (int i = 0; i < 8; ++i) p[lane + 64 * i] = f2bf(v[i] * r * g[lane + 64 * i]);
    }
}

__device__ __forceinline__ void ph_rw_prep1(const bf16_t* PROJ, const float* mu, bf16_t* R, bf16_t* K1, bf16_t* V1, float* LIN) {
    const size_t total = (size_t)T * RWKV_IN;
    for (size_t idx = (size_t)blockIdx.x * NTHR + threadIdx.x; idx < total; idx += (size_t)gridDim.x * NTHR) {
        int t = (int)(idx / RWKV_IN), c = (int)(idx % RWKV_IN); int s = t % S;
        float f = bf2f(PROJ[(size_t)t * PW + MLA_IN + c]);
        float p = (s > 0) ? bf2f(PROJ[(size_t)(t - 1) * PW + MLA_IN + c]) : 0.f;
        float v = f + (p - f) * mu[c];
        if (c < 512) R[(size_t)t * 512 + c] = f2bf(v);
        else if (c < 1024) K1[(size_t)t * 512 + c - 512] = f2bf(v);
        else if (c < 1536) V1[(size_t)t * 512 + c - 1024] = f2bf(v);
        else if (c < 1600) LIN[(size_t)t * 256 + c - 1536] = tanhf(v);
        else if (c < 1664) LIN[(size_t)t * 256 + c - 1536] = v;
        else LIN[(size_t)t * 256 + c - 1536] = 1.f / (1.f + expf(-v));
    }
}

__device__ __forceinline__ void ph_rw_prep2(bf16_t* K1, const float* WPRE, const float* APRE, const float* w0, const float* a0, const float* k_k, const float* k_a,
                                            float* KK, float* BB, float* DEC) {
    for (int idx = blockIdx.x * NTHR + threadIdx.x; idx < T * RH; idx += gridDim.x * NTHR) {
        int t = idx / RH, h = idx % RH; size_t base = (size_t)t * 512 + h * 64;
        float ss = 0.f;
        for (int j = 0; j < 64; ++j) { float kv = bf2f(K1[base + j]) * k_k[h * 64 + j]; ss += kv * kv; }
        float inv = rsqrtf(ss + 1e-12f);
        for (int j = 0; j < 64; ++j) {
            int c = h * 64 + j;
            float kv = bf2f(K1[base + j]);
            float a = 1.f / (1.f + expf(-(a0[c] + APRE[base + j])));
            float z = w0[c] + WPRE[base + j];
            float w = -log1pf(expf(-z)) - 0.5f;
            float dec = expf(-expf(w));
            float kk = kv * k_k[c] * inv;
            KK[base + j] = kk; BB[base + j] = kk * a; DEC[base + j] = dec;
            K1[base + j] = f2bf(kv * (1.f + (a - 1.f) * k_a[c]));
        }
    }
}

__device__ __forceinline__ void ph_rw_scan(LAS unsigned char* lds, const bf16_t* R, const bf16_t* K1, const bf16_t* V1, const float* KK, const float* BB, const float* DEC, float* Y) {
    const int lane = threadIdx.x & 63, wid = threadIdx.x >> 6;
    const int bh = blockIdx.x * 8 + wid;
    if (bh >= NB * RH) return;
    LAS float (*sh)[5][64] = (LAS float (*)[5][64])(lds + wid * 4096);
    const int b = bh / RH, h = bh % RH;
    float st[64];
    _Pragma("unroll") for (int j = 0; j < 64; ++j) st[j] = 0.f;
    size_t base = ((size_t)b * S) * 512 + h * 64 + lane;
    float nr = bf2f(R[base]), nk = bf2f(K1[base]), nkk = KK[base], nb = BB[base], nd = DEC[base], nv = bf2f(V1[base]);
    for (int s = 0; s < S; ++s) {
        const int buf = s & 1;
        sh[buf][0][lane] = nr; sh[buf][1][lane] = nk; sh[buf][2][lane] = nkk; sh[buf][3][lane] = nb; sh[buf][4][lane] = nd;
        const float vv = nv;
        if (s + 1 < S) { size_t nb_ = base + (size_t)(s + 1) * 512; nr = bf2f(R[nb_]); nk = bf2f(K1[nb_]); nkk = KK[nb_]; nb = BB[nb_]; nd = DEC[nb_]; nv = bf2f(V1[nb_]); }
        WAVE_SYNC();
        float sa = 0.f;
        _Pragma("unroll") for (int j = 0; j < 64; ++j) sa += st[j] * sh[buf][2][j];
        sa = -sa;
        float y = 0.f;
        _Pragma("unroll") for (int j = 0; j < 64; ++j) { st[j] = st[j] * sh[buf][4][j] + sa * sh[buf][3][j] + vv * sh[buf][1][j]; y += st[j] * sh[buf][0][j]; }
        Y[((size_t)b * S + s) * 512 + h * 64 + lane] = y;
        WAVE_SYNC();
    }
}

__device__ __forceinline__ void ph_rw_post(const float* Y, const bf16_t* R, const bf16_t* K1, const bf16_t* V1, const float* G, const float* r_k, const float* lnx_g, const float* lnx_b, bf16_t* MIX) {
    for (int idx = blockIdx.x * NTHR + threadIdx.x; idx < T * RH; idx += gridDim.x * NTHR) {
        int t = idx / RH, h = idx % RH; size_t base = (size_t)t * 512 + h * 64;
        float mean = 0.f; for (int j = 0; j < 64; ++j) mean += Y[base + j]; mean /= 64.f;
        float var = 0.f; for (int j = 0; j < 64; ++j) { float d = Y[base + j] - mean; var += d * d; } var /= 64.f;
        float rs = rsqrtf(var + 64e-5f);
        float bonus = 0.f; for (int j = 0; j < 64; ++j) bonus += bf2f(R[base + j]) * bf2f(K1[base + j]) * r_k[h * 64 + j];
        for (int j = 0; j < 64; ++j) {
            int c = h * 64 + j;
            float y = (Y[base + j] - mean) * rs * lnx_g[c] + lnx_b[c] + bonus * bf2f(V1[base + j]);
            MIX[(size_t)t * 1024 + 512 + c] = f2bf(y * G[base + j]);
        }
    }
}

__device__ __forceinline__ void ph_route(const float* X1, const float* g_ffn, const float* w_group, const float* b_group, const float* w_expert, const float* b_expert, int* EID, float* EW, float* RSF) {
    const int lane = threadIdx.x & 63, gw = blockIdx.x * 8 + (threadIdx.x >> 6), NGW = gridDim.x * 8;
    for (int t = gw; t < T; t += NGW) {
        const float* x = X1 + (size_t)t * D;
        float ss = 0.f, acc[36];
        _Pragma("unroll") for (int i = 0; i < 36; ++i) acc[i] = 0.f;
        for (int k = lane; k < D; k += 64) {
            float v = x[k]; ss += v * v; float tv = v * g_ffn[k];
            _Pragma("unroll") for (int g = 0; g < 4; ++g) acc[g] += tv * w_group[k * 4 + g];
            _Pragma("unroll") for (int e = 0; e < 32; ++e) acc[4 + e] += tv * w_expert[k * 32 + e];
        }
        for (int o = 32; o > 0; o >>= 1) { ss += __shfl_xor(ss, o); _Pragma("unroll") for (int i = 0; i < 36; ++i) acc[i] += __shfl_xor(acc[i], o); }
        if (lane == 0) {
            float rs = rsqrtf(ss / D + 1e-6f);
            float gl[4]; int gs = 0; float gm = -INFINITY;
            _Pragma("unroll") for (int g = 0; g < 4; ++g) { gl[g] = acc[g] * rs + b_group[g]; if (gl[g] > gm) { gm = gl[g]; gs = g; } }
            float den = 0.f; _Pragma("unroll") for (int g = 0; g < 4; ++g) den += expf(gl[g] - gm);
            float gp = 1.f / den;
            float el[8];
            _Pragma("unroll") for (int e = 0; e < 8; ++e) { float v = acc[4 + e]; _Pragma("unroll") for (int g = 1; g < 4; ++g) v = (gs == g) ? acc[4 + g * 8 + e] : v; el[e] = v * rs + b_expert[gs * 8 + e]; }
            int i1 = 0; float v1 = el[0];
            _Pragma("unroll") for (int e = 1; e < 8; ++e) if (el[e] > v1) { v1 = el[e]; i1 = e; }
            int i2 = -1; float v2 = -INFINITY;
            _Pragma("unroll") for (int e = 0; e < 8; ++e) if (e != i1 && el[e] > v2) { v2 = el[e]; i2 = e; }
            float e2 = expf(v2 - v1); float w1 = 1.f / (1.f + e2), w2 = e2 / (1.f + e2);
            EID[t * 2] = gs * 8 + i1; EID[t * 2 + 1] = gs * 8 + i2; EW[t * 2] = w1 * gp; EW[t * 2 + 1] = w2 * gp; RSF[t] = rs;
        }
    }
}

__device__ __forceinline__ void ph_moe(LAS unsigned char* lds, float* OUT, const float* g_ffn, const float* RSF, const int* EID, const float* EW,
                                       const float* w_gate, const float* w_up, const float* w_down) {
    const int sub = threadIdx.x >> 8, j = threadIdx.x & 255;
    LAS float* tn = (LAS float*)(lds + sub * 8192);
    LAS float* hid = (LAS float*)(lds + sub * 8192 + 4096);
    for (int t = blockIdx.x * 2 + sub; t < T; t += gridDim.x * 2) {
        float* x = OUT + (size_t)t * D;
        const float rs = RSF[t];
        float xv[4];
        __syncthreads();
        _Pragma("unroll") for (int i = 0; i < 4; ++i) { xv[i] = x[j + 256 * i]; tn[j + 256 * i] = xv[i] * rs * g_ffn[j + 256 * i]; }
        float y[4] = {0.f, 0.f, 0.f, 0.f};
        for (int sl = 0; sl < 2; ++sl) {
            const int e = EID[t * 2 + sl]; const float w = EW[t * 2 + sl];
            __syncthreads();
            const float* wg = w_gate + (size_t)e * D * DE; const float* wu = w_up + (size_t)e * D * DE;
            float hg = 0.f, hu = 0.f;
            for (int k = 0; k < D; ++k) { float tv = tn[k]; hg += tv * wg[(size_t)k * DE + j]; hu += tv * wu[(size_t)k * DE + j]; }
            hid[j] = hg / (1.f + expf(-hg)) * hu;
            __syncthreads();
            const float* wd = w_down + (size_t)e * DE * D;
            float a[4] = {0.f, 0.f, 0.f, 0.f};
            for (int k = 0; k < DE; ++k) { float hv = hid[k]; _Pragma("unroll") for (int i = 0; i < 4; ++i) a[i] += hv * wd[(size_t)k * D + j + 256 * i]; }
            _Pragma("unroll") for (int i = 0; i < 4; ++i) y[i] += w * a[i];
        }
        _Pragma("unroll") for (int i = 0; i < 4; ++i) x[j + 256 * i] = xv[i] + y[i];
    }
}

constexpr int N_PHASES = 14;
__global__ void __launch_bounds__(NTHR, 2) mk_fwd(Params p) {
    extern __shared__ __attribute__((aligned(16))) unsigned char lds_raw[];
    LAS unsigned char* lds = (LAS unsigned char*)lds_raw;
    volatile LAS unsigned* MISC = (volatile LAS unsigned*)(lds + 131072 + 320);
    for (int u = threadIdx.x; u < (LDS_BYTES - 131072) / 4; u += NTHR) ((LAS unsigned*)(lds + 131072))[u] = 0u;
    __syncthreads();
    unsigned* ctl = (unsigned*)(p.ws + WS_CTL);
    XcdBarrier bar; bar.bar = ctl + CW_BAR; bar.x = 0; bar.st = nullptr;
    if (!MK_PER_PHASE) bar = xcd_barrier_post(ctl + CW_BAR, MISC + 8);
#define GRID_BAR() do { if (!MK_PER_PHASE) xcd_barrier(bar); } while (0)
#define IN(k) (p.ph_lo <= (k) && (k) < p.ph_hi)
#define BOTH(k) (IN(k) && IN((k) + 1))
    unsigned char* ws = p.ws;
    float* small = (float*)(ws + WS_SMALL);
    float* RS_X = small; float* RS_CQ = small + T; float* RS_CKV = small + 2 * T; float* RSF = small + 3 * T;
    float* EW = small + 4 * T; int* EID = (int*)(small + 6 * T);
    bf16_t* PROJ = (bf16_t*)(ws + WS_PROJ);
    bf16_t* MIX = (bf16_t*)(ws + WS_MIX);
    unsigned char* RX = ws + WS_RX;
    bf16_t* Qb = (bf16_t*)(RX); bf16_t* Kb = (bf16_t*)(RX + 48 * MiB); bf16_t* KN = (bf16_t*)(RX + 96 * MiB); bf16_t* Vb = (bf16_t*)(RX + 128 * MiB);
    bf16_t* Rb = (bf16_t*)(RX); bf16_t* K1 = (bf16_t*)(RX + 32 * MiB); bf16_t* V1 = (bf16_t*)(RX + 64 * MiB);
    float* KK = (float*)(RX + 96 * MiB); float* BB = (float*)(RX + 160 * MiB); float* DEC = (float*)(RX + 224 * MiB);
    float* LIN = p.out; float* G = p.out + (size_t)T * 256;
    float* WPRE = (float*)(ws + WS_PROJ); float* APRE = (float*)(ws + WS_PROJ + 64 * MiB); float* Y = (float*)(ws + WS_PROJ);

    bf16_t* XN = (bf16_t*)p.out; bf16_t* W_in_t = (bf16_t*)((unsigned char*)p.out + 64 * MiB); bf16_t* W_o_t = (bf16_t*)(ws + WS_WO);
    if (IN(0)) { ph_prologue(lds, p.x, p.w_in, p.g_mix, p.w_o, XN, W_in_t, W_o_t); if (BOTH(0)) GRID_BAR(); }
    if (IN(1)) {
        pg8::Gemm g{XN, W_in_t, T, PW, D, D, D}; pg8::StaticOrder So; So.init(T, PW, (int)gridDim.x, (int)blockIdx.x);
        pg8::EpiBf16<0> E{PROJ, PW, nullptr, 0, 0, 1.f};
        pg8::gemm_phase<pg8::EpiBf16<0>, pg8::StaticOrder, PG8_ALIGN, PG8_SP2>(lds, g, So, E);
        if (BOTH(1)) GRID_BAR(); }
    if (IN(2)) { ph_rowstat<bf16_t>(PROJ, PW, 0, QR, 1e-6f, RS_CQ); ph_rowstat<bf16_t>(PROJ, PW, QR, KVR, 1e-6f, RS_CKV); if (BOTH(2)) GRID_BAR(); }
    if (IN(3)) {
        ph_gemm<bf16_t, bf16_t>(lds, PROJ, PW, RS_CQ, p.g_cq, p.w_uq, 768, Qb, 768, T, 768, QR, nullptr, 0);
        ph_gemm<bf16_t, bf16_t>(lds, PROJ + QR, PW, RS_CKV, p.g_ckv, p.w_uk, 512, KN, 512, T, 512, KVR, nullptr, 0);
        ph_gemm<bf16_t, bf16_t>(lds, PROJ + QR, PW, RS_CKV, p.g_ckv, p.w_uv, 512, Vb, 512, T, 512, KVR, nullptr, 0);
        if (BOTH(3)) GRID_BAR(); }
    if (IN(4)) { ph_qk_prep(Qb, KN, PROJ, p.pos, p.g_qn, p.g_kn, Kb); if (BOTH(4)) GRID_BAR(); }
    if (IN(5)) { ph_attn(lds, Qb, Kb, Vb, MIX, 1024); if (BOTH(5)) GRID_BAR(); }
    if (IN(6)) { ph_mla_norm(MIX, p.g_mla_out); ph_rw_prep1(PROJ, p.rw_mu, Rb, K1, V1, LIN); if (BOTH(6)) GRID_BAR(); }
    if (IN(7)) {
        ph_gemm<float, float>(lds, LIN, 256, nullptr, nullptr, p.rw_w2, 512, WPRE, 512, T, 512, 64, nullptr, 0);
        ph_gemm<float, float>(lds, LIN + 64, 256, nullptr, nullptr, p.rw_a2, 512, APRE, 512, T, 512, 64, nullptr, 0);
        ph_gemm<float, float>(lds, LIN + 128, 256, nullptr, nullptr, p.rw_g2, 512, G, 512, T, 512, 128, nullptr, 0);
        if (BOTH(7)) GRID_BAR(); }
    if (IN(8)) { ph_rw_prep2(K1, WPRE, APRE, p.rw_w0, p.rw_a0, p.rw_k_k, p.rw_k_a, KK, BB, DEC); if (BOTH(8)) GRID_BAR(); }
    if (IN(9)) { ph_rw_scan(lds, Rb, K1, V1, KK, BB, DEC, Y); if (BOTH(9)) GRID_BAR(); }
    if (IN(10)) { ph_rw_post(Y, Rb, K1, V1, G, p.rw_r_k, p.rw_lnx_g, p.rw_lnx_b, MIX); if (BOTH(10)) GRID_BAR(); }
    if (IN(11)) {
        pg8::Gemm g{MIX, W_o_t, T, D, D, D, D}; pg8::StaticOrder So; So.init(T, D, (int)gridDim.x, (int)blockIdx.x);
        pg8::EpiF32Res E{p.x, p.out, D};
        pg8::gemm_phase<pg8::EpiF32Res, pg8::StaticOrder, PG8_ALIGN, PG8_SP2>(lds, g, So, E);
        if (BOTH(11)) GRID_BAR(); }
    if (IN(12)) { ph_route(p.out, p.g_ffn, p.w_group, p.b_group, p.w_expert, p.b_expert, EID, EW, RSF); if (BOTH(12)) GRID_BAR(); }
    if (IN(13)) { ph_moe(lds, p.out, p.g_ffn, RSF, EID, EW, p.w_gate, p.w_up, p.w_down); }
}

extern "C" void kernel_launch(void* const* d_in, const int* in_sizes, int n_in, void* d_out, int out_size, void* d_ws, size_t ws_size, hipStream_t stream) {
    static int grid = 0;
    if (grid == 0) {
        if (n_in != 32 || out_size != T * D || ws_size < 512 * MiB) { fprintf(stderr, "kernel_launch: unexpected shapes (n_in %d out %d ws %zu)\n", n_in, out_size, ws_size); grid = -1; return; }
        int dev = 0, cus = 0, per_cu = 0;
        if (hipGetDevice(&dev) != hipSuccess || hipDeviceGetAttribute(&cus, hipDeviceAttributeMultiprocessorCount, dev) != hipSuccess) { grid = -1; return; }
        if (hipFuncSetAttribute((const void*)mk_fwd, hipFuncAttributeMaxDynamicSharedMemorySize, LDS_BYTES) != hipSuccess) { fprintf(stderr, "kernel_launch: hipFuncSetAttribute failed\n"); grid = -1; return; }
        if (hipOccupancyMaxActiveBlocksPerMultiprocessor(&per_cu, (const void*)mk_fwd, NTHR, LDS_BYTES) != hipSuccess || per_cu < 1) { fprintf(stderr, "kernel_launch: occupancy query says %d blocks/CU\n", per_cu); grid = -1; (void)hipGetLastError(); return; }
        grid = cus;
    }
    if (grid < 0) return;
    (void)hipMemsetAsync((char*)d_ws + WS_CTL, 0, CTL_ZERO_BYTES, stream);
    Params p{};
    p.x = (const float*)d_in[0]; p.pos = (const int*)d_in[1];
    p.g_mix = (const float*)d_in[2]; p.w_in = (const float*)d_in[3]; p.g_cq = (const float*)d_in[4]; p.w_uq = (const float*)d_in[5];
    p.g_ckv = (const float*)d_in[6]; p.w_uk = (const float*)d_in[7]; p.w_uv = (const float*)d_in[8]; p.g_qn = (const float*)d_in[9];
    p.g_kn = (const float*)d_in[10]; p.g_mla_out = (const float*)d_in[11]; p.rw_mu = (const float*)d_in[12]; p.rw_w0 = (const float*)d_in[13];
    p.rw_w2 = (const float*)d_in[14]; p.rw_a0 = (const float*)d_in[15]; p.rw_a2 = (const float*)d_in[16]; p.rw_g2 = (const float*)d_in[17];
    p.rw_k_k = (const float*)d_in[18]; p.rw_k_a = (const float*)d_in[19]; p.rw_r_k = (const float*)d_in[20]; p.rw_lnx_g = (const float*)d_in[21];
    p.rw_lnx_b = (const float*)d_in[22]; p.w_o = (const float*)d_in[23]; p.g_ffn = (const float*)d_in[24]; p.w_group = (const float*)d_in[25];
    p.b_group = (const float*)d_in[26]; p.w_expert = (const float*)d_in[27]; p.b_expert = (const float*)d_in[28]; p.w_gate = (const float*)d_in[29];
    p.w_up = (const float*)d_in[30]; p.w_down = (const float*)d_in[31];
    p.out = (float*)d_out; p.ws = (unsigned char*)d_ws;
#if MK_PER_PHASE
    for (int k = 0; k < N_PHASES; ++k) { p.ph_lo = k; p.ph_hi = k + 1; hipLaunchKernelGGL(mk_fwd, dim3(grid), dim3(NTHR), LDS_BYTES, stream, p); }
#else
    p.ph_lo = 0; p.ph_hi = N_PHASES;
    hipLaunchKernelGGL(mk_fwd, dim3(grid), dim3(NTHR), LDS_BYTES, stream, p);
#endif
}
```

```cpp
#include <hip/hip_runtime.h>
#include <stdint.h>
#include <math.h>
#include <cstdio>

#ifndef MK_PER_PHASE
#define MK_PER_PHASE 0
#endif

typedef unsigned short bf16_t;
constexpr int NB = 4, S = 8192, D = 1024, T = NB * S;
constexpr int H = 8, NOPE = 64, ROPE = 32, QK = 96, VD = 64, MLAW = 512, QR = 256, KVR = 128;
constexpr int RH = 8, RN = 64, RW = 512;
constexpr int MLA_IN = 416, RWKV_IN = 1792, INW = 2208;
constexpr int NG = 4, EPG = 8, NE = 32, DE = 256;
constexpr int NTHR = 512, LDS_BYTES = 147456;

#define LAS __attribute__((address_space(3)))
#define WAVE_SYNC() asm volatile("s_waitcnt lgkmcnt(0)" ::: "memory")

__device__ __forceinline__ float bf2f(bf16_t v) { return __uint_as_float(((unsigned)v) << 16); }
__device__ __forceinline__ bf16_t f2bf(float f) { unsigned u = __float_as_uint(f); return (bf16_t)((u + 0x7fffu + ((u >> 16) & 1u)) >> 16); }
__device__ __forceinline__ float ldf(const float* p) { return *p; }
__device__ __forceinline__ float ldf(const bf16_t* p) { return bf2f(*p); }
__device__ __forceinline__ void stf(float* p, float v) { *p = v; }
__device__ __forceinline__ void stf(bf16_t* p, float v) { *p = f2bf(v); }

#define XB_TMO      128
#define XB_XCNT(j)  (256  + 64 * (j))
#define XB_XSUB(j)  (1280 + 64 * (j))
#define XB_XGEN(j)  (2304 + 64 * (j))
#define XB_TOP      3328
#define XB_TOPGEN   3392
#define XCD_BAR_WORDS 3456
#define XB_SPIN_CAP (1u << 18)
__device__ __forceinline__ unsigned xb_ld(unsigned* p)              { return __hip_atomic_load(p, __ATOMIC_RELAXED, __HIP_MEMORY_SCOPE_AGENT); }
__device__ __forceinline__ unsigned xb_add(unsigned* p, unsigned v) { return __hip_atomic_fetch_add(p, v, __ATOMIC_RELAXED, __HIP_MEMORY_SCOPE_AGENT); }
__device__ __forceinline__ unsigned xb_xcc_id() { return (unsigned)__builtin_amdgcn_s_getreg((3 << 11) | 20) & 0xFu; }
#define XB_SPIN(cond, bar) do { unsigned _sp = 0; while (cond) { __builtin_amdgcn_s_sleep(1); \
    if ((++_sp & 255u) == 0u) { if (xb_ld(&(bar)[XB_TMO])) break; if (_sp > XB_SPIN_CAP) { atomicAdd(&(bar)[XB_TMO], 1u); break; } } } } while (0)
struct XcdBarrier { unsigned* bar; unsigned x; volatile LAS unsigned* st; };
__device__ __forceinline__ XcdBarrier xcd_barrier_post(unsigned* bar, volatile LAS unsigned* st) {
    XcdBarrier b; b.bar = bar; b.x = xb_xcc_id(); b.st = st;
    if (threadIdx.x == 0) (void)xb_add(&bar[XB_XCNT(b.x)], 1u);
    return b;
}
__device__ __forceinline__ void xcd_barrier_complete(unsigned* bar, unsigned x, unsigned& nloc, unsigned& nx) {
    const unsigned G = gridDim.x * gridDim.y * gridDim.z;
    unsigned sum, cnt, mine, sp = 0u;
    for (;;) {
        sum = 0u; cnt = 0u; mine = 0u;
#pragma unroll
        for (unsigned j = 0; j < 16; ++j) { const unsigned c = xb_ld(&bar[XB_XCNT(j)]); sum += c; cnt += (c > 0u) ? 1u : 0u; mine = (j == x) ? c : mine; }
        if (sum == G) break;
        __builtin_amdgcn_s_sleep(1);
        if ((++sp & 255u) == 0u) { if (xb_ld(&bar[XB_TMO])) break; if (sp > XB_SPIN_CAP) { atomicAdd(&bar[XB_TMO], 1u); break; } }
    }
    nloc = mine > 0u ? mine : 1u; nx = cnt > 0u ? cnt : 1u;
}
__device__ __forceinline__ void xcd_barrier(const XcdBarrier& b) {
    asm volatile("s_waitcnt vmcnt(0)" ::: "memory");
    __syncthreads();
    if (threadIdx.x == 0) {
        unsigned* bar = b.bar;
        __builtin_amdgcn_s_waitcnt(0);
        unsigned nloc = b.st[0], nx = b.st[1];
        if (nloc == 0u) { xcd_barrier_complete(bar, b.x, nloc, nx); b.st[0] = nloc; b.st[1] = nx; }
        const unsigned old = xb_add(&bar[XB_XSUB(b.x)], 1u);
        const unsigned gen = old / nloc;
        if (old + 1u == (gen + 1u) * nloc) {
            __builtin_amdgcn_fence(__ATOMIC_RELEASE, "agent");
            asm volatile("s_waitcnt vmcnt(0)" ::: "memory");
            const unsigned og = xb_add(&bar[XB_TOP], 1u);
            const unsigned tg = og / nx;
            if (og + 1u == (tg + 1u) * nx) xb_add(&bar[XB_TOPGEN], 1u);
            else XB_SPIN(xb_ld(&bar[XB_TOPGEN]) == tg, bar);
            __builtin_amdgcn_fence(__ATOMIC_ACQUIRE, "agent");
            xb_add(&bar[XB_XGEN(b.x)], 1u);
            asm volatile("s_waitcnt vmcnt(0)" ::: "memory");
        } else {
            XB_SPIN(xb_ld(&bar[XB_XGEN(b.x)]) == gen, bar);
            __builtin_amdgcn_fence(__ATOMIC_ACQUIRE, "agent");
            asm volatile("s_waitcnt vmcnt(0)" ::: "memory");
        }
    }
    __syncthreads();
}

namespace pg8 {
#define PG8_LAS __attribute__((address_space(3)))
typedef unsigned short bf16_t;
typedef short bf16x8 __attribute__((ext_vector_type(8)));
typedef float f32x4 __attribute__((ext_vector_type(4)));
typedef unsigned u32x4 __attribute__((ext_vector_type(4)));
constexpr int BM = 256, BK = 64, HALF = 128, HTB = HALF * BK * 2  , STAGE_BYTES = 8 * HTB, NXCD = 8, WGM = 8;

__host__ __device__ __forceinline__ int lds_byte(int r, int c) { const int st = (r >> 4) * 2 + (c >> 5), rr = r & 15, cc = c & 31, ob = rr * 64 + cc * 2; return st * 1024 + (ob ^ (((ob >> 9) & 1) << 5)); }
__host__ __device__ __forceinline__ void stage_rc(int b, int& R, int& C) { const int st = b / 1024, sb = b % 1024, swz = sb ^ (((sb >> 9) & 1) << 5); R = (st >> 1) * 16 + swz / 64; C = (st & 1) * 32 + (swz % 64) / 2; }
__host__ __device__ __forceinline__ int perm32(int rho) { const int n = rho >> 4, i = rho & 15; return 8 * (i >> 2) + 4 * n + (i & 3); }

struct Unit { int pm, pn; };
struct Gemm { const bf16_t* A; const bf16_t* Bt; int M, N, K, lda, ldb; };

struct StaticOrder {
    int nM, nN, nwg, G, c;
    __host__ __device__ void init(int M, int N, int G_, int c_) { nM = M / BM; nN = N / BM; nwg = nM * nN; G = G_; c = c_; }
    __host__ __device__ bool next(int i, Unit& u) const {
        const long L = (long)i * G + c; if (L >= nwg) return false;
        int wgid = (int)L; { const int q = nwg / NXCD, r = nwg % NXCD, xcd = wgid % NXCD, off = wgid / NXCD; wgid = (xcd < r ? xcd * (q + 1) : r * (q + 1) + (xcd - r) * q) + off; }
        const int nig = WGM * nN, gid = wgid / nig, fm = gid * WGM, gsz = (nM - fm) < WGM ? (nM - fm) : WGM;
        u.pm = fm + ((wgid % nig) % gsz); u.pn = (wgid % nig) / gsz; return true;
    }
    __device__ __forceinline__ void a_ready(const Unit&) const {}
    __device__ __forceinline__ void done(const Unit&) const {}
};

__device__ __forceinline__ unsigned cvt_pk_bf16(float lo, float hi) { unsigned r; asm volatile("v_cvt_pk_bf16_f32 %0, %1, %2" : "=v"(r) : "v"(lo), "v"(hi)); return r; }
typedef float f32x2 __attribute__((ext_vector_type(2)));
__device__ __forceinline__ f32x2 gelu_pk(f32x2 v) {
    const f32x2 av = __builtin_elementwise_abs(v), d = av * 0.2316418882f + 1.0f;
    f32x2 t; t.x = __builtin_amdgcn_rcpf(d.x); t.y = __builtin_amdgcn_rcpf(d.y);
    f32x2 q = t * 0.5307027145f + (-0.7265760135f); q = q * t + 0.7107068705f; q = q * t + (-0.142248368f); q = q * t + 0.127414796f; q = q * t;
    const f32x2 s = (v * v) * (-0.72134752044f);
    f32x2 e; e.x = __builtin_amdgcn_exp2f(s.x); e.y = __builtin_amdgcn_exp2f(s.y);
    const f32x2 m = v * (q * e), r = v - m;
    f32x2 o; o.x = v.x < 0.f ? m.x : r.x; o.y = v.y < 0.f ? m.y : r.y; return o;
}

template <int ACT  > struct EpiBf16 {
    static constexpr bool PERM = true, AFTER_DRAIN = false; static_assert(ACT == 0 || ACT == 1, "EpiBf16: ACT is 0 (none) or 1 (gelu_pk)");
    bf16_t* O; int ldc; const float* bias; int split_cols; size_t split_stride; float scale0;
    __device__ __forceinline__ void operator()(const f32x4 (&acc)[2][2][4][2], const Unit& u, int wr, int wc, int fr, int fq) const {
        const int row0 = u.pm * BM + wr * 64 + fr; int colt = u.pn * BM; bf16_t* base = O;
        float sc = 1.f; if (split_cols) { const int t = colt / split_cols; base += (size_t)t * split_stride; colt -= t * split_cols; if (t == 0) sc = scale0; }
        const int col0 = colt + wc * 32 + 8 * fq, bcol0 = u.pn * BM + wc * 32 + 8 * fq;
        f32x4 bv[2][2];
#pragma unroll
        for (int bj = 0; bj < 2; ++bj)
#pragma unroll
            for (int n = 0; n < 2; ++n) bv[bj][n] = bias ? *(const f32x4*)(bias + bcol0 + bj * HALF + 4 * n) : (f32x4){0.f, 0.f, 0.f, 0.f};
#pragma unroll
        for (int ai = 0; ai < 2; ++ai)
#pragma unroll
            for (int m = 0; m < 4; ++m) { bf16_t* rowp = base + (size_t)(row0 + ai * HALF + m * 16) * ldc + col0;
#pragma unroll
                for (int bj = 0; bj < 2; ++bj) { f32x4 v0 = acc[ai][bj][m][0] + bv[bj][0], v1 = acc[ai][bj][m][1] + bv[bj][1];
                    if (ACT == 1) { f32x2 a = gelu_pk((f32x2){v0[0], v0[1]}), b = gelu_pk((f32x2){v0[2], v0[3]}), c = gelu_pk((f32x2){v1[0], v1[1]}), d = gelu_pk((f32x2){v1[2], v1[3]});
                        v0 = (f32x4){a.x, a.y, b.x, b.y}; v1 = (f32x4){c.x, c.y, d.x, d.y}; }
                    v0 = v0 * sc; v1 = v1 * sc; u32x4 w; w.x = cvt_pk_bf16(v0[0], v0[1]); w.y = cvt_pk_bf16(v0[2], v0[3]); w.z = cvt_pk_bf16(v1[0], v1[1]); w.w = cvt_pk_bf16(v1[2], v1[3]);
                    *(u32x4*)(rowp + bj * HALF) = w; } }
    }
};
template <class Epi, class Sched, bool ALIGN_EPI = false, bool SP2 = false>
__device__ __forceinline__ void gemm_phase(PG8_LAS unsigned char* lds, const Gemm g, const Sched& S, const Epi& E) {
    const int tid = threadIdx.x, wid = __builtin_amdgcn_readfirstlane(tid >> 6), lane = tid & 63, wr = wid >> 2, wc = wid & 3, fr = lane & 15, fq = lane >> 4;
    const int K = g.K, nt = K / BK;
    unsigned voffA[2], voffB[2];
#pragma unroll
    for (int i = 0; i < 2; ++i) { int R, C; stage_rc(tid * 16 + i * 8192, R, C); const int Rb = Epi::PERM ? ((R & ~31) + perm32(R & 31)) : R;
        voffA[i] = (unsigned)(R * g.lda + C) * 2u; voffB[i] = (unsigned)(Rb * g.ldb + C) * 2u; }
    const size_t kstep = (size_t)(BK * 2);
    const size_t hstepA = (size_t)HALF * g.lda * 2, hstepB = (size_t)HALF * g.ldb * 2;
    const size_t tstepA = 2 * hstepA, tstepB = 2 * hstepB;
    const unsigned ldsw = (unsigned)wid * 1024u;
    const int aoff = lds_byte(wr * 64 + fr, fq * 8), boff = lds_byte(wc * 32 + fr, fq * 8);
#define PG8_SA(b, h) (((b) * 2 + (h)) * HTB)
#define PG8_SB(b, h) ((4 + (b) * 2 + (h)) * HTB)
#define PG8_STAGE(bufoff, gbase, voff) do { _Pragma("unroll") for (int _i = 0; _i < 2; ++_i) \
        __builtin_amdgcn_global_load_lds((const unsigned*)((const char*)(gbase) + (voff)[_i]), (PG8_LAS unsigned*)(lds + (bufoff) + ldsw + _i * 8192), 16, 0, 0); } while (0)
#define PG8_LDA(dst, b, h) do { _Pragma("unroll") for (int m = 0; m < 4; ++m) _Pragma("unroll") for (int k = 0; k < 2; ++k) dst[m][k] = *(const PG8_LAS bf16x8*)(lds + PG8_SA(b, h) + aoff + m * 2048 + k * 1024); } while (0)
#define PG8_LDB(dst, b, h) do { _Pragma("unroll") for (int n = 0; n < 2; ++n) _Pragma("unroll") for (int k = 0; k < 2; ++k) dst[n][k] = *(const PG8_LAS bf16x8*)(lds + PG8_SB(b, h) + boff + n * 2048 + k * 1024); } while (0)
#define PG8_MMA(ai, bj, At, Bt) do { __builtin_amdgcn_s_setprio(1); _Pragma("unroll") for (int m = 0; m < 4; ++m) _Pragma("unroll") for (int n = 0; n < 2; ++n) _Pragma("unroll") for (int k = 0; k < 2; ++k) \
        acc[ai][bj][m][n] = __builtin_amdgcn_mfma_f32_16x16x32_bf16(Bt[n][k], At[m][k], acc[ai][bj][m][n], 0, 0, 0); __builtin_amdgcn_s_setprio(0); } while (0)
#define PG8_WAIT_V(n) asm volatile("s_waitcnt vmcnt(" #n ")" ::: "memory")
#define PG8_WAIT_L(n) asm volatile("s_waitcnt lgkmcnt(" #n ")" ::: "memory")
#define PG8_BAR __builtin_amdgcn_s_barrier()
#define PG8_SCHED __builtin_amdgcn_sched_barrier(0)
    Unit cur, nxt; int ui = 0;
    if (!S.next(0, cur)) return;
    f32x4 acc[2][2][4][2];
#pragma unroll
    for (int a = 0; a < 2; ++a)
#pragma unroll
        for (int b = 0; b < 2; ++b)
#pragma unroll
            for (int m = 0; m < 4; ++m)
#pragma unroll
                for (int n = 0; n < 2; ++n) acc[a][b][m][n] = (f32x4){0.f, 0.f, 0.f, 0.f};
    bf16x8 At[4][2], B0[2][2], B1[2][2];
    const char* cA = (const char*)g.A + (size_t)cur.pm * tstepA; const char* cB = (const char*)g.Bt + (size_t)cur.pn * tstepB;
    S.a_ready(cur);
    if constexpr (SP2) {
        PG8_STAGE(PG8_SB(0, 0), cB, voffB); PG8_STAGE(PG8_SB(0, 1), cB + hstepB, voffB); PG8_STAGE(PG8_SA(0, 0), cA, voffA); PG8_STAGE(PG8_SA(0, 1), cA + hstepA, voffA);
        if (wr == 1) PG8_BAR;
        PG8_WAIT_V(2); PG8_BAR;
        PG8_STAGE(PG8_SB(1, 0), cB + kstep, voffB); PG8_STAGE(PG8_SA(1, 0), cA + kstep, voffA); PG8_STAGE(PG8_SB(1, 1), cB + hstepB + kstep, voffB);
        PG8_WAIT_V(6); PG8_BAR;
    } else {
        PG8_STAGE(PG8_SB(0, 0), cB, voffB); PG8_STAGE(PG8_SA(0, 0), cA, voffA); PG8_STAGE(PG8_SB(0, 1), cB + hstepB, voffB); PG8_STAGE(PG8_SA(0, 1), cA + hstepA, voffA);
        if (wr == 1) PG8_BAR;
        PG8_WAIT_V(4); PG8_BAR;
        PG8_STAGE(PG8_SB(1, 0), cB + kstep, voffB); PG8_STAGE(PG8_SA(1, 0), cA + kstep, voffA); PG8_STAGE(PG8_SB(1, 1), cB + hstepB + kstep, voffB);
        PG8_WAIT_V(6); PG8_BAR;
    }
    for (;;) {
        const bool has_next = S.next(ui + 1, nxt);
        const char* nA = has_next ? (const char*)g.A + (size_t)nxt.pm * tstepA : cA; const char* nB = has_next ? (const char*)g.Bt + (size_t)nxt.pn * tstepB : cB;
        for (int t = 0; t < nt; t += 2) {
            const bool last = (t == nt - 2);
            const char* a1 = cA + (size_t)(t + 1) * kstep;
            const char* a2 = last ? nA : cA + (size_t)(t + 2) * kstep; const char* b2 = last ? nB : cB + (size_t)(t + 2) * kstep;
            const char* a3 = a2 + kstep; const char* b3 = b2 + kstep;
            if (last && has_next) S.a_ready(nxt);
            if constexpr (SP2) {
            PG8_LDB(B0, 0, 0); PG8_LDB(B1, 0, 1); PG8_SCHED; PG8_LDA(At, 0, 0); PG8_STAGE(PG8_SA(1, 1), a1 + hstepA, voffA);
            PG8_WAIT_V(8); PG8_WAIT_L(0); PG8_BAR; PG8_MMA(0, 0, At, B0); PG8_MMA(0, 1, At, B1); PG8_BAR; PG8_SCHED;
            PG8_LDA(At, 0, 1); PG8_STAGE(PG8_SB(0, 0), b2, voffB); PG8_STAGE(PG8_SB(0, 1), b2 + hstepB, voffB); PG8_STAGE(PG8_SA(0, 0), a2, voffA);
            PG8_WAIT_V(8); PG8_WAIT_L(0); PG8_BAR; PG8_MMA(1, 0, At, B0); PG8_MMA(1, 1, At, B1); PG8_BAR; PG8_SCHED;
            PG8_LDB(B0, 1, 0); PG8_LDB(B1, 1, 1); PG8_SCHED; PG8_LDA(At, 1, 0); PG8_STAGE(PG8_SA(0, 1), a2 + hstepA, voffA);
            PG8_WAIT_V(8); PG8_WAIT_L(0); PG8_BAR; PG8_MMA(0, 0, At, B0); PG8_MMA(0, 1, At, B1); PG8_BAR; PG8_SCHED;
            PG8_LDA(At, 1, 1); PG8_STAGE(PG8_SB(1, 0), b3, voffB); PG8_STAGE(PG8_SB(1, 1), b3 + hstepB, voffB); PG8_STAGE(PG8_SA(1, 0), a3, voffA);
            PG8_WAIT_V(8); PG8_WAIT_L(0); PG8_BAR; PG8_MMA(1, 0, At, B0); PG8_MMA(1, 1, At, B1); PG8_BAR; PG8_SCHED;
            } else {
            PG8_LDB(B0, 0, 0); PG8_SCHED; PG8_LDA(At, 0, 0); PG8_STAGE(PG8_SA(1, 1), a1 + hstepA, voffA);
            PG8_WAIT_L(8); PG8_BAR; PG8_WAIT_L(0); PG8_MMA(0, 0, At, B0); PG8_BAR; PG8_SCHED;
            PG8_LDB(B1, 0, 1); PG8_STAGE(PG8_SB(0, 0), b2, voffB);
            PG8_BAR; PG8_WAIT_L(0); PG8_MMA(0, 1, At, B1); PG8_BAR;
            PG8_LDA(At, 0, 1); PG8_STAGE(PG8_SA(0, 0), a2, voffA);
            PG8_BAR; PG8_WAIT_L(0); PG8_MMA(1, 0, At, B0); PG8_BAR; PG8_SCHED;
            PG8_STAGE(PG8_SB(0, 1), b2 + hstepB, voffB);
            PG8_WAIT_V(6); PG8_BAR; PG8_MMA(1, 1, At, B1); PG8_BAR;
            PG8_LDB(B0, 1, 0); PG8_SCHED; PG8_LDA(At, 1, 0); PG8_STAGE(PG8_SA(0, 1), a2 + hstepA, voffA);
            PG8_WAIT_L(8); PG8_BAR; PG8_WAIT_L(0); PG8_MMA(0, 0, At, B0); PG8_BAR; PG8_SCHED;
            PG8_LDB(B1, 1, 1); PG8_STAGE(PG8_SB(1, 0), b3, voffB);
            PG8_BAR; PG8_WAIT_L(0); PG8_MMA(0, 1, At, B1); PG8_BAR;
            PG8_LDA(At, 1, 1); PG8_STAGE(PG8_SA(1, 0), a3, voffA);
            PG8_BAR; PG8_WAIT_L(0); PG8_MMA(1, 0, At, B0); PG8_BAR; PG8_SCHED;
            PG8_STAGE(PG8_SB(1, 1), b3 + hstepB, voffB);
            PG8_WAIT_V(6); PG8_BAR; PG8_MMA(1, 1, At, B1); PG8_BAR;
            }
        }
        if constexpr (ALIGN_EPI) { if (wr == 0) PG8_BAR; }
        if constexpr (!Epi::AFTER_DRAIN) { E(acc, cur, wr, wc, fr, fq); S.done(cur); }
        if (!has_next) break;
#pragma unroll
        for (int a = 0; a < 2; ++a)
#pragma unroll
            for (int b = 0; b < 2; ++b)
#pragma unroll
                for (int m = 0; m < 4; ++m)
#pragma unroll
                    for (int n = 0; n < 2; ++n) acc[a][b][m][n] = (f32x4){0.f, 0.f, 0.f, 0.f};
        cur = nxt; cA = nA; cB = nB; ++ui;
        if constexpr (ALIGN_EPI) { if (wr == 1) PG8_BAR; }
    }
    PG8_WAIT_V(0);
    if constexpr (!ALIGN_EPI) { if (wr == 0) PG8_BAR; }
    PG8_BAR;
    if constexpr (Epi::AFTER_DRAIN) { E.fused(acc, cur, wr, wc, fr, fq, lds, wid, lane); S.done(cur); }
#undef PG8_SA
#undef PG8_SB
#undef PG8_STAGE
#undef PG8_LDA
#undef PG8_LDB
#undef PG8_MMA
#undef PG8_WAIT_V
#undef PG8_WAIT_L
#undef PG8_BAR
#undef PG8_SCHED
}
}

namespace pg8 {
struct EpiF32Res {
    static constexpr bool PERM = false, AFTER_DRAIN = false;
    const float* base; float* out; int ldc;
    __device__ __forceinline__ void operator()(const f32x4 (&acc)[2][2][4][2], const Unit& u, int wr, int wc, int fr, int fq) const {
        const int col0 = u.pn * BM + wc * 32 + 4 * fq;
#pragma unroll
        for (int ai = 0; ai < 2; ++ai)
#pragma unroll
            for (int m = 0; m < 4; ++m) { const size_t off = (size_t)(u.pm * BM + ai * HALF + wr * 64 + m * 16 + fr) * ldc + col0;
#pragma unroll
                for (int bj = 0; bj < 2; ++bj)
#pragma unroll
                    for (int n = 0; n < 2; ++n) { const f32x4 bs = *(const f32x4*)(base + off + bj * HALF + n * 16); *(f32x4*)(out + off + bj * HALF + n * 16) = bs + acc[ai][bj][m][n]; } }
    }
};
}
#ifndef PG8_SP2
#define PG8_SP2 true
#endif
#ifndef PG8_ALIGN
#define PG8_ALIGN true
#endif

typedef unsigned v4u __attribute__((ext_vector_type(4)));
typedef float f32x4 __attribute__((ext_vector_type(4)));
#define GAS __attribute__((address_space(1)))
#define LDS_WAIT() asm volatile("s_waitcnt lgkmcnt(0)" ::: "memory")
__device__ __forceinline__ unsigned pk2(float lo, float hi) { return (unsigned)f2bf(lo) | ((unsigned)f2bf(hi) << 16); }
__device__ __forceinline__ void p0_transpose_item(const float* W, int ldw, int N, const float* kgain, bf16_t* WT, int ldt, int row_off, LAS float* scr, int item, int lane) {
    const int nblk = N / 32, kb = item / nblk, nb = item % nblk, k0 = 64 * kb, n0 = 32 * nb;
#pragma unroll 8
    for (int i = 0; i < 32; ++i) { const int kk = 2 * i + (lane >> 5); float v = W[(size_t)(k0 + kk) * ldw + n0 + (lane & 31)]; if (kgain) v *= kgain[k0 + kk]; scr[kk * 33 + (lane & 31)] = v; }
    LDS_WAIT(); asm volatile("" ::: "memory");
    const int c = lane & 7;
#pragma unroll
    for (int j = 0; j < 4; ++j) { const int n = (lane >> 3) + 8 * j; const LAS float* sp = scr + (8 * c) * 33 + n;
        v4u o; o.x = pk2(sp[0 * 33], sp[1 * 33]); o.y = pk2(sp[2 * 33], sp[3 * 33]); o.z = pk2(sp[4 * 33], sp[5 * 33]); o.w = pk2(sp[6 * 33], sp[7 * 33]);
        *(v4u*)(WT + (size_t)(row_off + n0 + n) * ldt + k0 + 8 * c) = o; }
    LDS_WAIT(); asm volatile("" ::: "memory");
}
__device__ __forceinline__ float wave_sum(float v) {
#pragma unroll
    for (int o = 1; o < 64; o <<= 1) v += __shfl_xor(v, o);
    return v;
}
__device__ __forceinline__ void rms_row_to_bf16(const float* xrow, bf16_t* orow, int lane) {
    const f32x4* xr = (const f32x4*)xrow + lane;
    f32x4 v[4]; float s = 0.f;
#pragma unroll
    for (int j = 0; j < 4; ++j) { v[j] = xr[64 * j]; s += (v[j].x * v[j].x + v[j].y * v[j].y) + (v[j].z * v[j].z + v[j].w * v[j].w); }
    const float rstd = rsqrtf(wave_sum(s) * (1.f / D) + 1e-6f);
    unsigned long long* o8 = (unsigned long long*)orow + lane;
#pragma unroll
    for (int j = 0; j < 4; ++j) o8[64 * j] = (unsigned long long)pk2(v[j].x * rstd, v[j].y * rstd) | ((unsigned long long)pk2(v[j].z * rstd, v[j].w * rstd) << 32);
}
constexpr int PW = 2304;
__device__ __forceinline__ void ph_prologue(LAS unsigned char* lds, const float* x, const float* w_in, const float* g_mix, const float* w_o, bf16_t* XN, bf16_t* W_in_t, bf16_t* W_o_t) {
    const int lane = threadIdx.x & 63, wave = threadIdx.x >> 6;
    LAS float* scr = (LAS float*)(lds + wave * 16384);
    const int gw = blockIdx.x * 8 + wave, NGW = gridDim.x * 8;
    constexpr int I_IN = (D / 64) * (INW / 32), I_O = (D / 64) * (D / 32);
    for (int it = gw; it < I_IN + I_O; it += NGW) {
        if (it < I_IN) p0_transpose_item(w_in, INW, INW, g_mix, W_in_t, D, 0, scr, it, lane);
        else p0_transpose_item(w_o, D, D, nullptr, W_o_t, D, 0, scr, it - I_IN, lane);
    }
    for (int i = blockIdx.x * NTHR + threadIdx.x; i < (PW - INW) * D / 8; i += gridDim.x * NTHR) ((v4u*)(W_in_t + (size_t)INW * D))[i] = (v4u){0u, 0u, 0u, 0u};
    for (int m = gw; m < T; m += NGW) rms_row_to_bf16(x + (size_t)m * D, XN + (size_t)m * D, lane);
}

namespace att {
typedef short bf16x8 __attribute__((ext_vector_type(8)));
typedef short s16x4 __attribute__((ext_vector_type(4)));
typedef float f32x16 __attribute__((ext_vector_type(16)));
typedef unsigned u32x4 __attribute__((ext_vector_type(4)));
constexpr int DQ = 96, DV = 64, QS = 768, KS = 768, VS = 512, OS = 1024;
constexpr float SCALE = 0.10206207261596577f;
constexpr float THR = 8.f;
constexpr int NW = 8, QBLK = 32, KVBLK = 64, QB = NW * QBLK, NQB = S / QB;
constexpr int SHM_V = 8192, SHM_K = 16384;
constexpr int LDS_BYTES = 2 * SHM_V + 2 * SHM_K + NW * 64 * 4;
#define KSWZ(row, colB) ((row) * 256 + ((colB) ^ (((row) & 7) << 4)))
#define SBAR() __builtin_amdgcn_sched_barrier(0)
__device__ __forceinline__ int v_st(int k, int c) { const int kk = (k & ~0xC) | ((k & 4) << 1) | ((k & 8) >> 1); return ((kk >> 3) * 2 + (c >> 5)) * 512 + ((kk & 7) * 32 + (c & 31)) * 2; }
__device__ __forceinline__ int v_rd_base(int lane) { return ((lane & 3) << 3) | (((lane >> 2) & 3) << 6) | (((lane >> 4) & 1) << 5) | (((lane >> 5) & 1) << 8); }
constexpr int v_rd_off(int d0, int ks, int half) { return d0 * 512 + ks * 2048 + half * 1024; }
__device__ __forceinline__ int crow(int r, int hi) { return (r & 3) + 8 * (r >> 2) + 4 * hi; }
__device__ __forceinline__ unsigned cvtpk(float lo, float hi) { unsigned r; asm volatile("v_cvt_pk_bf16_f32 %0, %1, %2" : "=v"(r) : "v"(lo), "v"(hi)); return r; }
__device__ __forceinline__ bf16x8 load8(const bf16_t* p) { return *reinterpret_cast<const bf16x8*>(p); }
__device__ __forceinline__ void mask_tile(f32x16& p0, f32x16& p1, int dq) {
    const float NEG = -__builtin_inff();
#pragma unroll
    for (int r = 0; r < 16; ++r) { const int c = (r & 3) + 8 * (r >> 2); if (dq - c < 0) p0[r] = NEG; if (dq - c - 32 < 0) p1[r] = NEG; }
}
__device__ __forceinline__ void partialSM(f32x16& p0, f32x16& p1, float& m_reg, float& mn, float& alpha) {
    float pmax = p0[0];
#pragma unroll
    for (int r = 1; r < 16; ++r) pmax = fmaxf(pmax, p0[r]);
#pragma unroll
    for (int r = 0; r < 16; ++r) pmax = fmaxf(pmax, p1[r]);
    { auto rr = __builtin_amdgcn_permlane32_swap(__float_as_uint(pmax), __float_as_uint(pmax), false, false); pmax = fmaxf(__uint_as_float(rr[0]), __uint_as_float(rr[1])); }
    constexpr float C2 = 1.4426950408889634f * SCALE;
    if (__builtin_expect(__all((pmax - m_reg) * SCALE <= THR), 1)) { mn = m_reg; alpha = 1.f; }
    else { mn = fmaxf(m_reg, pmax); alpha = __builtin_amdgcn_exp2f((m_reg - mn) * C2); m_reg = mn; }
    const float mnL = -mn * C2;
#pragma unroll
    for (int r = 0; r < 16; ++r) p0[r] = fmaf(p0[r], C2, mnL);
#pragma unroll
    for (int r = 0; r < 16; ++r) p1[r] = fmaf(p1[r], C2, mnL);
#pragma unroll
    for (int r = 0; r < 16; ++r) p0[r] = __builtin_amdgcn_exp2f(p0[r]);
}
__device__ __forceinline__ void finishSM(f32x16& p0, f32x16& p1, float alpha, float& l_reg, bf16x8& pa0, bf16x8& pa1, bf16x8& pa2, bf16x8& pa3) {
#pragma unroll
    for (int r = 0; r < 16; ++r) p1[r] = __builtin_amdgcn_exp2f(p1[r]);
    float ps = 0;
#pragma unroll
    for (int r = 0; r < 16; ++r) ps += p0[r];
#pragma unroll
    for (int r = 0; r < 16; ++r) ps += p1[r];
    { auto rr = __builtin_amdgcn_permlane32_swap(__float_as_uint(ps), __float_as_uint(ps), false, false); ps = __uint_as_float(rr[0]) + __uint_as_float(rr[1]); }
    l_reg = l_reg * alpha + ps;
#define PK4(P, B_, OUT) do { unsigned a0 = cvtpk(P[B_+0], P[B_+1]), a1 = cvtpk(P[B_+2], P[B_+3]); unsigned b0 = cvtpk(P[B_+4], P[B_+5]), b1 = cvtpk(P[B_+6], P[B_+7]); \
        auto r0 = __builtin_amdgcn_permlane32_swap(a0, b0, false, false); auto r1 = __builtin_amdgcn_permlane32_swap(a1, b1, false, false); \
        u32x4 w = {r0[0], r1[0], r0[1], r1[1]}; OUT = *reinterpret_cast<bf16x8*>(&w); } while (0)
    PK4(p0, 0, pa0); PK4(p0, 8, pa1); PK4(p1, 0, pa2); PK4(p1, 8, pa3);
#undef PK4
}
template <int KB>
__device__ __forceinline__ void qkt(f32x16& p0, f32x16& p1, const char* K_lds, int r32, int hi, const bf16x8* qr) {
    p0 = f32x16{}; p1 = f32x16{};
    const char* kb[4];
#pragma unroll
    for (int dd = 0; dd < 4; ++dd) kb[dd] = K_lds + KB * SHM_K + KSWZ(r32, (dd * 16 + hi * 8) * 2);
#pragma unroll
    for (int d0 = 0; d0 < 6; ++d0) { const char* a = kb[d0 & 3] + (d0 >> 2) * 128;
        bf16x8 b0 = *reinterpret_cast<const bf16x8*>(a);
        bf16x8 b1 = *reinterpret_cast<const bf16x8*>(a + 32 * 256);
        p0 = __builtin_amdgcn_mfma_f32_32x32x16_bf16(b0, qr[d0], p0, 0, 0, 0);
        p1 = __builtin_amdgcn_mfma_f32_32x32x16_bf16(b1, qr[d0], p1, 0, 0, 0); }
}
template <int VB>
__device__ __forceinline__ void pv_tile(f32x16* o, int vb0, bf16x8 pa0, bf16x8 pa1, bf16x8 pa2, bf16x8 pa3) {
#define TRRD(dst, off) asm volatile("ds_read_b64_tr_b16 %0, %1 offset:%2" : "=&v"(dst) : "v"(vb0), "i"(off) : "memory")
#define PV_D0(d0) do { s16x4 l0, l1, l2, l3, h0, h1, h2, h3; constexpr int b_ = VB * SHM_V + v_rd_off(d0, 0, 0); \
        TRRD(l0, b_); TRRD(h0, b_ + 1024); TRRD(l1, b_ + 2048); TRRD(h1, b_ + 3072); TRRD(l2, b_ + 4096); TRRD(h2, b_ + 5120); TRRD(l3, b_ + 6144); TRRD(h3, b_ + 7168); \
        asm volatile("s_waitcnt lgkmcnt(0)" ::: "memory"); SBAR(); \
        o[d0] = __builtin_amdgcn_mfma_f32_32x32x16_bf16(pa0, (bf16x8){l0[0], l0[1], l0[2], l0[3], h0[0], h0[1], h0[2], h0[3]}, o[d0], 0, 0, 0); \
        o[d0] = __builtin_amdgcn_mfma_f32_32x32x16_bf16(pa1, (bf16x8){l1[0], l1[1], l1[2], l1[3], h1[0], h1[1], h1[2], h1[3]}, o[d0], 0, 0, 0); \
        o[d0] = __builtin_amdgcn_mfma_f32_32x32x16_bf16(pa2, (bf16x8){l2[0], l2[1], l2[2], l2[3], h2[0], h2[1], h2[2], h2[3]}, o[d0], 0, 0, 0); \
        o[d0] = __builtin_amdgcn_mfma_f32_32x32x16_bf16(pa3, (bf16x8){l3[0], l3[1], l3[2], l3[3], h3[0], h3[1], h3[2], h3[3]}, o[d0], 0, 0, 0); } while (0)
    PV_D0(0); PV_D0(1);
#undef PV_D0
#undef TRRD
}
struct BlockRef { const bf16_t* Q; const bf16_t* K; const bf16_t* V; bf16_t* O; int P0; };
struct Seam { bf16x8 qr[6]; bf16x8 st_v0, st_k0, st_k1; };
#define VMW() asm volatile("s_waitcnt vmcnt(0)" ::: "memory")
#define VMWN(n) asm volatile("s_waitcnt vmcnt(%0)" :: "i"(n) : "memory")
#define SLOAD_H(Kp, Vp, k0) do { S.st_v0 = load8((Vp) + (size_t)((k0) + vr) * VS + vc); \
        S.st_k0 = load8((Kp) + (size_t)((k0) + sr) * KS + kc); S.st_k1 = load8((Kp) + (size_t)((k0) + 32 + sr) * KS + kc); } while (0)
#define SWRITE_HK(bf) do { *(bf16x8*)(K_lds + (bf) * SHM_K + kws) = S.st_k0; *(bf16x8*)(K_lds + (bf) * SHM_K + kws + 32 * 256) = S.st_k1; } while (0)
#define SWRITE_HV(bf) do { *(bf16x8*)(V_lds + (bf) * SHM_V + vst0) = S.st_v0; } while (0)
#define SWRITE_H(bf) do { SWRITE_HV(bf); SWRITE_HK(bf); } while (0)
#define STAGE_IDX() const int sr = tid >> 4, kc = ((tid & 15) < 12 ? (tid & 15) : 11) * 8, kws = KSWZ(sr, kc * 2), vr = tid >> 3, vc = (tid & 7) * 8, vst0 = v_st(vr, vc)
__device__ __forceinline__ void prime(const BlockRef& cur, char* lds, Seam& S) {
    const int tid = threadIdx.x, wid = __builtin_amdgcn_readfirstlane(tid >> 6), lane = tid & 63, r32 = lane & 31, hi = lane >> 5;
    STAGE_IDX(); (void)vst0; char* K_lds = lds + 2 * SHM_V;
#pragma unroll
    for (int d0 = 0; d0 < 6; ++d0) S.qr[d0] = load8(cur.Q + (size_t)(wid * QBLK + r32) * QS + d0 * 16 + hi * 8);
    SLOAD_H(cur.K, cur.V, 0); VMW(); SWRITE_HK(0);
    __syncthreads();
}
__device__ __forceinline__ void block(const BlockRef& cur, const BlockRef& nxt, char* lds, Seam& S) {
    const int tid = threadIdx.x, wid = __builtin_amdgcn_readfirstlane(tid >> 6), lane = tid & 63, r32 = lane & 31, hi = lane >> 5;
    const int NT = cur.P0 / KVBLK + QB / KVBLK;
    const int qlo = cur.P0 + wid * QBLK, qm = qlo + r32 - 4 * hi;
    char* V_lds = lds; char* K_lds = lds + 2 * SHM_V;
    float* wsf = (float*)(lds + 2 * SHM_V + 2 * SHM_K) + wid * 64; float* li_l = wsf, * al_l = wsf + 32;
    float m_reg = -1e30f, l_reg = 0; f32x16 o[2] = {};
    STAGE_IDX();
    const int vb0 = (int)(uintptr_t)V_lds + v_rd_base(lane);
    const bf16_t* Kh = cur.K; const bf16_t* Vh = cur.V;
#define RESC(a) do { if (__any((a) < 1.f)) { if (hi == 0) al_l[r32] = (a); asm volatile("s_waitcnt lgkmcnt(0)" ::: "memory"); \
                     _Pragma("unroll") for (int d_ = 0; d_ < 2; ++d_) _Pragma("unroll") for (int r = 0; r < 16; ++r) o[d_][r] *= al_l[crow(r, hi)]; } } while (0)
#define KBASE(t) ((t) * KVBLK)
#define MASKT(P0_, P1_, t) do { const int kb_ = KBASE(t); if (kb_ + KVBLK - 1 > qlo) mask_tile(P0_, P1_, qm - kb_); } while (0)
    constexpr int NQL = 6;
#define SEAM_K0() do { VMWN(NQL); SWRITE_HK(0); SBAR(); } while (0)
    f32x16 pA0, pA1, pB0, pB1; float mnA, mnB, alA, alB; bf16x8 pa0, pa1, pa2, pa3;
    SWRITE_HV(0); SBAR();
    if (NT > 1) SLOAD_H(Kh, Vh, KBASE(1));
    SBAR(); qkt<0>(pA0, pA1, K_lds, r32, hi, S.qr);
    MASKT(pA0, pA1, 0); partialSM(pA0, pA1, m_reg, mnA, alA);
    if (NT > 1) { VMW(); SWRITE_H(1); }
    __syncthreads();
#define HALF_STEP(PX0, PX1, mnX, alX, PY0, PY1, alY, t, KB, VB, SB) do { \
        SBAR(); qkt<KB>(PX0, PX1, K_lds, r32, hi, S.qr); \
        finishSM(PY0, PY1, alY, l_reg, pa0, pa1, pa2, pa3); SBAR(); \
        if ((t) + 1 < NT) { SLOAD_H(Kh, Vh, KBASE((t) + 1)); SBAR(); } \
        pv_tile<VB>(o, vb0, pa0, pa1, pa2, pa3); MASKT(PX0, PX1, (t)); partialSM(PX0, PX1, m_reg, mnX, alX); \
        __syncthreads(); \
        if ((t) + 1 < NT) { VMW(); SWRITE_H(SB); } \
        RESC(alX); __syncthreads(); } while (0)
    for (int t = 1; t + 1 < NT; t += 2) {
        HALF_STEP(pB0, pB1, mnB, alB, pA0, pA1, alA, t, 1, 0, 0);
        HALF_STEP(pA0, pA1, mnA, alA, pB0, pB1, alB, t + 1, 0, 1, 1);
    }
    const bool even = (NT & 1) == 0;
    if (even) { SBAR(); qkt<1>(pB0, pB1, K_lds, r32, hi, S.qr); SBAR(); }
    SLOAD_H(nxt.K, nxt.V, 0); SBAR();
#pragma unroll
    for (int d0 = 0; d0 < 6; ++d0) S.qr[d0] = load8(nxt.Q + (size_t)(wid * QBLK + r32) * QS + d0 * 16 + hi * 8);
    SBAR();
    finishSM(pA0, pA1, alA, l_reg, pa0, pa1, pa2, pa3); SBAR();
    pv_tile<0>(o, vb0, pa0, pa1, pa2, pa3);
    if (even) { MASKT(pB0, pB1, NT - 1); partialSM(pB0, pB1, m_reg, mnB, alB); __syncthreads(); RESC(alB);
        finishSM(pB0, pB1, alB, l_reg, pa0, pa1, pa2, pa3); SBAR(); pv_tile<1>(o, vb0, pa0, pa1, pa2, pa3); }
    SBAR(); SEAM_K0();
    if (hi == 0) li_l[r32] = l_reg; asm volatile("s_waitcnt lgkmcnt(0)" ::: "memory");
    float rli[16];
#pragma unroll
    for (int r = 0; r < 16; ++r) rli[r] = __builtin_amdgcn_rcpf(li_l[crow(r, hi)]);
    bf16_t* Ow = cur.O + (size_t)(wid * QBLK) * OS;
#pragma unroll
    for (int r = 0; r < 16; ++r) { const int orow = crow(r, hi);
#pragma unroll
        for (int d0 = 0; d0 < 2; ++d0) { const float v = o[d0][r] * rli[r];
            const float vn = __shfl_xor(v, 1);
            if ((r32 & 1) == 0) *(unsigned*)(Ow + (size_t)orow * OS + d0 * 32 + r32) = cvtpk(v, vn); } }
    __syncthreads();
#undef RESC
#undef KBASE
#undef MASKT
#undef SEAM_K0
#undef HALF_STEP
}
#undef VMW
#undef VMWN
#undef SLOAD_H
#undef SWRITE_HK
#undef SWRITE_HV
#undef SWRITE_H
#undef STAGE_IDX
__device__ __forceinline__ BlockRef ref_of(int L, int pass, const bf16_t* Q, const bf16_t* K, const bf16_t* V, bf16_t* O) {
    const int bh = L / (NQB / 2), x = L % (NQB / 2), qb = pass ? (NQB - 1 - x) : x, b = bh / H, h = bh % H;
    BlockRef r; const size_t row0 = (size_t)b * S;
    r.Q = Q + (row0 + (size_t)qb * QB) * QS + h * DQ; r.O = O + (row0 + (size_t)qb * QB) * OS + h * DV;
    r.K = K + row0 * KS + h * DQ; r.V = V + row0 * VS + h * DV; r.P0 = qb * QB;
    return r;
}
__device__ __forceinline__ void phase(char* lds, const bf16_t* Q, const bf16_t* K, const bf16_t* V, bf16_t* O) {
    const int G = gridDim.x, total = (NQB / 2) * NB * H;
    const int vcu = (G % 8 == 0) ? ((int)blockIdx.x % 8) * (G / 8) + (int)blockIdx.x / 8 : (int)blockIdx.x;
    int L = vcu; if (L >= total) return;
    int pass = 0;
    BlockRef cur = ref_of(L, 0, Q, K, V, O);
    Seam Sm;
    prime(cur, lds, Sm);
    for (;;) {
        const bool more_pass = pass == 0, more_item = L + G < total, last = !more_pass && !more_item;
        int passn = pass + 1, Ln = L;
        if (!more_pass) { passn = 0; Ln = more_item ? L + G : L; }
        const BlockRef nxt = last ? cur : ref_of(Ln, passn, Q, K, V, O);
        block(cur, nxt, lds, Sm);
        if (last) break;
        cur = nxt; pass = passn; L = Ln;
    }
}
#undef KSWZ
#undef SBAR
}

struct Params {
    const float* x; const int* pos;
    const float *g_mix, *w_in, *g_cq, *w_uq, *g_ckv, *w_uk, *w_uv, *g_qn, *g_kn, *g_mla_out;
    const float *rw_mu, *rw_w0, *rw_w2, *rw_a0, *rw_a2, *rw_g2, *rw_k_k, *rw_k_a, *rw_r_k, *rw_lnx_g, *rw_lnx_b;
    const float *w_o, *g_ffn, *w_group, *b_group, *w_expert, *b_expert, *w_gate, *w_up, *w_down;
    float* out; unsigned char* ws;
    int ph_lo, ph_hi;
};
constexpr size_t MiB = 1u << 20;
constexpr size_t WS_CTL = 0, CTL_ZERO_BYTES = 1 * MiB;
constexpr size_t WS_SMALL = 1 * MiB;
constexpr size_t WS_PROJ = 4 * MiB;
constexpr size_t WS_MIX = 148 * MiB;
constexpr size_t WS_RX = 212 * MiB;
constexpr size_t WS_WO = 502 * MiB;
constexpr int CW_BAR = 4096;

template <class TI> __device__ __forceinline__ void ph_rowstat(const TI* in, int ld, int col0, int n, float eps, float* rstd) {
    const int lane = threadIdx.x & 63, gw = blockIdx.x * 8 + (threadIdx.x >> 6), NGW = gridDim.x * 8;
    for (int row = gw; row < T; row += NGW) {
        const TI* p = in + (size_t)row * ld + col0;
        float s = 0.f;
        for (int c = lane; c < n; c += 64) { float v = ldf(p + c); s += v * v; }
        for (int o = 32; o > 0; o >>= 1) s += __shfl_xor(s, o);
        if (lane == 0) rstd[row] = rsqrtf(s / n + eps);
    }
}

template <class TA, class TC> __device__ __forceinline__ void ph_gemm(LAS unsigned char* lds, const TA* A, int lda, const float* rowscale, const float* kgain, const float* Bm, int ldb,
                                                                     TC* C, int ldc, int M, int N, int K, const float* R, int ldr) {
    const int sub = threadIdx.x >> 8, tid = threadIdx.x & 255, tx = tid % 16, ty = tid / 16;
    LAS float (*As)[68] = (LAS float (*)[68])(lds + sub * 16384);
    LAS float (*Bs)[68] = (LAS float (*)[68])(lds + sub * 16384 + 8192);
    const int ntn = (N + 63) / 64, ntiles = ntn * (M / 64);
    const int ar = tid / 4, ac = (tid % 4) * 4, br = tid / 16, bc = (tid % 16) * 4;
    for (int vb = blockIdx.x * 2 + sub; vb < ntiles; vb += gridDim.x * 2) {
        const int m0 = (vb / ntn) * 64, n0 = (vb % ntn) * 64;
        float acc[4][4];
        _Pragma("unroll") for (int i = 0; i < 4; ++i) _Pragma("unroll") for (int j = 0; j < 4; ++j) acc[i][j] = 0.f;
        const float rs = rowscale ? rowscale[m0 + ar] : 1.f;
        for (int k0 = 0; k0 < K; k0 += 16) {
            _Pragma("unroll") for (int i = 0; i < 4; ++i) { float v = ldf(A + (size_t)(m0 + ar) * lda + k0 + ac + i) * rs; if (kgain) v *= kgain[k0 + ac + i]; As[ac + i][ar] = v; }
            _Pragma("unroll") for (int i = 0; i < 4; ++i) { int n = n0 + bc + i; Bs[br][bc + i] = (n < N) ? Bm[(size_t)(k0 + br) * ldb + n] : 0.f; }
            __syncthreads();
            _Pragma("unroll") for (int k = 0; k < 16; ++k) {
                float a[4], b[4];
                _Pragma("unroll") for (int i = 0; i < 4; ++i) a[i] = As[k][ty * 4 + i];
                _Pragma("unroll") for (int j = 0; j < 4; ++j) b[j] = Bs[k][tx * 4 + j];
                _Pragma("unroll") for (int i = 0; i < 4; ++i) _Pragma("unroll") for (int j = 0; j < 4; ++j) acc[i][j] += a[i] * b[j];
            }
            __syncthreads();
        }
        _Pragma("unroll") for (int i = 0; i < 4; ++i) _Pragma("unroll") for (int j = 0; j < 4; ++j) {
            int m = m0 + ty * 4 + i, n = n0 + tx * 4 + j;
            if (n < N) { float v = acc[i][j]; if (R) v += R[(size_t)m * ldr + n]; stf(C + (size_t)m * ldc + n, v); }
        }
    }
}

__device__ __forceinline__ void ph_qk_prep(bf16_t* Q, const bf16_t* KNOPE, const bf16_t* PROJ, const int* pos, const float* g_qn, const float* g_kn, bf16_t* K) {
    for (int idx = blockIdx.x * NTHR + threadIdx.x; idx < T * H; idx += gridDim.x * NTHR) {
        const int t = idx / H, h = idx % H;
        const float p = (float)pos[t];
        bf16_t* qp = Q + (size_t)t * 768 + h * QK; bf16_t* kp = K + (size_t)t * 768 + h * QK;
        const bf16_t* knp = KNOPE + (size_t)t * 512 + h * NOPE; const bf16_t* krp = PROJ + (size_t)t * PW + 384;
        float sq = 0.f, sk = 0.f;
#pragma unroll 4
        for (int d = 0; d < QK; ++d) { float v = bf2f(qp[d]); sq += v * v; }
#pragma unroll 4
        for (int d = 0; d < NOPE; ++d) { float v = bf2f(knp[d]); sk += v * v; }
#pragma unroll 4
        for (int d = 0; d < ROPE; ++d) { float v = bf2f(krp[d]); sk += v * v; }
        const float rq = rsqrtf(sq / QK + 1e-6f), rk = rsqrtf(sk / QK + 1e-6f);
#pragma unroll 4
        for (int d = 0; d < NOPE; ++d) { qp[d] = f2bf(bf2f(qp[d]) * rq * g_qn[d]); kp[d] = f2bf(bf2f(knp[d]) * rk * g_kn[d]); }
#pragma unroll 1
        for (int i = 0; i < 16; ++i) {
            const float inv_freq = 1.0f / powf(10000.0f, (float)i / 16.0f);
            const float ang = p * inv_freq, c = cosf(ang), s = sinf(ang);
            float x1 = bf2f(qp[64 + i]) * rq * g_qn[64 + i], x2 = bf2f(qp[80 + i]) * rq * g_qn[80 + i];
            qp[64 + i] = f2bf(x1 * c - x2 * s); qp[80 + i] = f2bf(x2 * c + x1 * s);
            x1 = bf2f(krp[i]) * rk * g_kn[64 + i]; x2 = bf2f(krp[16 + i]) * rk * g_kn[80 + i];
            kp[64 + i] = f2bf(x1 * c - x2 * s); kp[80 + i] = f2bf(x2 * c + x1 * s);
        }
    }
}

__device__ __forceinline__ void ph_attn(LAS unsigned char* lds, const bf16_t* Q, const bf16_t* K, const bf16_t* V, bf16_t* O, int ldo) {
    const int lane = threadIdx.x & 63, wid = threadIdx.x >> 6;
    LAS float (*Ks)[QK] = (LAS float (*)[QK])(lds + wid * 16384);
    LAS float (*Vs)[VD] = (LAS float (*)[VD])(lds + wid * 16384 + 16 * QK * 4);
    const int ntask = (S / 64) * NB * H;
    for (int task = blockIdx.x * 8 + wid; task < ntask; task += gridDim.x * 8) {
        const int qt = (S / 64 - 1) - task / (NB * H), bh = task % (NB * H), b = bh / H, h = bh % H;
        const int qi = qt * 64 + lane; const size_t trow = (size_t)b * S + qi;
        float q[QK], o[VD];
        const float scale = 0.10206207261596577f;
        _Pragma("unroll") for (int d = 0; d < QK; ++d) q[d] = bf2f(Q[trow * 768 + h * QK + d]) * scale;
        _Pragma("unroll") for (int d = 0; d < VD; ++d) o[d] = 0.f;
        float m = -INFINITY, l = 0.f;
        const int nkt = (qt * 64 + 64) / 16;
        for (int kt = 0; kt < nkt; ++kt) {
            WAVE_SYNC();
            for (int i = lane; i < 16 * QK; i += 64) { int r = i / QK, c = i % QK; Ks[r][c] = bf2f(K[((size_t)b * S + kt * 16 + r) * 768 + h * QK + c]); }
            for (int i = lane; i < 16 * VD; i += 64) { int r = i / VD, c = i % VD; Vs[r][c] = bf2f(V[((size_t)b * S + kt * 16 + r) * 512 + h * VD + c]); }
            WAVE_SYNC();
#pragma unroll 1
            for (int j = 0; j < 16; ++j) {
                if (kt * 16 + j > qi) continue;
                float s = 0.f;
                _Pragma("unroll") for (int d = 0; d < QK; ++d) s += q[d] * Ks[j][d];
                const float mn = fmaxf(m, s), alpha = expf(m - mn), pe = expf(s - mn);
                l = l * alpha + pe;
                _Pragma("unroll") for (int d = 0; d < VD; ++d) o[d] = o[d] * alpha + pe * Vs[j][d];
                m = mn;
            }
        }
        float inv = 1.f / l;
        _Pragma("unroll") for (int d = 0; d < VD; ++d) O[trow * ldo + h * VD + d] = f2bf(o[d] * inv);
    }
}

__device__ __forceinline__ void ph_mla_norm(bf16_t* MIX, const float* g) {
    const int lane = threadIdx.x & 63, gw = blockIdx.x * 8 + (threadIdx.x >> 6), NGW = gridDim.x * 8;
    for (int row = gw; row < T; row += NGW) {
        bf16_t* p = MIX + (size_t)row * 1024;
        float v[8]; float s = 0.f;
        _Pragma("unroll") for (int i = 0; i < 8; ++i) { v[i] = bf2f(p[lane + 64 * i]); s += v[i] * v[i]; }
        for (int o = 32; o > 0; o >>= 1) s += __shfl_xor(s, o);
        float r = rsqrtf(s / 512.f + 1e-6f);
        _Pragma("unroll") for (int i = 0; i < 8; ++i) p[lane + 64 * i] = f2bf(v[i] * r * g[lane + 64 * i]);
    }
}

__device__ __forceinline__ void ph_rw_prep1(const bf16_t* PROJ, const float* mu, bf16_t* R, bf16_t* K1, bf16_t* V1, float* LIN) {
    const size_t total = (size_t)T * RWKV_IN;
    for (size_t idx = (size_t)blockIdx.x * NTHR + threadIdx.x; idx < total; idx += (size_t)gridDim.x * NTHR) {
        int t = (int)(idx / RWKV_IN), c = (int)(idx % RWKV_IN); int s = t % S;
        float f = bf2f(PROJ[(size_t)t * PW + MLA_IN + c]);
        float p = (s > 0) ? bf2f(PROJ[(size_t)(t - 1) * PW + MLA_IN + c]) : 0.f;
        float v = f + (p - f) * mu[c];
        if (c < 512) R[(size_t)t * 512 + c] = f2bf(v);
        else if (c < 1024) K1[(size_t)t * 512 + c - 512] = f2bf(v);
        else if (c < 1536) V1[(size_t)t * 512 + c - 1024] = f2bf(v);
        else if (c < 1600) LIN[(size_t)t * 256 + c - 1536] = tanhf(v);
        else if (c < 1664) LIN[(size_t)t * 256 + c - 1536] = v;
        else LIN[(size_t)t * 256 + c - 1536] = 1.f / (1.f + expf(-v));
    }
}

__device__ __forceinline__ void ph_rw_prep2(bf16_t* K1, const float* WPRE, const float* APRE, const float* w0, const float* a0, const float* k_k, const float* k_a,
                                            float* KK, float* BB, float* DEC) {
    for (int idx = blockIdx.x * NTHR + threadIdx.x; idx < T * RH; idx += gridDim.x * NTHR) {
        int t = idx / RH, h = idx % RH; size_t base = (size_t)t * 512 + h * 64;
        float ss = 0.f;
        for (int j = 0; j < 64; ++j) { float kv = bf2f(K1[base + j]) * k_k[h * 64 + j]; ss += kv * kv; }
        float inv = rsqrtf(ss + 1e-12f);
        for (int j = 0; j < 64; ++j) {
            int c = h * 64 + j;
            float kv = bf2f(K1[base + j]);
            float a = 1.f / (1.f + expf(-(a0[c] + APRE[base + j])));
            float z = w0[c] + WPRE[base + j];
            float w = -log1pf(expf(-z)) - 0.5f;
            float dec = expf(-expf(w));
            float kk = kv * k_k[c] * inv;
            KK[base + j] = kk; BB[base + j] = kk * a; DEC[base + j] = dec;
            K1[base + j] = f2bf(kv * (1.f + (a - 1.f) * k_a[c]));
        }
    }
}

__device__ __forceinline__ void ph_rw_scan(LAS unsigned char* lds, const bf16_t* R, const bf16_t* K1, const bf16_t* V1, const float* KK, const float* BB, const float* DEC, float* Y) {
    const int lane = threadIdx.x & 63, wid = threadIdx.x >> 6;
    const int bh = blockIdx.x * 8 + wid;
    if (bh >= NB * RH) return;
    LAS float (*sh)[5][64] = (LAS float (*)[5][64])(lds + wid * 4096);
    const int b = bh / RH, h = bh % RH;
    float st[64];
    _Pragma("unroll") for (int j = 0; j < 64; ++j) st[j] = 0.f;
    size_t base = ((size_t)b * S) * 512 + h * 64 + lane;
    float nr = bf2f(R[base]), nk = bf2f(K1[base]), nkk = KK[base], nb = BB[base], nd = DEC[base], nv = bf2f(V1[base]);
    for (int s = 0; s < S; ++s) {
        const int buf = s & 1;
        sh[buf][0][lane] = nr; sh[buf][1][lane] = nk; sh[buf][2][lane] = nkk; sh[buf][3][lane] = nb; sh[buf][4][lane] = nd;
        const float vv = nv;
        if (s + 1 < S) { size_t nb_ = base + (size_t)(s + 1) * 512; nr = bf2f(R[nb_]); nk = bf2f(K1[nb_]); nkk = KK[nb_]; nb = BB[nb_]; nd = DEC[nb_]; nv = bf2f(V1[nb_]); }
        WAVE_SYNC();
        float sa = 0.f;
        _Pragma("unroll") for (int j = 0; j < 64; ++j) sa += st[j] * sh[buf][2][j];
        sa = -sa;
        float y = 0.f;
        _Pragma("unroll") for (int j = 0; j < 64; ++j) { st[j] = st[j] * sh[buf][4][j] + sa * sh[buf][3][j] + vv * sh[buf][1][j]; y += st[j] * sh[buf][0][j]; }
        Y[((size_t)b * S + s) * 512 + h * 64 + lane] = y;
        WAVE_SYNC();
    }
}

__device__ __forceinline__ void ph_rw_post(const float* Y, const bf16_t* R, const bf16_t* K1, const bf16_t* V1, const float* G, const float* r_k, const float* lnx_g, const float* lnx_b, bf16_t* MIX) {
    for (int idx = blockIdx.x * NTHR + threadIdx.x; idx < T * RH; idx += gridDim.x * NTHR) {
        int t = idx / RH, h = idx % RH; size_t base = (size_t)t * 512 + h * 64;
        float mean = 0.f; for (int j = 0; j < 64; ++j) mean += Y[base + j]; mean /= 64.f;
        float var = 0.f; for (int j = 0; j < 64; ++j) { float d = Y[base + j] - mean; var += d * d; } var /= 64.f;
        float rs = rsqrtf(var + 64e-5f);
        float bonus = 0.f; for (int j = 0; j < 64; ++j) bonus += bf2f(R[base + j]) * bf2f(K1[base + j]) * r_k[h * 64 + j];
        for (int j = 0; j < 64; ++j) {
            int c = h * 64 + j;
            float y = (Y[base + j] - mean) * rs * lnx_g[c] + lnx_b[c] + bonus * bf2f(V1[base + j]);
            MIX[(size_t)t * 1024 + 512 + c] = f2bf(y * G[base + j]);
        }
    }
}

__device__ __forceinline__ void ph_route(const float* X1, const float* g_ffn, const float* w_group, const float* b_group, const float* w_expert, const float* b_expert, int* EID, float* EW, float* RSF) {
    const int lane = threadIdx.x & 63, gw = blockIdx.x * 8 + (threadIdx.x >> 6), NGW = gridDim.x * 8;
    for (int t = gw; t < T; t += NGW) {
        const float* x = X1 + (size_t)t * D;
        float ss = 0.f, acc[36];
        _Pragma("unroll") for (int i = 0; i < 36; ++i) acc[i] = 0.f;
        for (int k = lane; k < D; k += 64) {
            float v = x[k]; ss += v * v; float tv = v * g_ffn[k];
            _Pragma("unroll") for (int g = 0; g < 4; ++g) acc[g] += tv * w_group[k * 4 + g];
            _Pragma("unroll") for (int e = 0; e < 32; ++e) acc[4 + e] += tv * w_expert[k * 32 + e];
        }
        for (int o = 32; o > 0; o >>= 1) { ss += __shfl_xor(ss, o); _Pragma("unroll") for (int i = 0; i < 36; ++i) acc[i] += __shfl_xor(acc[i], o); }
        if (lane == 0) {
            float rs = rsqrtf(ss / D + 1e-6f);
            float gl[4]; int gs = 0; float gm = -INFINITY;
            _Pragma("unroll") for (int g = 0; g < 4; ++g) { gl[g] = acc[g] * rs + b_group[g]; if (gl[g] > gm) { gm = gl[g]; gs = g; } }
            float den = 0.f; _Pragma("unroll") for (int g = 0; g < 4; ++g) den += expf(gl[g] - gm);
            float gp = 1.f / den;
            float el[8];
            _Pragma("unroll") for (int e = 0; e < 8; ++e) { float v = acc[4 + e]; _Pragma("unroll") for (int g = 1; g < 4; ++g) v = (gs == g) ? acc[4 + g * 8 + e] : v; el[e] = v * rs + b_expert[gs * 8 + e]; }
            int i1 = 0; float v1 = el[0];
            _Pragma("unroll") for (int e = 1; e < 8; ++e) if (el[e] > v1) { v1 = el[e]; i1 = e; }
            int i2 = -1; float v2 = -INFINITY;
            _Pragma("unroll") for (int e = 0; e < 8; ++e) if (e != i1 && el[e] > v2) { v2 = el[e]; i2 = e; }
            float e2 = expf(v2 - v1); float w1 = 1.f / (1.f + e2), w2 = e2 / (1.f + e2);
            EID[t * 2] = gs * 8 + i1; EID[t * 2 + 1] = gs * 8 + i2; EW[t * 2] = w1 * gp; EW[t * 2 + 1] = w2 * gp; RSF[t] = rs;
        }
    }
}

__device__ __forceinline__ void ph_moe(LAS unsigned char* lds, float* OUT, const float* g_ffn, const float* RSF, const int* EID, const float* EW,
                                       const float* w_gate, const float* w_up, const float* w_down) {
    const int sub = threadIdx.x >> 8, j = threadIdx.x & 255;
    LAS float* tn = (LAS float*)(lds + sub * 8192);
    LAS float* hid = (LAS float*)(lds + sub * 8192 + 4096);
    for (int t = blockIdx.x * 2 + sub; t < T; t += gridDim.x * 2) {
        float* x = OUT + (size_t)t * D;
        const float rs = RSF[t];
        float xv[4];
        __syncthreads();
        _Pragma("unroll") for (int i = 0; i < 4; ++i) { xv[i] = x[j + 256 * i]; tn[j + 256 * i] = xv[i] * rs * g_ffn[j + 256 * i]; }
        float y[4] = {0.f, 0.f, 0.f, 0.f};
        for (int sl = 0; sl < 2; ++sl) {
            const int e = EID[t * 2 + sl]; const float w = EW[t * 2 + sl];
            __syncthreads();
            const float* wg = w_gate + (size_t)e * D * DE; const float* wu = w_up + (size_t)e * D * DE;
            float hg = 0.f, hu = 0.f;
            for (int k = 0; k < D; ++k) { float tv = tn[k]; hg += tv * wg[(size_t)k * DE + j]; hu += tv * wu[(size_t)k * DE + j]; }
            hid[j] = hg / (1.f + expf(-hg)) * hu;
            __syncthreads();
            const float* wd = w_down + (size_t)e * DE * D;
            float a[4] = {0.f, 0.f, 0.f, 0.f};
            for (int k = 0; k < DE; ++k) { float hv = hid[k]; _Pragma("unroll") for (int i = 0; i < 4; ++i) a[i] += hv * wd[(size_t)k * D + j + 256 * i]; }
            _Pragma("unroll") for (int i = 0; i < 4; ++i) y[i] += w * a[i];
        }
        _Pragma("unroll") for (int i = 0; i < 4; ++i) x[j + 256 * i] = xv[i] + y[i];
    }
}

constexpr int N_PHASES = 14;
__global__ void __launch_bounds__(NTHR, 2) mk_fwd(Params p) {
    extern __shared__ __attribute__((aligned(16))) unsigned char lds_raw[];
    LAS unsigned char* lds = (LAS unsigned char*)lds_raw;
    volatile LAS unsigned* MISC = (volatile LAS unsigned*)(lds + 131072 + 320);
    for (int u = threadIdx.x; u < (LDS_BYTES - 131072) / 4; u += NTHR) ((LAS unsigned*)(lds + 131072))[u] = 0u;
    __syncthreads();
    unsigned* ctl = (unsigned*)(p.ws + WS_CTL);
    XcdBarrier bar; bar.bar = ctl + CW_BAR; bar.x = 0; bar.st = nullptr;
    if (!MK_PER_PHASE) bar = xcd_barrier_post(ctl + CW_BAR, MISC + 8);
#define GRID_BAR() do { if (!MK_PER_PHASE) xcd_barrier(bar); } while (0)
#define IN(k) (p.ph_lo <= (k) && (k) < p.ph_hi)
#define BOTH(k) (IN(k) && IN((k) + 1))
    unsigned char* ws = p.ws;
    float* small = (float*)(ws + WS_SMALL);
    float* RS_X = small; float* RS_CQ = small + T; float* RS_CKV = small + 2 * T; float* RSF = small + 3 * T;
    float* EW = small + 4 * T; int* EID = (int*)(small + 6 * T);
    bf16_t* PROJ = (bf16_t*)(ws + WS_PROJ);
    bf16_t* MIX = (bf16_t*)(ws + WS_MIX);
    unsigned char* RX = ws + WS_RX;
    bf16_t* Qb = (bf16_t*)(RX); bf16_t* Kb = (bf16_t*)(RX + 48 * MiB); bf16_t* KN = (bf16_t*)(RX + 96 * MiB); bf16_t* Vb = (bf16_t*)(RX + 128 * MiB);
    bf16_t* Rb = (bf16_t*)(RX); bf16_t* K1 = (bf16_t*)(RX + 32 * MiB); bf16_t* V1 = (bf16_t*)(RX + 64 * MiB);
    float* KK = (float*)(RX + 96 * MiB); float* BB = (float*)(RX + 160 * MiB); float* DEC = (float*)(RX + 224 * MiB);
    float* LIN = p.out; float* G = p.out + (size_t)T * 256;
    float* WPRE = (float*)(ws + WS_PROJ); float* APRE = (float*)(ws + WS_PROJ + 64 * MiB); float* Y = (float*)(ws + WS_PROJ);

    bf16_t* XN = (bf16_t*)p.out; bf16_t* W_in_t = (bf16_t*)((unsigned char*)p.out + 64 * MiB); bf16_t* W_o_t = (bf16_t*)(ws + WS_WO);
    if (IN(0)) { ph_prologue(lds, p.x, p.w_in, p.g_mix, p.w_o, XN, W_in_t, W_o_t); if (BOTH(0)) GRID_BAR(); }
    if (IN(1)) {
        pg8::Gemm g{XN, W_in_t, T, PW, D, D, D}; pg8::StaticOrder So; So.init(T, PW, (int)gridDim.x, (int)blockIdx.x);
        pg8::EpiBf16<0> E{PROJ, PW, nullptr, 0, 0, 1.f};
        pg8::gemm_phase<pg8::EpiBf16<0>, pg8::StaticOrder, PG8_ALIGN, PG8_SP2>(lds, g, So, E);
        if (BOTH(1)) GRID_BAR(); }
    if (IN(2)) { ph_rowstat<bf16_t>(PROJ, PW, 0, QR, 1e-6f, RS_CQ); ph_rowstat<bf16_t>(PROJ, PW, QR, KVR, 1e-6f, RS_CKV); if (BOTH(2)) GRID_BAR(); }
    if (IN(3)) {
        ph_gemm<bf16_t, bf16_t>(lds, PROJ, PW, RS_CQ, p.g_cq, p.w_uq, 768, Qb, 768, T, 768, QR, nullptr, 0);
        ph_gemm<bf16_t, bf16_t>(lds, PROJ + QR, PW, RS_CKV, p.g_ckv, p.w_uk, 512, KN, 512, T, 512, KVR, nullptr, 0);
        ph_gemm<bf16_t, bf16_t>(lds, PROJ + QR, PW, RS_CKV, p.g_ckv, p.w_uv, 512, Vb, 512, T, 512, KVR, nullptr, 0);
        if (BOTH(3)) GRID_BAR(); }
    if (IN(4)) { ph_qk_prep(Qb, KN, PROJ, p.pos, p.g_qn, p.g_kn, Kb); if (BOTH(4)) GRID_BAR(); }
    if (IN(5)) { att::phase((char*)lds_raw, Qb, Kb, Vb, MIX); if (BOTH(5)) GRID_BAR(); }
    if (IN(6)) { ph_mla_norm(MIX, p.g_mla_out); ph_rw_prep1(PROJ, p.rw_mu, Rb, K1, V1, LIN); if (BOTH(6)) GRID_BAR(); }
    if (IN(7)) {
        ph_gemm<float, float>(lds, LIN, 256, nullptr, nullptr, p.rw_w2, 512, WPRE, 512, T, 512, 64, nullptr, 0);
        ph_gemm<float, float>(lds, LIN + 64, 256, nullptr, nullptr, p.rw_a2, 512, APRE, 512, T, 512, 64, nullptr, 0);
        ph_gemm<float, float>(lds, LIN + 128, 256, nullptr, nullptr, p.rw_g2, 512, G, 512, T, 512, 128, nullptr, 0);
        if (BOTH(7)) GRID_BAR(); }
    if (IN(8)) { ph_rw_prep2(K1, WPRE, APRE, p.rw_w0, p.rw_a0, p.rw_k_k, p.rw_k_a, KK, BB, DEC); if (BOTH(8)) GRID_BAR(); }
    if (IN(9)) { ph_rw_scan(lds, Rb, K1, V1, KK, BB, DEC, Y); if (BOTH(9)) GRID_BAR(); }
    if (IN(10)) { ph_rw_post(Y, Rb, K1, V1, G, p.rw_r_k, p.rw_lnx_g, p.rw_lnx_b, MIX); if (BOTH(10)) GRID_BAR(); }
    if (IN(11)) {
        pg8::Gemm g{MIX, W_o_t, T, D, D, D, D}; pg8::StaticOrder So; So.init(T, D, (int)gridDim.x, (int)blockIdx.x);
        pg8::EpiF32Res E{p.x, p.out, D};
        pg8::gemm_phase<pg8::EpiF32Res, pg8::StaticOrder, PG8_ALIGN, PG8_SP2>(lds, g, So, E);
        if (BOTH(11)) GRID_BAR(); }
    if (IN(12)) { ph_route(p.out, p.g_ffn, p.w_group, p.b_group, p.w_expert, p.b_expert, EID, EW, RSF); if (BOTH(12)) GRID_BAR(); }
    if (IN(13)) { ph_moe(lds, p.out, p.g_ffn, RSF, EID, EW, p.w_gate, p.w_up, p.w_down); }
}

extern "C" void kernel_launch(void* const* d_in, const int* in_sizes, int n_in, void* d_out, int out_size, void* d_ws, size_t ws_size, hipStream_t stream) {
    static int grid = 0;
    if (grid == 0) {
        if (n_in != 32 || out_size != T * D || ws_size < 512 * MiB) { fprintf(stderr, "kernel_launch: unexpected shapes (n_in %d out %d ws %zu)\n", n_in, out_size, ws_size); grid = -1; return; }
        int dev = 0, cus = 0, per_cu = 0;
        if (hipGetDevice(&dev) != hipSuccess || hipDeviceGetAttribute(&cus, hipDeviceAttributeMultiprocessorCount, dev) != hipSuccess) { grid = -1; return; }
        if (hipFuncSetAttribute((const void*)mk_fwd, hipFuncAttributeMaxDynamicSharedMemorySize, LDS_BYTES) != hipSuccess) { fprintf(stderr, "kernel_launch: hipFuncSetAttribute failed\n"); grid = -1; return; }
        if (hipOccupancyMaxActiveBlocksPerMultiprocessor(&per_cu, (const void*)mk_fwd, NTHR, LDS_BYTES) != hipSuccess || per_cu < 1) { fprintf(stderr, "kernel_launch: occupancy query says %d blocks/CU\n", per_cu); grid = -1; (void)hipGetLastError(); return; }
        grid = cus;
    }
    if (grid < 0) return;
    (void)hipMemsetAsync((char*)d_ws + WS_CTL, 0, CTL_ZERO_BYTES, stream);
    Params p{};
    p.x = (const float*)d_in[0]; p.pos = (const int*)d_in[1];
    p.g_mix = (const float*)d_in[2]; p.w_in = (const float*)d_in[3]; p.g_cq = (const float*)d_in[4]; p.w_uq = (const float*)d_in[5];
    p.g_ckv = (const float*)d_in[6]; p.w_uk = (const float*)d_in[7]; p.w_uv = (const float*)d_in[8]; p.g_qn = (const float*)d_in[9];
    p.g_kn = (const float*)d_in[10]; p.g_mla_out = (const float*)d_in[11]; p.rw_mu = (const float*)d_in[12]; p.rw_w0 = (const float*)d_in[13];
    p.rw_w2 = (const float*)d_in[14]; p.rw_a0 = (const float*)d_in[15]; p.rw_a2 = (const float*)d_in[16]; p.rw_g2 = (const float*)d_in[17];
    p.rw_k_k = (const float*)d_in[18]; p.rw_k_a = (const float*)d_in[19]; p.rw_r_k = (const float*)d_in[20]; p.rw_lnx_g = (const float*)d_in[21];
    p.rw_lnx_b = (const float*)d_in[22]; p.w_o = (const float*)d_in[23]; p.g_ffn = (const float*)d_in[24]; p.w_group = (const float*)d_in[25];
    p.b_group = (const float*)d_in[26]; p.w_expert = (const float*)d_in[27]; p.b_expert = (const float*)d_in[28]; p.w_gate = (const float*)d_in[29];
    p.w_up = (const float*)d_in[30]; p.w_down = (const float*)d_in[31];
    p.out = (float*)d_out; p.ws = (unsigned char*)d_ws;
#if MK_PER_PHASE
    for (int k = 0; k < N_PHASES; ++k) { p.ph_lo = k; p.ph_hi = k + 1; hipLaunchKernelGGL(mk_fwd, dim3(grid), dim3(NTHR), LDS_BYTES, stream, p); }
#else
    p.ph_lo = 0; p.ph_hi = N_PHASES;
    hipLaunchKernelGGL(mk_fwd, dim3(grid), dim3(NTHR), LDS_BYTES, stream, p);
#endif
}
```

```cpp
#include <hip/hip_runtime.h>
#include <stdint.h>
#include <math.h>
#include <cstdio>

#ifndef MK_PER_PHASE
#define MK_PER_PHASE 0
#endif

typedef unsigned short bf16_t;
constexpr int NB = 4, S = 8192, D = 1024, T = NB * S;
constexpr int H = 8, NOPE = 64, ROPE = 32, QK = 96, VD = 64, MLAW = 512, QR = 256, KVR = 128;
constexpr int RH = 8, RN = 64, RW = 512;
constexpr int MLA_IN = 416, RWKV_IN = 1792, INW = 2208;
constexpr int NG = 4, EPG = 8, NE = 32, DE = 256;
constexpr int NTHR = 512, LDS_BYTES = 147456;

#define LAS __attribute__((address_space(3)))
#define WAVE_SYNC() asm volatile("s_waitcnt lgkmcnt(0)" ::: "memory")

__device__ __forceinline__ float bf2f(bf16_t v) { return __uint_as_float(((unsigned)v) << 16); }
__device__ __forceinline__ bf16_t f2bf(float f) { unsigned u = __float_as_uint(f); return (bf16_t)((u + 0x7fffu + ((u >> 16) & 1u)) >> 16); }
__device__ __forceinline__ float ldf(const float* p) { return *p; }
__device__ __forceinline__ float ldf(const bf16_t* p) { return bf2f(*p); }
__device__ __forceinline__ void stf(float* p, float v) { *p = v; }
__device__ __forceinline__ void stf(bf16_t* p, float v) { *p = f2bf(v); }

#define XB_TMO      128
#define XB_XCNT(j)  (256  + 64 * (j))
#define XB_XSUB(j)  (1280 + 64 * (j))
#define XB_XGEN(j)  (2304 + 64 * (j))
#define XB_TOP      3328
#define XB_TOPGEN   3392
#define XCD_BAR_WORDS 3456
#define XB_SPIN_CAP (1u << 18)
__device__ __forceinline__ unsigned xb_ld(unsigned* p)              { return __hip_atomic_load(p, __ATOMIC_RELAXED, __HIP_MEMORY_SCOPE_AGENT); }
__device__ __forceinline__ unsigned xb_add(unsigned* p, unsigned v) { return __hip_atomic_fetch_add(p, v, __ATOMIC_RELAXED, __HIP_MEMORY_SCOPE_AGENT); }
__device__ __forceinline__ unsigned xb_xcc_id() { return (unsigned)__builtin_amdgcn_s_getreg((3 << 11) | 20) & 0xFu; }
#define XB_SPIN(cond, bar) do { unsigned _sp = 0; while (cond) { __builtin_amdgcn_s_sleep(1); \
    if ((++_sp & 255u) == 0u) { if (xb_ld(&(bar)[XB_TMO])) break; if (_sp > XB_SPIN_CAP) { atomicAdd(&(bar)[XB_TMO], 1u); break; } } } } while (0)
struct XcdBarrier { unsigned* bar; unsigned x; volatile LAS unsigned* st; };
__device__ __forceinline__ XcdBarrier xcd_barrier_post(unsigned* bar, volatile LAS unsigned* st) {
    XcdBarrier b; b.bar = bar; b.x = xb_xcc_id(); b.st = st;
    if (threadIdx.x == 0) (void)xb_add(&bar[XB_XCNT(b.x)], 1u);
    return b;
}
__device__ __forceinline__ void xcd_barrier_complete(unsigned* bar, unsigned x, unsigned& nloc, unsigned& nx) {
    const unsigned G = gridDim.x * gridDim.y * gridDim.z;
    unsigned sum, cnt, mine, sp = 0u;
    for (;;) {
        sum = 0u; cnt = 0u; mine = 0u;
#pragma unroll
        for (unsigned j = 0; j < 16; ++j) { const unsigned c = xb_ld(&bar[XB_XCNT(j)]); sum += c; cnt += (c > 0u) ? 1u : 0u; mine = (j == x) ? c : mine; }
        if (sum == G) break;
        __builtin_amdgcn_s_sleep(1);
        if ((++sp & 255u) == 0u) { if (xb_ld(&bar[XB_TMO])) break; if (sp > XB_SPIN_CAP) { atomicAdd(&bar[XB_TMO], 1u); break; } }
    }
    nloc = mine > 0u ? mine : 1u; nx = cnt > 0u ? cnt : 1u;
}
__device__ __forceinline__ void xcd_barrier(const XcdBarrier& b) {
    asm volatile("s_waitcnt vmcnt(0)" ::: "memory");
    __syncthreads();
    if (threadIdx.x == 0) {
        unsigned* bar = b.bar;
        __builtin_amdgcn_s_waitcnt(0);
        unsigned nloc = b.st[0], nx = b.st[1];
        if (nloc == 0u) { xcd_barrier_complete(bar, b.x, nloc, nx); b.st[0] = nloc; b.st[1] = nx; }
        const unsigned old = xb_add(&bar[XB_XSUB(b.x)], 1u);
        const unsigned gen = old / nloc;
        if (old + 1u == (gen + 1u) * nloc) {
            __builtin_amdgcn_fence(__ATOMIC_RELEASE, "agent");
            asm volatile("s_waitcnt vmcnt(0)" ::: "memory");
            const unsigned og = xb_add(&bar[XB_TOP], 1u);
            const unsigned tg = og / nx;
            if (og + 1u == (tg + 1u) * nx) xb_add(&bar[XB_TOPGEN], 1u);
            else XB_SPIN(xb_ld(&bar[XB_TOPGEN]) == tg, bar);
            __builtin_amdgcn_fence(__ATOMIC_ACQUIRE, "agent");
            xb_add(&bar[XB_XGEN(b.x)], 1u);
            asm volatile("s_waitcnt vmcnt(0)" ::: "memory");
        } else {
            XB_SPIN(xb_ld(&bar[XB_XGEN(b.x)]) == gen, bar);
            __builtin_amdgcn_fence(__ATOMIC_ACQUIRE, "agent");
            asm volatile("s_waitcnt vmcnt(0)" ::: "memory");
        }
    }
    __syncthreads();
}

namespace pg8 {
#define PG8_LAS __attribute__((address_space(3)))
typedef unsigned short bf16_t;
typedef short bf16x8 __attribute__((ext_vector_type(8)));
typedef float f32x4 __attribute__((ext_vector_type(4)));
typedef unsigned u32x4 __attribute__((ext_vector_type(4)));
constexpr int BM = 256, BK = 64, HALF = 128, HTB = HALF * BK * 2  , STAGE_BYTES = 8 * HTB, NXCD = 8, WGM = 8;

__host__ __device__ __forceinline__ int lds_byte(int r, int c) { const int st = (r >> 4) * 2 + (c >> 5), rr = r & 15, cc = c & 31, ob = rr * 64 + cc * 2; return st * 1024 + (ob ^ (((ob >> 9) & 1) << 5)); }
__host__ __device__ __forceinline__ void stage_rc(int b, int& R, int& C) { const int st = b / 1024, sb = b % 1024, swz = sb ^ (((sb >> 9) & 1) << 5); R = (st >> 1) * 16 + swz / 64; C = (st & 1) * 32 + (swz % 64) / 2; }
__host__ __device__ __forceinline__ int perm32(int rho) { const int n = rho >> 4, i = rho & 15; return 8 * (i >> 2) + 4 * n + (i & 3); }

struct Unit { int pm, pn; };
struct Gemm { const bf16_t* A; const bf16_t* Bt; int M, N, K, lda, ldb; };

struct StaticOrder {
    int nM, nN, nwg, G, c;
    __host__ __device__ void init(int M, int N, int G_, int c_) { nM = M / BM; nN = N / BM; nwg = nM * nN; G = G_; c = c_; }
    __host__ __device__ bool next(int i, Unit& u) const {
        const long L = (long)i * G + c; if (L >= nwg) return false;
        int wgid = (int)L; { const int q = nwg / NXCD, r = nwg % NXCD, xcd = wgid % NXCD, off = wgid / NXCD; wgid = (xcd < r ? xcd * (q + 1) : r * (q + 1) + (xcd - r) * q) + off; }
        const int nig = WGM * nN, gid = wgid / nig, fm = gid * WGM, gsz = (nM - fm) < WGM ? (nM - fm) : WGM;
        u.pm = fm + ((wgid % nig) % gsz); u.pn = (wgid % nig) / gsz; return true;
    }
    __device__ __forceinline__ void a_ready(const Unit&) const {}
    __device__ __forceinline__ void done(const Unit&) const {}
};

__device__ __forceinline__ unsigned cvt_pk_bf16(float lo, float hi) { unsigned r; asm volatile("v_cvt_pk_bf16_f32 %0, %1, %2" : "=v"(r) : "v"(lo), "v"(hi)); return r; }
typedef float f32x2 __attribute__((ext_vector_type(2)));
__device__ __forceinline__ f32x2 gelu_pk(f32x2 v) {
    const f32x2 av = __builtin_elementwise_abs(v), d = av * 0.2316418882f + 1.0f;
    f32x2 t; t.x = __builtin_amdgcn_rcpf(d.x); t.y = __builtin_amdgcn_rcpf(d.y);
    f32x2 q = t * 0.5307027145f + (-0.7265760135f); q = q * t + 0.7107068705f; q = q * t + (-0.142248368f); q = q * t + 0.127414796f; q = q * t;
    const f32x2 s = (v * v) * (-0.72134752044f);
    f32x2 e; e.x = __builtin_amdgcn_exp2f(s.x); e.y = __builtin_amdgcn_exp2f(s.y);
    const f32x2 m = v * (q * e), r = v - m;
    f32x2 o; o.x = v.x < 0.f ? m.x : r.x; o.y = v.y < 0.f ? m.y : r.y; return o;
}

template <int ACT  > struct EpiBf16 {
    static constexpr bool PERM = true, AFTER_DRAIN = false; static_assert(ACT == 0 || ACT == 1, "EpiBf16: ACT is 0 (none) or 1 (gelu_pk)");
    bf16_t* O; int ldc; const float* bias; int split_cols; size_t split_stride; float scale0;
    __device__ __forceinline__ void operator()(const f32x4 (&acc)[2][2][4][2], const Unit& u, int wr, int wc, int fr, int fq) const {
        const int row0 = u.pm * BM + wr * 64 + fr; int colt = u.pn * BM; bf16_t* base = O;
        float sc = 1.f; if (split_cols) { const int t = colt / split_cols; base += (size_t)t * split_stride; colt -= t * split_cols; if (t == 0) sc = scale0; }
        const int col0 = colt + wc * 32 + 8 * fq, bcol0 = u.pn * BM + wc * 32 + 8 * fq;
        f32x4 bv[2][2];
#pragma unroll
        for (int bj = 0; bj < 2; ++bj)
#pragma unroll
            for (int n = 0; n < 2; ++n) bv[bj][n] = bias ? *(const f32x4*)(bias + bcol0 + bj * HALF + 4 * n) : (f32x4){0.f, 0.f, 0.f, 0.f};
#pragma unroll
        for (int ai = 0; ai < 2; ++ai)
#pragma unroll
            for (int m = 0; m < 4; ++m) { bf16_t* rowp = base + (size_t)(row0 + ai * HALF + m * 16) * ldc + col0;
#pragma unroll
                for (int bj = 0; bj < 2; ++bj) { f32x4 v0 = acc[ai][bj][m][0] + bv[bj][0], v1 = acc[ai][bj][m][1] + bv[bj][1];
                    if (ACT == 1) { f32x2 a = gelu_pk((f32x2){v0[0], v0[1]}), b = gelu_pk((f32x2){v0[2], v0[3]}), c = gelu_pk((f32x2){v1[0], v1[1]}), d = gelu_pk((f32x2){v1[2], v1[3]});
                        v0 = (f32x4){a.x, a.y, b.x, b.y}; v1 = (f32x4){c.x, c.y, d.x, d.y}; }
                    v0 = v0 * sc; v1 = v1 * sc; u32x4 w; w.x = cvt_pk_bf16(v0[0], v0[1]); w.y = cvt_pk_bf16(v0[2], v0[3]); w.z = cvt_pk_bf16(v1[0], v1[1]); w.w = cvt_pk_bf16(v1[2], v1[3]);
                    *(u32x4*)(rowp + bj * HALF) = w; } }
    }
};
template <class Epi, class Sched, bool ALIGN_EPI, bool SP2, int KK, int LDA, int LDB>
__device__ __forceinline__ void gemm_phase(PG8_LAS unsigned char* lds, const Gemm g, const Sched& S, const Epi& E) {
    const int tid = threadIdx.x, wid = __builtin_amdgcn_readfirstlane(tid >> 6), lane = tid & 63, wr = wid >> 2, wc = wid & 3, fr = lane & 15, fq = lane >> 4;
    constexpr int K = KK, nt = K / BK; static_assert(nt % 2 == 0 && nt >= 2, "K must be a multiple of 128");
    unsigned voffA[2], voffB[2];
#pragma unroll
    for (int i = 0; i < 2; ++i) { int R, C; stage_rc(tid * 16 + i * 8192, R, C); const int Rb = Epi::PERM ? ((R & ~31) + perm32(R & 31)) : R;
        voffA[i] = (unsigned)(R * LDA + C) * 2u; voffB[i] = (unsigned)(Rb * LDB + C) * 2u; }
    constexpr size_t kstep = (size_t)(BK * 2);
    constexpr size_t hstepA = (size_t)HALF * LDA * 2, hstepB = (size_t)HALF * LDB * 2;
    constexpr size_t tstepA = 2 * hstepA, tstepB = 2 * hstepB;
    const unsigned ldsw = (unsigned)wid * 1024u;
    const int aoff = lds_byte(wr * 64 + fr, fq * 8), boff = lds_byte(wc * 32 + fr, fq * 8);
#define PG8_SA(b, h) (((b) * 2 + (h)) * HTB)
#define PG8_SB(b, h) ((4 + (b) * 2 + (h)) * HTB)
#define PG8_STAGE(bufoff, gbase, voff) do { _Pragma("unroll") for (int _i = 0; _i < 2; ++_i) \
        __builtin_amdgcn_global_load_lds((const unsigned*)((const char*)(gbase) + (voff)[_i]), (PG8_LAS unsigned*)(lds + (bufoff) + ldsw + _i * 8192), 16, 0, 0); } while (0)
#define PG8_LDA(dst, b, h) do { _Pragma("unroll") for (int m = 0; m < 4; ++m) _Pragma("unroll") for (int k = 0; k < 2; ++k) dst[m][k] = *(const PG8_LAS bf16x8*)(lds + PG8_SA(b, h) + aoff + m * 2048 + k * 1024); } while (0)
#define PG8_LDB(dst, b, h) do { _Pragma("unroll") for (int n = 0; n < 2; ++n) _Pragma("unroll") for (int k = 0; k < 2; ++k) dst[n][k] = *(const PG8_LAS bf16x8*)(lds + PG8_SB(b, h) + boff + n * 2048 + k * 1024); } while (0)
#define PG8_MMA(ai, bj, At, Bt) do { __builtin_amdgcn_s_setprio(1); _Pragma("unroll") for (int m = 0; m < 4; ++m) _Pragma("unroll") for (int n = 0; n < 2; ++n) _Pragma("unroll") for (int k = 0; k < 2; ++k) \
        acc[ai][bj][m][n] = __builtin_amdgcn_mfma_f32_16x16x32_bf16(Bt[n][k], At[m][k], acc[ai][bj][m][n], 0, 0, 0); __builtin_amdgcn_s_setprio(0); } while (0)
#define PG8_WAIT_V(n) asm volatile("s_waitcnt vmcnt(" #n ")" ::: "memory")
#define PG8_WAIT_L(n) asm volatile("s_waitcnt lgkmcnt(" #n ")" ::: "memory")
#define PG8_BAR __builtin_amdgcn_s_barrier()
#define PG8_SCHED __builtin_amdgcn_sched_barrier(0)
    Unit cur, nxt; int ui = 0;
    if (!S.next(0, cur)) return;
    f32x4 acc[2][2][4][2];
#pragma unroll
    for (int a = 0; a < 2; ++a)
#pragma unroll
        for (int b = 0; b < 2; ++b)
#pragma unroll
            for (int m = 0; m < 4; ++m)
#pragma unroll
                for (int n = 0; n < 2; ++n) acc[a][b][m][n] = (f32x4){0.f, 0.f, 0.f, 0.f};
    bf16x8 At[4][2], B0[2][2], B1[2][2];
    const char* cA = (const char*)g.A + (size_t)cur.pm * tstepA; const char* cB = (const char*)g.Bt + (size_t)cur.pn * tstepB;
    S.a_ready(cur);
    if constexpr (SP2) {
        PG8_STAGE(PG8_SB(0, 0), cB, voffB); PG8_STAGE(PG8_SB(0, 1), cB + hstepB, voffB); PG8_STAGE(PG8_SA(0, 0), cA, voffA); PG8_STAGE(PG8_SA(0, 1), cA + hstepA, voffA);
        if (wr == 1) PG8_BAR;
        PG8_WAIT_V(2); PG8_BAR;
        PG8_STAGE(PG8_SB(1, 0), cB + kstep, voffB); PG8_STAGE(PG8_SA(1, 0), cA + kstep, voffA); PG8_STAGE(PG8_SB(1, 1), cB + hstepB + kstep, voffB);
        PG8_WAIT_V(6); PG8_BAR;
    } else {
        PG8_STAGE(PG8_SB(0, 0), cB, voffB); PG8_STAGE(PG8_SA(0, 0), cA, voffA); PG8_STAGE(PG8_SB(0, 1), cB + hstepB, voffB); PG8_STAGE(PG8_SA(0, 1), cA + hstepA, voffA);
        if (wr == 1) PG8_BAR;
        PG8_WAIT_V(4); PG8_BAR;
        PG8_STAGE(PG8_SB(1, 0), cB + kstep, voffB); PG8_STAGE(PG8_SA(1, 0), cA + kstep, voffA); PG8_STAGE(PG8_SB(1, 1), cB + hstepB + kstep, voffB);
        PG8_WAIT_V(6); PG8_BAR;
    }
    for (;;) {
        const bool has_next = S.next(ui + 1, nxt);
        const char* nA = has_next ? (const char*)g.A + (size_t)nxt.pm * tstepA : cA; const char* nB = has_next ? (const char*)g.Bt + (size_t)nxt.pn * tstepB : cB;
_Pragma("unroll 1")
        for (int t = 0; t < nt; t += 2) {
            const bool last = (t == nt - 2);
            const char* a1 = cA + (size_t)(t + 1) * kstep;
            const char* a2 = last ? nA : cA + (size_t)(t + 2) * kstep; const char* b2 = last ? nB : cB + (size_t)(t + 2) * kstep;
            const char* a3 = a2 + kstep; const char* b3 = b2 + kstep;
            if (last && has_next) S.a_ready(nxt);
            if constexpr (SP2) {
            PG8_LDB(B0, 0, 0); PG8_LDB(B1, 0, 1); PG8_SCHED; PG8_LDA(At, 0, 0); PG8_STAGE(PG8_SA(1, 1), a1 + hstepA, voffA);
            PG8_WAIT_V(8); PG8_WAIT_L(0); PG8_BAR; PG8_MMA(0, 0, At, B0); PG8_MMA(0, 1, At, B1); PG8_BAR; PG8_SCHED;
            PG8_LDA(At, 0, 1); PG8_STAGE(PG8_SB(0, 0), b2, voffB); PG8_STAGE(PG8_SB(0, 1), b2 + hstepB, voffB); PG8_STAGE(PG8_SA(0, 0), a2, voffA);
            PG8_WAIT_V(8); PG8_WAIT_L(0); PG8_BAR; PG8_MMA(1, 0, At, B0); PG8_MMA(1, 1, At, B1); PG8_BAR; PG8_SCHED;
            PG8_LDB(B0, 1, 0); PG8_LDB(B1, 1, 1); PG8_SCHED; PG8_LDA(At, 1, 0); PG8_STAGE(PG8_SA(0, 1), a2 + hstepA, voffA);
            PG8_WAIT_V(8); PG8_WAIT_L(0); PG8_BAR; PG8_MMA(0, 0, At, B0); PG8_MMA(0, 1, At, B1); PG8_BAR; PG8_SCHED;
            PG8_LDA(At, 1, 1); PG8_STAGE(PG8_SB(1, 0), b3, voffB); PG8_STAGE(PG8_SB(1, 1), b3 + hstepB, voffB); PG8_STAGE(PG8_SA(1, 0), a3, voffA);
            PG8_WAIT_V(8); PG8_WAIT_L(0); PG8_BAR; PG8_MMA(1, 0, At, B0); PG8_MMA(1, 1, At, B1); PG8_BAR; PG8_SCHED;
            } else {
            PG8_LDB(B0, 0, 0); PG8_SCHED; PG8_LDA(At, 0, 0); PG8_STAGE(PG8_SA(1, 1), a1 + hstepA, voffA);
            PG8_WAIT_L(8); PG8_BAR; PG8_WAIT_L(0); PG8_MMA(0, 0, At, B0); PG8_BAR; PG8_SCHED;
            PG8_LDB(B1, 0, 1); PG8_STAGE(PG8_SB(0, 0), b2, voffB);
            PG8_BAR; PG8_WAIT_L(0); PG8_MMA(0, 1, At, B1); PG8_BAR;
            PG8_LDA(At, 0, 1); PG8_STAGE(PG8_SA(0, 0), a2, voffA);
            PG8_BAR; PG8_WAIT_L(0); PG8_MMA(1, 0, At, B0); PG8_BAR; PG8_SCHED;
            PG8_STAGE(PG8_SB(0, 1), b2 + hstepB, voffB);
            PG8_WAIT_V(6); PG8_BAR; PG8_MMA(1, 1, At, B1); PG8_BAR;
            PG8_LDB(B0, 1, 0); PG8_SCHED; PG8_LDA(At, 1, 0); PG8_STAGE(PG8_SA(0, 1), a2 + hstepA, voffA);
            PG8_WAIT_L(8); PG8_BAR; PG8_WAIT_L(0); PG8_MMA(0, 0, At, B0); PG8_BAR; PG8_SCHED;
            PG8_LDB(B1, 1, 1); PG8_STAGE(PG8_SB(1, 0), b3, voffB);
            PG8_BAR; PG8_WAIT_L(0); PG8_MMA(0, 1, At, B1); PG8_BAR;
            PG8_LDA(At, 1, 1); PG8_STAGE(PG8_SA(1, 0), a3, voffA);
            PG8_BAR; PG8_WAIT_L(0); PG8_MMA(1, 0, At, B0); PG8_BAR; PG8_SCHED;
            PG8_STAGE(PG8_SB(1, 1), b3 + hstepB, voffB);
            PG8_WAIT_V(6); PG8_BAR; PG8_MMA(1, 1, At, B1); PG8_BAR;
            }
        }
        if constexpr (ALIGN_EPI) { if (wr == 0) PG8_BAR; }
        if constexpr (!Epi::AFTER_DRAIN) { E(acc, cur, wr, wc, fr, fq); S.done(cur); }
        if (!has_next) break;
#pragma unroll
        for (int a = 0; a < 2; ++a)
#pragma unroll
            for (int b = 0; b < 2; ++b)
#pragma unroll
                for (int m = 0; m < 4; ++m)
#pragma unroll
                    for (int n = 0; n < 2; ++n) acc[a][b][m][n] = (f32x4){0.f, 0.f, 0.f, 0.f};
        cur = nxt; cA = nA; cB = nB; ++ui;
        if constexpr (ALIGN_EPI) { if (wr == 1) PG8_BAR; }
    }
    PG8_WAIT_V(0);
    if constexpr (!ALIGN_EPI) { if (wr == 0) PG8_BAR; }
    PG8_BAR;
    if constexpr (Epi::AFTER_DRAIN) { E.fused(acc, cur, wr, wc, fr, fq, lds, wid, lane); S.done(cur); }
#undef PG8_SA
#undef PG8_SB
#undef PG8_STAGE
#undef PG8_LDA
#undef PG8_LDB
#undef PG8_MMA
#undef PG8_WAIT_V
#undef PG8_WAIT_L
#undef PG8_BAR
#undef PG8_SCHED
}
}

namespace pg8 {
struct EpiF32Res {
    static constexpr bool PERM = false, AFTER_DRAIN = false;
    const float* base; float* out; int ldc;
    __device__ __forceinline__ void operator()(const f32x4 (&acc)[2][2][4][2], const Unit& u, int wr, int wc, int fr, int fq) const {
        const int col0 = u.pn * BM + wc * 32 + 4 * fq;
#pragma unroll
        for (int ai = 0; ai < 2; ++ai)
#pragma unroll
            for (int m = 0; m < 4; ++m) { const size_t off = (size_t)(u.pm * BM + ai * HALF + wr * 64 + m * 16 + fr) * ldc + col0;
#pragma unroll
                for (int bj = 0; bj < 2; ++bj)
#pragma unroll
                    for (int n = 0; n < 2; ++n) { const f32x4 bs = *(const f32x4*)(base + off + bj * HALF + n * 16); *(f32x4*)(out + off + bj * HALF + n * 16) = bs + acc[ai][bj][m][n]; } }
    }
};
}
#ifndef PG8_SP2
#define PG8_SP2 true
#endif
#ifndef PG8_ALIGN
#define PG8_ALIGN true
#endif

typedef unsigned v4u __attribute__((ext_vector_type(4)));
typedef float f32x4 __attribute__((ext_vector_type(4)));
#define GAS __attribute__((address_space(1)))
#define LDS_WAIT() asm volatile("s_waitcnt lgkmcnt(0)" ::: "memory")
__device__ __forceinline__ unsigned pk2(float lo, float hi) { return (unsigned)f2bf(lo) | ((unsigned)f2bf(hi) << 16); }
__device__ __forceinline__ void p0_transpose_item(const float* W, int ldw, int N, const float* kgain, bf16_t* WT, int ldt, int row_off, LAS float* scr, int item, int lane) {
    const int nblk = N / 32, kb = item / nblk, nb = item % nblk, k0 = 64 * kb, n0 = 32 * nb;
#pragma unroll 8
    for (int i = 0; i < 32; ++i) { const int kk = 2 * i + (lane >> 5); float v = W[(size_t)(k0 + kk) * ldw + n0 + (lane & 31)]; if (kgain) v *= kgain[k0 + kk]; scr[kk * 33 + (lane & 31)] = v; }
    LDS_WAIT(); asm volatile("" ::: "memory");
    const int c = lane & 7;
#pragma unroll
    for (int j = 0; j < 4; ++j) { const int n = (lane >> 3) + 8 * j; const LAS float* sp = scr + (8 * c) * 33 + n;
        v4u o; o.x = pk2(sp[0 * 33], sp[1 * 33]); o.y = pk2(sp[2 * 33], sp[3 * 33]); o.z = pk2(sp[4 * 33], sp[5 * 33]); o.w = pk2(sp[6 * 33], sp[7 * 33]);
        *(v4u*)(WT + (size_t)(row_off + n0 + n) * ldt + k0 + 8 * c) = o; }
    LDS_WAIT(); asm volatile("" ::: "memory");
}
__device__ __forceinline__ float wave_sum(float v) {
#pragma unroll
    for (int o = 1; o < 64; o <<= 1) v += __shfl_xor(v, o);
    return v;
}
__device__ __forceinline__ void rms_row_to_bf16(const float* xrow, bf16_t* orow, int lane) {
    const f32x4* xr = (const f32x4*)xrow + lane;
    f32x4 v[4]; float s = 0.f;
#pragma unroll
    for (int j = 0; j < 4; ++j) { v[j] = xr[64 * j]; s += (v[j].x * v[j].x + v[j].y * v[j].y) + (v[j].z * v[j].z + v[j].w * v[j].w); }
    const float rstd = rsqrtf(wave_sum(s) * (1.f / D) + 1e-6f);
    unsigned long long* o8 = (unsigned long long*)orow + lane;
#pragma unroll
    for (int j = 0; j < 4; ++j) o8[64 * j] = (unsigned long long)pk2(v[j].x * rstd, v[j].y * rstd) | ((unsigned long long)pk2(v[j].z * rstd, v[j].w * rstd) << 32);
}
constexpr int PW = 2304;
__device__ __forceinline__ void ph_prologue(LAS unsigned char* lds, const float* x, const float* w_in, const float* g_mix, const float* w_o, bf16_t* XN, bf16_t* W_in_t, bf16_t* W_o_t) {
    const int lane = threadIdx.x & 63, wave = threadIdx.x >> 6;
    LAS float* scr = (LAS float*)(lds + wave * 16384);
    const int gw = blockIdx.x * 8 + wave, NGW = gridDim.x * 8;
    constexpr int I_IN = (D / 64) * (INW / 32), I_O = (D / 64) * (D / 32);
    for (int it = gw; it < I_IN + I_O; it += NGW) {
        if (it < I_IN) p0_transpose_item(w_in, INW, INW, g_mix, W_in_t, D, 0, scr, it, lane);
        else p0_transpose_item(w_o, D, D, nullptr, W_o_t, D, 0, scr, it - I_IN, lane);
    }
    for (int i = blockIdx.x * NTHR + threadIdx.x; i < (PW - INW) * D / 8; i += gridDim.x * NTHR) ((v4u*)(W_in_t + (size_t)INW * D))[i] = (v4u){0u, 0u, 0u, 0u};
    for (int m = gw; m < T; m += NGW) rms_row_to_bf16(x + (size_t)m * D, XN + (size_t)m * D, lane);
}

constexpr int MOE_ROWS = 2 * T + NE * 256;
constexpr int MOE_MAXT = MOE_ROWS / 256;
constexpr int UP_OFF = 131072 + 1024;
namespace pg8 {
template <int NJ> struct MoeOrder {
    const int* tile_e; int nunits, G, c;
    __device__ __forceinline__ bool next(int i, Unit& u) const { const int L = i * G + c; if (L >= nunits) return false; u.pm = L / NJ; u.pn = tile_e[u.pm] * NJ + (L % NJ); return true; }
    __device__ __forceinline__ void a_ready(const Unit&) const {}
    __device__ __forceinline__ void done(const Unit&) const {}
};
struct EpiSwiGLU {
    static constexpr bool PERM = true, AFTER_DRAIN = false;
    bf16_t* HID; const float* roww;
    __device__ __forceinline__ void operator()(const f32x4 (&acc)[2][2][4][2], const Unit& u, int wr, int wc, int fr, int fq) const {
        const int row0 = u.pm * BM + wr * 64 + fr, hc0 = (u.pn & 1) * 128 + wc * 32 + 8 * fq;
#pragma unroll
        for (int ai = 0; ai < 2; ++ai)
#pragma unroll
            for (int m = 0; m < 4; ++m) { const int row = row0 + ai * HALF + m * 16; const float w = roww[row];
                float h[8];
#pragma unroll
                for (int n = 0; n < 2; ++n)
#pragma unroll
                    for (int q = 0; q < 4; ++q) { const float g = acc[ai][0][m][n][q], up = acc[ai][1][m][n][q];
                        h[n * 4 + q] = g * __builtin_amdgcn_rcpf(1.f + __builtin_amdgcn_exp2f(-1.4426950408889634f * g)) * up * w; }
                u32x4 o; o.x = cvt_pk_bf16(h[0], h[1]); o.y = cvt_pk_bf16(h[2], h[3]); o.z = cvt_pk_bf16(h[4], h[5]); o.w = cvt_pk_bf16(h[6], h[7]);
                *(u32x4*)(HID + (size_t)row * 256 + hc0) = o; }
    }
};
template <int NJ> struct EpiBf16Mod {
    static constexpr bool PERM = true, AFTER_DRAIN = false;
    bf16_t* O; int ldc;
    __device__ __forceinline__ void operator()(const f32x4 (&acc)[2][2][4][2], const Unit& u, int wr, int wc, int fr, int fq) const {
        const int row0 = u.pm * BM + wr * 64 + fr, col0 = (u.pn % NJ) * BM + wc * 32 + 8 * fq;
#pragma unroll
        for (int ai = 0; ai < 2; ++ai)
#pragma unroll
            for (int m = 0; m < 4; ++m) { bf16_t* rowp = O + (size_t)(row0 + ai * HALF + m * 16) * ldc + col0;
#pragma unroll
                for (int bj = 0; bj < 2; ++bj) { const f32x4 v0 = acc[ai][bj][m][0], v1 = acc[ai][bj][m][1];
                    u32x4 w; w.x = cvt_pk_bf16(v0[0], v0[1]); w.y = cvt_pk_bf16(v0[2], v0[3]); w.z = cvt_pk_bf16(v1[0], v1[1]); w.w = cvt_pk_bf16(v1[2], v1[3]);
                    *(u32x4*)(rowp + bj * HALF) = w; } }
    }
};
}

__device__ __forceinline__ void ph_moe_route(LAS unsigned char* lds, const float* X1, const float* g_ffn, const float* w_group, const float* b_group, const float* w_expert, const float* b_expert,
                                             const float* w_gate, const float* w_up, const float* w_down, bf16_t* Wgu_t, bf16_t* Wd_t, int* EID, float* EW, float* RSF, int* CNT) {
    const int tid = threadIdx.x, lane = tid & 63, wave = tid >> 6, G = gridDim.x, b = blockIdx.x, TPB = T / G;
    {
        LAS float* scr = (LAS float*)(lds + wave * 16384);
        const int gw = b * 8 + wave, NGW = G * 8;
        constexpr int IPE = (D / 64) * (DE / 32);
        for (int it = gw; it < 3 * NE * IPE; it += NGW) {
            const int mat = it / (NE * IPE), r = it % (NE * IPE), e = r / IPE, item = r % IPE;
            if (mat < 2) { const int nb = item % (DE / 32), n0 = 32 * nb;
                const int row_off = e * 512 + (n0 / 128) * 256 + (n0 % 128) + (mat ? 128 : 0) - n0;
                p0_transpose_item((mat ? w_up : w_gate) + (size_t)e * D * DE, DE, DE, g_ffn, Wgu_t, D, row_off, scr, item, lane); }
            else p0_transpose_item(w_down + (size_t)e * DE * D, D, D, nullptr, Wd_t, DE, e * D, scr, item, lane);
        }
    }
    LAS int* hist = (LAS int*)(lds + UP_OFF);
    if (tid < 32) hist[tid] = 0;
    __syncthreads();
    for (int i = wave; i < TPB; i += 8) {
        const int t = b * TPB + i;
        const float* x = X1 + (size_t)t * D;
        float ss = 0.f, acc[36];
        _Pragma("unroll") for (int q = 0; q < 36; ++q) acc[q] = 0.f;
        for (int k = lane; k < D; k += 64) {
            float v = x[k]; ss += v * v; float tv = v * g_ffn[k];
            _Pragma("unroll") for (int g = 0; g < 4; ++g) acc[g] += tv * w_group[k * 4 + g];
            _Pragma("unroll") for (int e = 0; e < 32; ++e) acc[4 + e] += tv * w_expert[k * 32 + e];
        }
        for (int o = 32; o > 0; o >>= 1) { ss += __shfl_xor(ss, o); _Pragma("unroll") for (int q = 0; q < 36; ++q) acc[q] += __shfl_xor(acc[q], o); }
        if (lane == 0) {
            float rs = rsqrtf(ss / D + 1e-6f);
            float gl[4]; int gs = 0; float gm = -INFINITY;
            _Pragma("unroll") for (int g = 0; g < 4; ++g) { gl[g] = acc[g] * rs + b_group[g]; if (gl[g] > gm) { gm = gl[g]; gs = g; } }
            float den = 0.f; _Pragma("unroll") for (int g = 0; g < 4; ++g) den += expf(gl[g] - gm);
            float gp = 1.f / den;
            float el[8];
            _Pragma("unroll") for (int e = 0; e < 8; ++e) { float v = acc[4 + e]; _Pragma("unroll") for (int g = 1; g < 4; ++g) v = (gs == g) ? acc[4 + g * 8 + e] : v; el[e] = v * rs + b_expert[gs * 8 + e]; }
            int i1 = 0; float v1 = el[0];
            _Pragma("unroll") for (int e = 1; e < 8; ++e) if (el[e] > v1) { v1 = el[e]; i1 = e; }
            int i2 = -1; float v2 = -INFINITY;
            _Pragma("unroll") for (int e = 0; e < 8; ++e) if (e != i1 && el[e] > v2) { v2 = el[e]; i2 = e; }
            float e2 = expf(v2 - v1); float w1 = 1.f / (1.f + e2), w2 = e2 / (1.f + e2);
            const int ea = gs * 8 + i1, eb = gs * 8 + i2;
            EID[t * 2] = ea; EID[t * 2 + 1] = eb; EW[t * 2] = w1 * gp; EW[t * 2 + 1] = w2 * gp; RSF[t] = rs;
            __hip_atomic_fetch_add(hist + ea, 1, __ATOMIC_RELAXED, __HIP_MEMORY_SCOPE_WORKGROUP);
            __hip_atomic_fetch_add(hist + eb, 1, __ATOMIC_RELAXED, __HIP_MEMORY_SCOPE_WORKGROUP);
        }
    }
    __syncthreads();
    if (tid < 32) CNT[b * 32 + tid] = hist[tid];
}

__device__ __forceinline__ void ph_moe_scatter(LAS unsigned char* lds, const float* X1, const float* RSF, const int* EID, const float* EW, const int* CNT,
                                               int* POS, float* ROWW, bf16_t* H2S, int* TILE_E) {
    const int tid = threadIdx.x, lane = tid & 63, wave = tid >> 6, G = gridDim.x, b = blockIdx.x, TPB = T / G;
    LAS int* up = (LAS int*)(lds + UP_OFF);
    LAS int* tot = up, *pre = up + 32, *base = up + 64, *ptot = up + 128, *ppre = up + 128 + 512, *epair = up + 128 + 1024, *dpair = up + 128 + 1024 + 256;
    { const int e = tid & 31, g = tid >> 5; int st = 0, sp = 0;
      for (int bb = g; bb < G; bb += 16) { const int c = CNT[bb * 32 + e]; st += c; if (bb < b) sp += c; }
      ptot[g * 32 + e] = st; ppre[g * 32 + e] = sp; }
    __syncthreads();
    if (tid < 32) { int st = 0, sp = 0; for (int g = 0; g < 16; ++g) { st += ptot[g * 32 + tid]; sp += ppre[g * 32 + tid]; } tot[tid] = st; pre[tid] = sp; }
    __syncthreads();
    if (tid == 0) { int acc = 0; for (int e = 0; e < NE; ++e) { base[e] = acc; acc += (tot[e] + 255) / 256 * 256; } base[32] = acc; }
    if (tid < 2 * TPB) epair[tid] = EID[(size_t)b * TPB * 2 + tid];
    __syncthreads();
    if (b == 0) { const int ntiles = base[32] / 256;
        if (tid == 0) TILE_E[MOE_MAXT] = ntiles;
        for (int tile = tid; tile < ntiles; tile += NTHR) { int e = 0; for (int q = 1; q < NE; ++q) if (base[q] <= tile * 256) e = q; TILE_E[tile] = e; } }
    if (tid < 2 * TPB) { const int e = epair[tid]; int rank = 0; for (int j = 0; j < tid; ++j) rank += (epair[j] == e) ? 1 : 0;
        const int dest = base[e] + pre[e] + rank; dpair[tid] = dest; POS[(size_t)b * TPB * 2 + tid] = dest; ROWW[dest] = EW[(size_t)b * TPB * 2 + tid]; }
    __syncthreads();
    for (int i = wave; i < TPB; i += 8) {
        const int t = b * TPB + i; const float rs = RSF[t];
        const f32x4* xr = (const f32x4*)(X1 + (size_t)t * D) + lane;
        unsigned long long* o0 = (unsigned long long*)(H2S + (size_t)dpair[2 * i] * D) + lane; unsigned long long* o1 = (unsigned long long*)(H2S + (size_t)dpair[2 * i + 1] * D) + lane;
#pragma unroll
        for (int j = 0; j < 4; ++j) { const f32x4 v = xr[64 * j]; const unsigned long long pk = (unsigned long long)pk2(v.x * rs, v.y * rs) | ((unsigned long long)pk2(v.z * rs, v.w * rs) << 32); o0[64 * j] = pk; o1[64 * j] = pk; }
    }
}

__device__ __forceinline__ void ph_moe_combine(float* OUT, const bf16_t* YS, const int* POS) {
    const int lane = threadIdx.x & 63, gw = blockIdx.x * 8 + (threadIdx.x >> 6), NGW = gridDim.x * 8;
    for (int t = gw; t < T; t += NGW) {
        const int p0 = POS[t * 2], p1 = POS[t * 2 + 1];
        f32x4* xr = (f32x4*)(OUT + (size_t)t * D) + lane;
        const unsigned long long* y0 = (const unsigned long long*)(YS + (size_t)p0 * D) + lane; const unsigned long long* y1 = (const unsigned long long*)(YS + (size_t)p1 * D) + lane;
#pragma unroll
        for (int j = 0; j < 4; ++j) { f32x4 v = xr[64 * j]; const unsigned long long a = y0[64 * j], c = y1[64 * j];
            v.x += __uint_as_float((unsigned)(a << 16)) + __uint_as_float((unsigned)(c << 16));
            v.y += __uint_as_float((unsigned)a & 0xffff0000u) + __uint_as_float((unsigned)c & 0xffff0000u);
            v.z += __uint_as_float((unsigned)(a >> 32) << 16) + __uint_as_float((unsigned)(c >> 32) << 16);
            v.w += __uint_as_float((unsigned)(a >> 32) & 0xffff0000u) + __uint_as_float((unsigned)(c >> 32) & 0xffff0000u);
            xr[64 * j] = v; }
    }
}

namespace att {
typedef short bf16x8 __attribute__((ext_vector_type(8)));
typedef short s16x4 __attribute__((ext_vector_type(4)));
typedef float f32x16 __attribute__((ext_vector_type(16)));
typedef unsigned u32x4 __attribute__((ext_vector_type(4)));
constexpr int DQ = 96, DV = 64, QS = 768, KS = 768, VS = 512, OS = 1024;
constexpr float SCALE = 0.10206207261596577f;
constexpr float THR = 8.f;
constexpr int NW = 8, QBLK = 32, KVBLK = 64, QB = NW * QBLK, NQB = S / QB;
constexpr int SHM_V = 8192, SHM_K = 16384;
constexpr int LDS_BYTES = 2 * SHM_V + 2 * SHM_K + NW * 64 * 4;
#define KSWZ(row, colB) ((row) * 256 + ((colB) ^ (((row) & 7) << 4)))
#define SBAR() __builtin_amdgcn_sched_barrier(0)
__device__ __forceinline__ int v_st(int k, int c) { const int kk = (k & ~0xC) | ((k & 4) << 1) | ((k & 8) >> 1); return ((kk >> 3) * 2 + (c >> 5)) * 512 + ((kk & 7) * 32 + (c & 31)) * 2; }
__device__ __forceinline__ int v_rd_base(int lane) { return ((lane & 3) << 3) | (((lane >> 2) & 3) << 6) | (((lane >> 4) & 1) << 5) | (((lane >> 5) & 1) << 8); }
constexpr int v_rd_off(int d0, int ks, int half) { return d0 * 512 + ks * 2048 + half * 1024; }
__device__ __forceinline__ int crow(int r, int hi) { return (r & 3) + 8 * (r >> 2) + 4 * hi; }
__device__ __forceinline__ unsigned cvtpk(float lo, float hi) { unsigned r; asm volatile("v_cvt_pk_bf16_f32 %0, %1, %2" : "=v"(r) : "v"(lo), "v"(hi)); return r; }
__device__ __forceinline__ bf16x8 load8(const bf16_t* p) { return *reinterpret_cast<const bf16x8*>(p); }
__device__ __forceinline__ void mask_tile(f32x16& p0, f32x16& p1, int dq) {
    const float NEG = -__builtin_inff();
#pragma unroll
    for (int r = 0; r < 16; ++r) { const int c = (r & 3) + 8 * (r >> 2); if (dq - c < 0) p0[r] = NEG; if (dq - c - 32 < 0) p1[r] = NEG; }
}
__device__ __forceinline__ void partialSM(f32x16& p0, f32x16& p1, float& m_reg, float& mn, float& alpha) {
    float pmax = p0[0];
#pragma unroll
    for (int r = 1; r < 16; ++r) pmax = fmaxf(pmax, p0[r]);
#pragma unroll
    for (int r = 0; r < 16; ++r) pmax = fmaxf(pmax, p1[r]);
    { auto rr = __builtin_amdgcn_permlane32_swap(__float_as_uint(pmax), __float_as_uint(pmax), false, false); pmax = fmaxf(__uint_as_float(rr[0]), __uint_as_float(rr[1])); }
    constexpr float C2 = 1.4426950408889634f * SCALE;
    if (__builtin_expect(__all((pmax - m_reg) * SCALE <= THR), 1)) { mn = m_reg; alpha = 1.f; }
    else { mn = fmaxf(m_reg, pmax); alpha = __builtin_amdgcn_exp2f((m_reg - mn) * C2); m_reg = mn; }
    const float mnL = -mn * C2;
#pragma unroll
    for (int r = 0; r < 16; ++r) p0[r] = fmaf(p0[r], C2, mnL);
#pragma unroll
    for (int r = 0; r < 16; ++r) p1[r] = fmaf(p1[r], C2, mnL);
#pragma unroll
    for (int r = 0; r < 16; ++r) p0[r] = __builtin_amdgcn_exp2f(p0[r]);
}
__device__ __forceinline__ void finishSM(f32x16& p0, f32x16& p1, float alpha, float& l_reg, bf16x8& pa0, bf16x8& pa1, bf16x8& pa2, bf16x8& pa3) {
#pragma unroll
    for (int r = 0; r < 16; ++r) p1[r] = __builtin_amdgcn_exp2f(p1[r]);
    float ps = 0;
#pragma unroll
    for (int r = 0; r < 16; ++r) ps += p0[r];
#pragma unroll
    for (int r = 0; r < 16; ++r) ps += p1[r];
    { auto rr = __builtin_amdgcn_permlane32_swap(__float_as_uint(ps), __float_as_uint(ps), false, false); ps = __uint_as_float(rr[0]) + __uint_as_float(rr[1]); }
    l_reg = l_reg * alpha + ps;
#define PK4(P, B_, OUT) do { unsigned a0 = cvtpk(P[B_+0], P[B_+1]), a1 = cvtpk(P[B_+2], P[B_+3]); unsigned b0 = cvtpk(P[B_+4], P[B_+5]), b1 = cvtpk(P[B_+6], P[B_+7]); \
        auto r0 = __builtin_amdgcn_permlane32_swap(a0, b0, false, false); auto r1 = __builtin_amdgcn_permlane32_swap(a1, b1, false, false); \
        u32x4 w = {r0[0], r1[0], r0[1], r1[1]}; OUT = *reinterpret_cast<bf16x8*>(&w); } while (0)
    PK4(p0, 0, pa0); PK4(p0, 8, pa1); PK4(p1, 0, pa2); PK4(p1, 8, pa3);
#undef PK4
}
template <int KB>
__device__ __forceinline__ void qkt(f32x16& p0, f32x16& p1, const char* K_lds, int r32, int hi, const bf16x8* qr) {
    p0 = f32x16{}; p1 = f32x16{};
    const char* kb[4];
#pragma unroll
    for (int dd = 0; dd < 4; ++dd) kb[dd] = K_lds + KB * SHM_K + KSWZ(r32, (dd * 16 + hi * 8) * 2);
#pragma unroll
    for (int d0 = 0; d0 < 6; ++d0) { const char* a = kb[d0 & 3] + (d0 >> 2) * 128;
        bf16x8 b0 = *reinterpret_cast<const bf16x8*>(a);
        bf16x8 b1 = *reinterpret_cast<const bf16x8*>(a + 32 * 256);
        p0 = __builtin_amdgcn_mfma_f32_32x32x16_bf16(b0, qr[d0], p0, 0, 0, 0);
        p1 = __builtin_amdgcn_mfma_f32_32x32x16_bf16(b1, qr[d0], p1, 0, 0, 0); }
}
template <int VB>
__device__ __forceinline__ void pv_tile(f32x16* o, int vb0, bf16x8 pa0, bf16x8 pa1, bf16x8 pa2, bf16x8 pa3) {
#define TRRD(dst, off) asm volatile("ds_read_b64_tr_b16 %0, %1 offset:%2" : "=&v"(dst) : "v"(vb0), "i"(off) : "memory")
#define PV_D0(d0) do { s16x4 l0, l1, l2, l3, h0, h1, h2, h3; constexpr int b_ = VB * SHM_V + v_rd_off(d0, 0, 0); \
        TRRD(l0, b_); TRRD(h0, b_ + 1024); TRRD(l1, b_ + 2048); TRRD(h1, b_ + 3072); TRRD(l2, b_ + 4096); TRRD(h2, b_ + 5120); TRRD(l3, b_ + 6144); TRRD(h3, b_ + 7168); \
        asm volatile("s_waitcnt lgkmcnt(0)" ::: "memory"); SBAR(); \
        o[d0] = __builtin_amdgcn_mfma_f32_32x32x16_bf16(pa0, (bf16x8){l0[0], l0[1], l0[2], l0[3], h0[0], h0[1], h0[2], h0[3]}, o[d0], 0, 0, 0); \
        o[d0] = __builtin_amdgcn_mfma_f32_32x32x16_bf16(pa1, (bf16x8){l1[0], l1[1], l1[2], l1[3], h1[0], h1[1], h1[2], h1[3]}, o[d0], 0, 0, 0); \
        o[d0] = __builtin_amdgcn_mfma_f32_32x32x16_bf16(pa2, (bf16x8){l2[0], l2[1], l2[2], l2[3], h2[0], h2[1], h2[2], h2[3]}, o[d0], 0, 0, 0); \
        o[d0] = __builtin_amdgcn_mfma_f32_32x32x16_bf16(pa3, (bf16x8){l3[0], l3[1], l3[2], l3[3], h3[0], h3[1], h3[2], h3[3]}, o[d0], 0, 0, 0); } while (0)
    PV_D0(0); PV_D0(1);
#undef PV_D0
#undef TRRD
}
struct BlockRef { const bf16_t* Q; const bf16_t* K; const bf16_t* V; bf16_t* O; int P0; };
struct Seam { bf16x8 qr[6]; bf16x8 st_v0, st_k0, st_k1; };
#define VMW() asm volatile("s_waitcnt vmcnt(0)" ::: "memory")
#define VMWN(n) asm volatile("s_waitcnt vmcnt(%0)" :: "i"(n) : "memory")
#define SLOAD_H(Kp, Vp, k0) do { S.st_v0 = load8((Vp) + (size_t)((k0) + vr) * VS + vc); \
        S.st_k0 = load8((Kp) + (size_t)((k0) + sr) * KS + kc); S.st_k1 = load8((Kp) + (size_t)((k0) + 32 + sr) * KS + kc); } while (0)
#define SWRITE_HK(bf) do { *(bf16x8*)(K_lds + (bf) * SHM_K + kws) = S.st_k0; *(bf16x8*)(K_lds + (bf) * SHM_K + kws + 32 * 256) = S.st_k1; } while (0)
#define SWRITE_HV(bf) do { *(bf16x8*)(V_lds + (bf) * SHM_V + vst0) = S.st_v0; } while (0)
#define SWRITE_H(bf) do { SWRITE_HV(bf); SWRITE_HK(bf); } while (0)
#define STAGE_IDX() const int sr = tid >> 4, kc = ((tid & 15) < 12 ? (tid & 15) : 11) * 8, kws = KSWZ(sr, kc * 2), vr = tid >> 3, vc = (tid & 7) * 8, vst0 = v_st(vr, vc)
__device__ __forceinline__ void prime(const BlockRef& cur, char* lds, Seam& S) {
    const int tid = threadIdx.x, wid = __builtin_amdgcn_readfirstlane(tid >> 6), lane = tid & 63, r32 = lane & 31, hi = lane >> 5;
    STAGE_IDX(); (void)vst0; char* K_lds = lds + 2 * SHM_V;
#pragma unroll
    for (int d0 = 0; d0 < 6; ++d0) S.qr[d0] = load8(cur.Q + (size_t)(wid * QBLK + r32) * QS + d0 * 16 + hi * 8);
    SLOAD_H(cur.K, cur.V, 0); VMW(); SWRITE_HK(0);
    __syncthreads();
}
__device__ __forceinline__ void block(const BlockRef& cur, const BlockRef& nxt, char* lds, Seam& S) {
    const int tid = threadIdx.x, wid = __builtin_amdgcn_readfirstlane(tid >> 6), lane = tid & 63, r32 = lane & 31, hi = lane >> 5;
    const int NT = cur.P0 / KVBLK + QB / KVBLK;
    const int qlo = cur.P0 + wid * QBLK, qm = qlo + r32 - 4 * hi;
    char* V_lds = lds; char* K_lds = lds + 2 * SHM_V;
    float* wsf = (float*)(lds + 2 * SHM_V + 2 * SHM_K) + wid * 64; float* li_l = wsf, * al_l = wsf + 32;
    float m_reg = -1e30f, l_reg = 0; f32x16 o[2] = {};
    STAGE_IDX();
    const int vb0 = (int)(uintptr_t)V_lds + v_rd_base(lane);
    const bf16_t* Kh = cur.K; const bf16_t* Vh = cur.V;
#define RESC(a) do { if (__any((a) < 1.f)) { if (hi == 0) al_l[r32] = (a); asm volatile("s_waitcnt lgkmcnt(0)" ::: "memory"); \
                     _Pragma("unroll") for (int d_ = 0; d_ < 2; ++d_) _Pragma("unroll") for (int r = 0; r < 16; ++r) o[d_][r] *= al_l[crow(r, hi)]; } } while (0)
#define KBASE(t) ((t) * KVBLK)
#define MASKT(P0_, P1_, t) do { const int kb_ = KBASE(t); if (kb_ + KVBLK - 1 > qlo) mask_tile(P0_, P1_, qm - kb_); } while (0)
    constexpr int NQL = 6;
#define SEAM_K0() do { VMWN(NQL); SWRITE_HK(0); SBAR(); } while (0)
    f32x16 pA0, pA1, pB0, pB1; float mnA, mnB, alA, alB; bf16x8 pa0, pa1, pa2, pa3;
    SWRITE_HV(0); SBAR();
    if (NT > 1) SLOAD_H(Kh, Vh, KBASE(1));
    SBAR(); qkt<0>(pA0, pA1, K_lds, r32, hi, S.qr);
    MASKT(pA0, pA1, 0); partialSM(pA0, pA1, m_reg, mnA, alA);
    if (NT > 1) { VMW(); SWRITE_H(1); }
    __syncthreads();
#define HALF_STEP(PX0, PX1, mnX, alX, PY0, PY1, alY, t, KB, VB, SB) do { \
        SBAR(); qkt<KB>(PX0, PX1, K_lds, r32, hi, S.qr); \
        finishSM(PY0, PY1, alY, l_reg, pa0, pa1, pa2, pa3); SBAR(); \
        if ((t) + 1 < NT) { SLOAD_H(Kh, Vh, KBASE((t) + 1)); SBAR(); } \
        pv_tile<VB>(o, vb0, pa0, pa1, pa2, pa3); MASKT(PX0, PX1, (t)); partialSM(PX0, PX1, m_reg, mnX, alX); \
        __syncthreads(); \
        if ((t) + 1 < NT) { VMW(); SWRITE_H(SB); } \
        RESC(alX); __syncthreads(); } while (0)
    for (int t = 1; t + 1 < NT; t += 2) {
        HALF_STEP(pB0, pB1, mnB, alB, pA0, pA1, alA, t, 1, 0, 0);
        HALF_STEP(pA0, pA1, mnA, alA, pB0, pB1, alB, t + 1, 0, 1, 1);
    }
    const bool even = (NT & 1) == 0;
    if (even) { SBAR(); qkt<1>(pB0, pB1, K_lds, r32, hi, S.qr); SBAR(); }
    SLOAD_H(nxt.K, nxt.V, 0); SBAR();
#pragma unroll
    for (int d0 = 0; d0 < 6; ++d0) S.qr[d0] = load8(nxt.Q + (size_t)(wid * QBLK + r32) * QS + d0 * 16 + hi * 8);
    SBAR();
    finishSM(pA0, pA1, alA, l_reg, pa0, pa1, pa2, pa3); SBAR();
    pv_tile<0>(o, vb0, pa0, pa1, pa2, pa3);
    if (even) { MASKT(pB0, pB1, NT - 1); partialSM(pB0, pB1, m_reg, mnB, alB); __syncthreads(); RESC(alB);
        finishSM(pB0, pB1, alB, l_reg, pa0, pa1, pa2, pa3); SBAR(); pv_tile<1>(o, vb0, pa0, pa1, pa2, pa3); }
    SBAR(); SEAM_K0();
    if (hi == 0) li_l[r32] = l_reg; asm volatile("s_waitcnt lgkmcnt(0)" ::: "memory");
    float rli[16];
#pragma unroll
    for (int r = 0; r < 16; ++r) rli[r] = __builtin_amdgcn_rcpf(li_l[crow(r, hi)]);
    bf16_t* Ow = cur.O + (size_t)(wid * QBLK) * OS;
#pragma unroll
    for (int r = 0; r < 16; ++r) { const int orow = crow(r, hi);
#pragma unroll
        for (int d0 = 0; d0 < 2; ++d0) { const float v = o[d0][r] * rli[r];
            const float vn = __shfl_xor(v, 1);
            if ((r32 & 1) == 0) *(unsigned*)(Ow + (size_t)orow * OS + d0 * 32 + r32) = cvtpk(v, vn); } }
    __syncthreads();
#undef RESC
#undef KBASE
#undef MASKT
#undef SEAM_K0
#undef HALF_STEP
}
#undef VMW
#undef VMWN
#undef SLOAD_H
#undef SWRITE_HK
#undef SWRITE_HV
#undef SWRITE_H
#undef STAGE_IDX
__device__ __forceinline__ BlockRef ref_of(int L, int pass, const bf16_t* Q, const bf16_t* K, const bf16_t* V, bf16_t* O) {
    const int bh = L / (NQB / 2), x = L % (NQB / 2), qb = pass ? (NQB - 1 - x) : x, b = bh / H, h = bh % H;
    BlockRef r; const size_t row0 = (size_t)b * S;
    r.Q = Q + (row0 + (size_t)qb * QB) * QS + h * DQ; r.O = O + (row0 + (size_t)qb * QB) * OS + h * DV;
    r.K = K + row0 * KS + h * DQ; r.V = V + row0 * VS + h * DV; r.P0 = qb * QB;
    return r;
}
__device__ __forceinline__ void phase(char* lds, const bf16_t* Q, const bf16_t* K, const bf16_t* V, bf16_t* O) {
    const int G = gridDim.x, total = (NQB / 2) * NB * H;
    const int vcu = (G % 8 == 0) ? ((int)blockIdx.x % 8) * (G / 8) + (int)blockIdx.x / 8 : (int)blockIdx.x;
    int L = vcu; if (L >= total) return;
    int pass = 0;
    BlockRef cur = ref_of(L, 0, Q, K, V, O);
    Seam Sm;
    prime(cur, lds, Sm);
    for (;;) {
        const bool more_pass = pass == 0, more_item = L + G < total, last = !more_pass && !more_item;
        int passn = pass + 1, Ln = L;
        if (!more_pass) { passn = 0; Ln = more_item ? L + G : L; }
        const BlockRef nxt = last ? cur : ref_of(Ln, passn, Q, K, V, O);
        block(cur, nxt, lds, Sm);
        if (last) break;
        cur = nxt; pass = passn; L = Ln;
    }
}
#undef KSWZ
#undef SBAR
}

struct Params {
    const float* x; const int* pos;
    const float *g_mix, *w_in, *g_cq, *w_uq, *g_ckv, *w_uk, *w_uv, *g_qn, *g_kn, *g_mla_out;
    const float *rw_mu, *rw_w0, *rw_w2, *rw_a0, *rw_a2, *rw_g2, *rw_k_k, *rw_k_a, *rw_r_k, *rw_lnx_g, *rw_lnx_b;
    const float *w_o, *g_ffn, *w_group, *b_group, *w_expert, *b_expert, *w_gate, *w_up, *w_down;
    float* out; unsigned char* ws;
    int ph_lo, ph_hi;
};
constexpr size_t MiB = 1u << 20;
constexpr size_t WS_CTL = 0, CTL_ZERO_BYTES = 1 * MiB;
constexpr size_t WS_SMALL = 1 * MiB;
constexpr size_t WS_PROJ = 4 * MiB;
constexpr size_t WS_MIX = 148 * MiB;
constexpr size_t WS_RX = 212 * MiB;
constexpr size_t WS_WO = 502 * MiB;
constexpr int CW_BAR = 4096;

template <class TI> __device__ __forceinline__ void ph_rowstat(const TI* in, int ld, int col0, int n, float eps, float* rstd) {
    const int lane = threadIdx.x & 63, gw = blockIdx.x * 8 + (threadIdx.x >> 6), NGW = gridDim.x * 8;
    for (int row = gw; row < T; row += NGW) {
        const TI* p = in + (size_t)row * ld + col0;
        float s = 0.f;
        for (int c = lane; c < n; c += 64) { float v = ldf(p + c); s += v * v; }
        for (int o = 32; o > 0; o >>= 1) s += __shfl_xor(s, o);
        if (lane == 0) rstd[row] = rsqrtf(s / n + eps);
    }
}

template <class TA, class TC> __device__ __forceinline__ void ph_gemm(LAS unsigned char* lds, const TA* A, int lda, const float* rowscale, const float* kgain, const float* Bm, int ldb,
                                                                     TC* C, int ldc, int M, int N, int K, const float* R, int ldr) {
    const int sub = threadIdx.x >> 8, tid = threadIdx.x & 255, tx = tid % 16, ty = tid / 16;
    LAS float (*As)[68] = (LAS float (*)[68])(lds + sub * 16384);
    LAS float (*Bs)[68] = (LAS float (*)[68])(lds + sub * 16384 + 8192);
    const int ntn = (N + 63) / 64, ntiles = ntn * (M / 64);
    const int ar = tid / 4, ac = (tid % 4) * 4, br = tid / 16, bc = (tid % 16) * 4;
    for (int vb = blockIdx.x * 2 + sub; vb < ntiles; vb += gridDim.x * 2) {
        const int m0 = (vb / ntn) * 64, n0 = (vb % ntn) * 64;
        float acc[4][4];
        _Pragma("unroll") for (int i = 0; i < 4; ++i) _Pragma("unroll") for (int j = 0; j < 4; ++j) acc[i][j] = 0.f;
        const float rs = rowscale ? rowscale[m0 + ar] : 1.f;
        for (int k0 = 0; k0 < K; k0 += 16) {
            _Pragma("unroll") for (int i = 0; i < 4; ++i) { float v = ldf(A + (size_t)(m0 + ar) * lda + k0 + ac + i) * rs; if (kgain) v *= kgain[k0 + ac + i]; As[ac + i][ar] = v; }
            _Pragma("unroll") for (int i = 0; i < 4; ++i) { int n = n0 + bc + i; Bs[br][bc + i] = (n < N) ? Bm[(size_t)(k0 + br) * ldb + n] : 0.f; }
            __syncthreads();
            _Pragma("unroll") for (int k = 0; k < 16; ++k) {
                float a[4], b[4];
                _Pragma("unroll") for (int i = 0; i < 4; ++i) a[i] = As[k][ty * 4 + i];
                _Pragma("unroll") for (int j = 0; j < 4; ++j) b[j] = Bs[k][tx * 4 + j];
                _Pragma("unroll") for (int i = 0; i < 4; ++i) _Pragma("unroll") for (int j = 0; j < 4; ++j) acc[i][j] += a[i] * b[j];
            }
            __syncthreads();
        }
        _Pragma("unroll") for (int i = 0; i < 4; ++i) _Pragma("unroll") for (int j = 0; j < 4; ++j) {
            int m = m0 + ty * 4 + i, n = n0 + tx * 4 + j;
            if (n < N) { float v = acc[i][j]; if (R) v += R[(size_t)m * ldr + n]; stf(C + (size_t)m * ldc + n, v); }
        }
    }
}

__device__ __forceinline__ void ph_qk_prep(bf16_t* Q, const bf16_t* KNOPE, const bf16_t* PROJ, const int* pos, const float* g_qn, const float* g_kn, bf16_t* K) {
    for (int idx = blockIdx.x * NTHR + threadIdx.x; idx < T * H; idx += gridDim.x * NTHR) {
        const int t = idx / H, h = idx % H;
        const float p = (float)pos[t];
        bf16_t* qp = Q + (size_t)t * 768 + h * QK; bf16_t* kp = K + (size_t)t * 768 + h * QK;
        const bf16_t* knp = KNOPE + (size_t)t * 512 + h * NOPE; const bf16_t* krp = PROJ + (size_t)t * PW + 384;
        float sq = 0.f, sk = 0.f;
#pragma unroll 4
        for (int d = 0; d < QK; ++d) { float v = bf2f(qp[d]); sq += v * v; }
#pragma unroll 4
        for (int d = 0; d < NOPE; ++d) { float v = bf2f(knp[d]); sk += v * v; }
#pragma unroll 4
        for (int d = 0; d < ROPE; ++d) { float v = bf2f(krp[d]); sk += v * v; }
        const float rq = rsqrtf(sq / QK + 1e-6f), rk = rsqrtf(sk / QK + 1e-6f);
#pragma unroll 4
        for (int d = 0; d < NOPE; ++d) { qp[d] = f2bf(bf2f(qp[d]) * rq * g_qn[d]); kp[d] = f2bf(bf2f(knp[d]) * rk * g_kn[d]); }
#pragma unroll 1
        for (int i = 0; i < 16; ++i) {
            const float inv_freq = 1.0f / powf(10000.0f, (float)i / 16.0f);
            const float ang = p * inv_freq, c = cosf(ang), s = sinf(ang);
            float x1 = bf2f(qp[64 + i]) * rq * g_qn[64 + i], x2 = bf2f(qp[80 + i]) * rq * g_qn[80 + i];
            qp[64 + i] = f2bf(x1 * c - x2 * s); qp[80 + i] = f2bf(x2 * c + x1 * s);
            x1 = bf2f(krp[i]) * rk * g_kn[64 + i]; x2 = bf2f(krp[16 + i]) * rk * g_kn[80 + i];
            kp[64 + i] = f2bf(x1 * c - x2 * s); kp[80 + i] = f2bf(x2 * c + x1 * s);
        }
    }
}

__device__ __forceinline__ void ph_mla_norm(bf16_t* MIX, const float* g) {
    const int lane = threadIdx.x & 63, gw = blockIdx.x * 8 + (threadIdx.x >> 6), NGW = gridDim.x * 8;
    for (int row = gw; row < T; row += NGW) {
        bf16_t* p = MIX + (size_t)row * 1024;
        float v[8]; float s = 0.f;
        _Pragma("unroll") for (int i = 0; i < 8; ++i) { v[i] = bf2f(p[lane + 64 * i]); s += v[i] * v[i]; }
        for (int o = 32; o > 0; o >>= 1) s += __shfl_xor(s, o);
        float r = rsqrtf(s / 512.f + 1e-6f);
        _Pragma("unroll") for (int i = 0; i < 8; ++i) p[lane + 64 * i] = f2bf(v[i] * r * g[lane + 64 * i]);
    }
}

__device__ __forceinline__ void ph_rw_prep1(const bf16_t* PROJ, const float* mu, bf16_t* R, bf16_t* K1, bf16_t* V1, float* LIN) {
    const size_t total = (size_t)T * RWKV_IN;
    for (size_t idx = (size_t)blockIdx.x * NTHR + threadIdx.x; idx < total; idx += (size_t)gridDim.x * NTHR) {
        int t = (int)(idx / RWKV_IN), c = (int)(idx % RWKV_IN); int s = t % S;
        float f = bf2f(PROJ[(size_t)t * PW + MLA_IN + c]);
        float p = (s > 0) ? bf2f(PROJ[(size_t)(t - 1) * PW + MLA_IN + c]) : 0.f;
        float v = f + (p - f) * mu[c];
        if (c < 512) R[(size_t)t * 512 + c] = f2bf(v);
        else if (c < 1024) K1[(size_t)t * 512 + c - 512] = f2bf(v);
        else if (c < 1536) V1[(size_t)t * 512 + c - 1024] = f2bf(v);
        else if (c < 1600) LIN[(size_t)t * 256 + c - 1536] = tanhf(v);
        else if (c < 1664) LIN[(size_t)t * 256 + c - 1536] = v;
        else LIN[(size_t)t * 256 + c - 1536] = 1.f / (1.f + expf(-v));
    }
}

__device__ __forceinline__ void ph_rw_prep2(bf16_t* K1, const float* WPRE, const float* APRE, const float* w0, const float* a0, const float* k_k, const float* k_a,
                                            float* KK, float* BB, float* DEC) {
    for (int idx = blockIdx.x * NTHR + threadIdx.x; idx < T * RH; idx += gridDim.x * NTHR) {
        int t = idx / RH, h = idx % RH; size_t base = (size_t)t * 512 + h * 64;
        float ss = 0.f;
        for (int j = 0; j < 64; ++j) { float kv = bf2f(K1[base + j]) * k_k[h * 64 + j]; ss += kv * kv; }
        float inv = rsqrtf(ss + 1e-12f);
        for (int j = 0; j < 64; ++j) {
            int c = h * 64 + j;
            float kv = bf2f(K1[base + j]);
            float a = 1.f / (1.f + expf(-(a0[c] + APRE[base + j])));
            float z = w0[c] + WPRE[base + j];
            float w = -log1pf(expf(-z)) - 0.5f;
            float dec = expf(-expf(w));
            float kk = kv * k_k[c] * inv;
            KK[base + j] = kk; BB[base + j] = kk * a; DEC[base + j] = dec;
            K1[base + j] = f2bf(kv * (1.f + (a - 1.f) * k_a[c]));
        }
    }
}

__device__ __forceinline__ void ph_rw_scan(LAS unsigned char* lds, const bf16_t* R, const bf16_t* K1, const bf16_t* V1, const float* KK, const float* BB, const float* DEC, float* Y) {
    const int lane = threadIdx.x & 63, wid = threadIdx.x >> 6;
    const int bh = blockIdx.x * 8 + wid;
    if (bh >= NB * RH) return;
    LAS float (*sh)[5][64] = (LAS float (*)[5][64])(lds + wid * 4096);
    const int b = bh / RH, h = bh % RH;
    float st[64];
    _Pragma("unroll") for (int j = 0; j < 64; ++j) st[j] = 0.f;
    size_t base = ((size_t)b * S) * 512 + h * 64 + lane;
    float nr = bf2f(R[base]), nk = bf2f(K1[base]), nkk = KK[base], nb = BB[base], nd = DEC[base], nv = bf2f(V1[base]);
    for (int s = 0; s < S; ++s) {
        const int buf = s & 1;
        sh[buf][0][lane] = nr; sh[buf][1][lane] = nk; sh[buf][2][lane] = nkk; sh[buf][3][lane] = nb; sh[buf][4][lane] = nd;
        const float vv = nv;
        if (s + 1 < S) { size_t nb_ = base + (size_t)(s + 1) * 512; nr = bf2f(R[nb_]); nk = bf2f(K1[nb_]); nkk = KK[nb_]; nb = BB[nb_]; nd = DEC[nb_]; nv = bf2f(V1[nb_]); }
        WAVE_SYNC();
        float sa = 0.f;
        _Pragma("unroll") for (int j = 0; j < 64; ++j) sa += st[j] * sh[buf][2][j];
        sa = -sa;
        float y = 0.f;
        _Pragma("unroll") for (int j = 0; j < 64; ++j) { st[j] = st[j] * sh[buf][4][j] + sa * sh[buf][3][j] + vv * sh[buf][1][j]; y += st[j] * sh[buf][0][j]; }
        Y[((size_t)b * S + s) * 512 + h * 64 + lane] = y;
        WAVE_SYNC();
    }
}

__device__ __forceinline__ void ph_rw_post(const float* Y, const bf16_t* R, const bf16_t* K1, const bf16_t* V1, const float* G, const float* r_k, const float* lnx_g, const float* lnx_b, bf16_t* MIX) {
    for (int idx = blockIdx.x * NTHR + threadIdx.x; idx < T * RH; idx += gridDim.x * NTHR) {
        int t = idx / RH, h = idx % RH; size_t base = (size_t)t * 512 + h * 64;
        float mean = 0.f; for (int j = 0; j < 64; ++j) mean += Y[base + j]; mean /= 64.f;
        float var = 0.f; for (int j = 0; j < 64; ++j) { float d = Y[base + j] - mean; var += d * d; } var /= 64.f;
        float rs = rsqrtf(var + 64e-5f);
        float bonus = 0.f; for (int j = 0; j < 64; ++j) bonus += bf2f(R[base + j]) * bf2f(K1[base + j]) * r_k[h * 64 + j];
        for (int j = 0; j < 64; ++j) {
            int c = h * 64 + j;
            float y = (Y[base + j] - mean) * rs * lnx_g[c] + lnx_b[c] + bonus * bf2f(V1[base + j]);
            MIX[(size_t)t * 1024 + 512 + c] = f2bf(y * G[base + j]);
        }
    }
}

constexpr int N_PHASES = 17;
__global__ void __launch_bounds__(NTHR, 2) mk_fwd(Params p) {
    extern __shared__ __attribute__((aligned(16))) unsigned char lds_raw[];
    LAS unsigned char* lds = (LAS unsigned char*)lds_raw;
    volatile LAS unsigned* MISC = (volatile LAS unsigned*)(lds + 131072 + 320);
    for (int u = threadIdx.x; u < (LDS_BYTES - 131072) / 4; u += NTHR) ((LAS unsigned*)(lds + 131072))[u] = 0u;
    __syncthreads();
    unsigned* ctl = (unsigned*)(p.ws + WS_CTL);
    XcdBarrier bar; bar.bar = ctl + CW_BAR; bar.x = 0; bar.st = nullptr;
    if (!MK_PER_PHASE) bar = xcd_barrier_post(ctl + CW_BAR, MISC + 8);
#define GRID_BAR() do { if (!MK_PER_PHASE) xcd_barrier(bar); } while (0)
#define IN(k) (p.ph_lo <= (k) && (k) < p.ph_hi)
#define BOTH(k) (IN(k) && IN((k) + 1))
    unsigned char* ws = p.ws;
    float* small = (float*)(ws + WS_SMALL);
    float* RS_X = small; float* RS_CQ = small + T; float* RS_CKV = small + 2 * T; float* RSF = small + 3 * T;
    float* EW = small + 4 * T; int* EID = (int*)(small + 6 * T);
    bf16_t* PROJ = (bf16_t*)(ws + WS_PROJ);
    bf16_t* MIX = (bf16_t*)(ws + WS_MIX);
    unsigned char* RX = ws + WS_RX;
    bf16_t* Qb = (bf16_t*)(RX); bf16_t* Kb = (bf16_t*)(RX + 48 * MiB); bf16_t* KN = (bf16_t*)(RX + 96 * MiB); bf16_t* Vb = (bf16_t*)(RX + 128 * MiB);
    bf16_t* Rb = (bf16_t*)(RX); bf16_t* K1 = (bf16_t*)(RX + 32 * MiB); bf16_t* V1 = (bf16_t*)(RX + 64 * MiB);
    float* KK = (float*)(RX + 96 * MiB); float* BB = (float*)(RX + 160 * MiB); float* DEC = (float*)(RX + 224 * MiB);
    float* LIN = p.out; float* G = p.out + (size_t)T * 256;
    float* WPRE = (float*)(ws + WS_PROJ); float* APRE = (float*)(ws + WS_PROJ + 64 * MiB); float* Y = (float*)(ws + WS_PROJ);

    bf16_t* XN = (bf16_t*)p.out; bf16_t* W_in_t = (bf16_t*)((unsigned char*)p.out + 64 * MiB); bf16_t* W_o_t = (bf16_t*)(ws + WS_WO);
    if (IN(0)) { ph_prologue(lds, p.x, p.w_in, p.g_mix, p.w_o, XN, W_in_t, W_o_t); if (BOTH(0)) GRID_BAR(); }
    if (IN(1)) {
        pg8::Gemm g{XN, W_in_t, T, PW, D, D, D}; pg8::StaticOrder So; So.init(T, PW, (int)gridDim.x, (int)blockIdx.x);
        pg8::EpiBf16<0> E{PROJ, PW, nullptr, 0, 0, 1.f};
        pg8::gemm_phase<pg8::EpiBf16<0>, pg8::StaticOrder, PG8_ALIGN, PG8_SP2, D, D, D>(lds, g, So, E);
        if (BOTH(1)) GRID_BAR(); }
    if (IN(2)) { ph_rowstat<bf16_t>(PROJ, PW, 0, QR, 1e-6f, RS_CQ); ph_rowstat<bf16_t>(PROJ, PW, QR, KVR, 1e-6f, RS_CKV); if (BOTH(2)) GRID_BAR(); }
    if (IN(3)) {
        ph_gemm<bf16_t, bf16_t>(lds, PROJ, PW, RS_CQ, p.g_cq, p.w_uq, 768, Qb, 768, T, 768, QR, nullptr, 0);
        ph_gemm<bf16_t, bf16_t>(lds, PROJ + QR, PW, RS_CKV, p.g_ckv, p.w_uk, 512, KN, 512, T, 512, KVR, nullptr, 0);
        ph_gemm<bf16_t, bf16_t>(lds, PROJ + QR, PW, RS_CKV, p.g_ckv, p.w_uv, 512, Vb, 512, T, 512, KVR, nullptr, 0);
        if (BOTH(3)) GRID_BAR(); }
    if (IN(4)) { ph_qk_prep(Qb, KN, PROJ, p.pos, p.g_qn, p.g_kn, Kb); if (BOTH(4)) GRID_BAR(); }
    if (IN(5)) { att::phase((char*)lds_raw, Qb, Kb, Vb, MIX); if (BOTH(5)) GRID_BAR(); }
    if (IN(6)) { ph_mla_norm(MIX, p.g_mla_out); ph_rw_prep1(PROJ, p.rw_mu, Rb, K1, V1, LIN); if (BOTH(6)) GRID_BAR(); }
    if (IN(7)) {
        ph_gemm<float, float>(lds, LIN, 256, nullptr, nullptr, p.rw_w2, 512, WPRE, 512, T, 512, 64, nullptr, 0);
        ph_gemm<float, float>(lds, LIN + 64, 256, nullptr, nullptr, p.rw_a2, 512, APRE, 512, T, 512, 64, nullptr, 0);
        ph_gemm<float, float>(lds, LIN + 128, 256, nullptr, nullptr, p.rw_g2, 512, G, 512, T, 512, 128, nullptr, 0);
        if (BOTH(7)) GRID_BAR(); }
    if (IN(8)) { ph_rw_prep2(K1, WPRE, APRE, p.rw_w0, p.rw_a0, p.rw_k_k, p.rw_k_a, KK, BB, DEC); if (BOTH(8)) GRID_BAR(); }
    if (IN(9)) { ph_rw_scan(lds, Rb, K1, V1, KK, BB, DEC, Y); if (BOTH(9)) GRID_BAR(); }
    if (IN(10)) { ph_rw_post(Y, Rb, K1, V1, G, p.rw_r_k, p.rw_lnx_g, p.rw_lnx_b, MIX); if (BOTH(10)) GRID_BAR(); }
    if (IN(11)) {
        pg8::Gemm g{MIX, W_o_t, T, D, D, D, D}; pg8::StaticOrder So; So.init(T, D, (int)gridDim.x, (int)blockIdx.x);
        pg8::EpiF32Res E{p.x, p.out, D};
        pg8::gemm_phase<pg8::EpiF32Res, pg8::StaticOrder, PG8_ALIGN, PG8_SP2, D, D, D>(lds, g, So, E);
        if (BOTH(11)) GRID_BAR(); }
    bf16_t* H2S = (bf16_t*)(ws + 4 * MiB);
    bf16_t* Wgu_t = (bf16_t*)(ws + 148 * MiB);
    bf16_t* Wd_t = (bf16_t*)(ws + 180 * MiB);
    bf16_t* HID = (bf16_t*)(ws + 196 * MiB);
    bf16_t* YS = (bf16_t*)(ws + 232 * MiB);
    int* POS = (int*)(small + 8 * T); float* ROWW = small + 10 * T; int* CNT = (int*)(small + 13 * T); int* TILE_E = (int*)(small + 13 * T + 8192);
    if (IN(12)) { ph_moe_route(lds, p.out, p.g_ffn, p.w_group, p.b_group, p.w_expert, p.b_expert, p.w_gate, p.w_up, p.w_down, Wgu_t, Wd_t, EID, EW, RSF, CNT); if (BOTH(12)) GRID_BAR(); }
    if (IN(13)) { ph_moe_scatter(lds, p.out, RSF, EID, EW, CNT, POS, ROWW, H2S, TILE_E); if (BOTH(13)) GRID_BAR(); }
    if (IN(14)) {
        const int ntiles = TILE_E[MOE_MAXT];
        pg8::Gemm g{H2S, Wgu_t, 0, 0, D, D, D}; pg8::MoeOrder<2> So{TILE_E, ntiles * 2, (int)gridDim.x, (int)blockIdx.x};
        pg8::EpiSwiGLU E{HID, ROWW};
        pg8::gemm_phase<pg8::EpiSwiGLU, pg8::MoeOrder<2>, PG8_ALIGN, PG8_SP2, D, D, D>(lds, g, So, E);
        if (BOTH(14)) GRID_BAR(); }
    if (IN(15)) {
        const int ntiles = TILE_E[MOE_MAXT];
        pg8::Gemm g{HID, Wd_t, 0, 0, DE, DE, DE}; pg8::MoeOrder<4> So{TILE_E, ntiles * 4, (int)gridDim.x, (int)blockIdx.x};
        pg8::EpiBf16Mod<4> E{YS, D};
        pg8::gemm_phase<pg8::EpiBf16Mod<4>, pg8::MoeOrder<4>, PG8_ALIGN, PG8_SP2, DE, DE, DE>(lds, g, So, E);
        if (BOTH(15)) GRID_BAR(); }
    if (IN(16)) { ph_moe_combine(p.out, YS, POS); }
}

extern "C" void kernel_launch(void* const* d_in, const int* in_sizes, int n_in, void* d_out, int out_size, void* d_ws, size_t ws_size, hipStream_t stream) {
    static int grid = 0;
    if (grid == 0) {
        if (n_in != 32 || out_size != T * D || ws_size < 512 * MiB) { fprintf(stderr, "kernel_launch: unexpected shapes (n_in %d out %d ws %zu)\n", n_in, out_size, ws_size); grid = -1; return; }
        int dev = 0, cus = 0, per_cu = 0;
        if (hipGetDevice(&dev) != hipSuccess || hipDeviceGetAttribute(&cus, hipDeviceAttributeMultiprocessorCount, dev) != hipSuccess) { grid = -1; return; }
        if (hipFuncSetAttribute((const void*)mk_fwd, hipFuncAttributeMaxDynamicSharedMemorySize, LDS_BYTES) != hipSuccess) { fprintf(stderr, "kernel_launch: hipFuncSetAttribute failed\n"); grid = -1; return; }
        if (hipOccupancyMaxActiveBlocksPerMultiprocessor(&per_cu, (const void*)mk_fwd, NTHR, LDS_BYTES) != hipSuccess || per_cu < 1) { fprintf(stderr, "kernel_launch: occupancy query says %d blocks/CU\n", per_cu); grid = -1; (void)hipGetLastError(); return; }
        grid = cus;
        if (T % grid != 0 || (T / grid) * 2 > NTHR) { fprintf(stderr, "kernel_launch: unsupported CU count %d\n", cus); grid = -1; return; }
    }
    if (grid < 0) return;
    (void)hipMemsetAsync((char*)d_ws + WS_CTL, 0, CTL_ZERO_BYTES, stream);
    Params p{};
    p.x = (const float*)d_in[0]; p.pos = (const int*)d_in[1];
    p.g_mix = (const float*)d_in[2]; p.w_in = (const float*)d_in[3]; p.g_cq = (const float*)d_in[4]; p.w_uq = (const float*)d_in[5];
    p.g_ckv = (const float*)d_in[6]; p.w_uk = (const float*)d_in[7]; p.w_uv = (const float*)d_in[8]; p.g_qn = (const float*)d_in[9];
    p.g_kn = (const float*)d_in[10]; p.g_mla_out = (const float*)d_in[11]; p.rw_mu = (const float*)d_in[12]; p.rw_w0 = (const float*)d_in[13];
    p.rw_w2 = (const float*)d_in[14]; p.rw_a0 = (const float*)d_in[15]; p.rw_a2 = (const float*)d_in[16]; p.rw_g2 = (const float*)d_in[17];
    p.rw_k_k = (const float*)d_in[18]; p.rw_k_a = (const float*)d_in[19]; p.rw_r_k = (const float*)d_in[20]; p.rw_lnx_g = (const float*)d_in[21];
    p.rw_lnx_b = (const float*)d_in[22]; p.w_o = (const float*)d_in[23]; p.g_ffn = (const float*)d_in[24]; p.w_group = (const float*)d_in[25];
    p.b_group = (const float*)d_in[26]; p.w_expert = (const float*)d_in[27]; p.b_expert = (const float*)d_in[28]; p.w_gate = (const float*)d_in[29];
    p.w_up = (const float*)d_in[30]; p.w_down = (const float*)d_in[31];
    p.out = (float*)d_out; p.ws = (unsigned char*)d_ws;
#if MK_PER_PHASE
    for (int k = 0; k < N_PHASES; ++k) { p.ph_lo = k; p.ph_hi = k + 1; hipLaunchKernelGGL(mk_fwd, dim3(grid), dim3(NTHR), LDS_BYTES, stream, p); }
#else
    p.ph_lo = 0; p.ph_hi = N_PHASES;
    hipLaunchKernelGGL(mk_fwd, dim3(grid), dim3(NTHR), LDS_BYTES, stream, p);
#endif
}
```

```cpp
#include <hip/hip_runtime.h>
#include <stdint.h>
#include <math.h>
#include <cstdio>

#ifndef PROBE_MASK
#define PROBE_MASK 0u
#endif
#define NREP(k) (((PROBE_MASK >> (k)) & 1u) ? 3 : 1)
#ifndef MK_PER_PHASE
#define MK_PER_PHASE 0
#endif

typedef unsigned short bf16_t;
constexpr int NB = 4, S = 8192, D = 1024, T = NB * S;
constexpr int H = 8, NOPE = 64, ROPE = 32, QK = 96, VD = 64, MLAW = 512, QR = 256, KVR = 128;
constexpr int RH = 8, RN = 64, RW = 512;
constexpr int MLA_IN = 416, RWKV_IN = 1792, INW = 2208;
constexpr int NG = 4, EPG = 8, NE = 32, DE = 256;
constexpr int NTHR = 512, LDS_BYTES = 147456;

#define LAS __attribute__((address_space(3)))
#define WAVE_SYNC() asm volatile("s_waitcnt lgkmcnt(0)" ::: "memory")
#define LDS_BARRIER() asm volatile("s_waitcnt lgkmcnt(0)\n\ts_barrier" ::: "memory")

__device__ __forceinline__ float bf2f(bf16_t v) { return __uint_as_float(((unsigned)v) << 16); }
__device__ __forceinline__ bf16_t f2bf(float f) { unsigned u = __float_as_uint(f); return (bf16_t)((u + 0x7fffu + ((u >> 16) & 1u)) >> 16); }
__device__ __forceinline__ float ldf(const float* p) { return *p; }
__device__ __forceinline__ float ldf(const bf16_t* p) { return bf2f(*p); }
__device__ __forceinline__ void stf(float* p, float v) { *p = v; }
__device__ __forceinline__ void stf(bf16_t* p, float v) { *p = f2bf(v); }

__device__ __forceinline__ int otid() { int t = threadIdx.x; asm volatile("" : "+v"(t)); return t; }
#define XB_TMO      128
#define XB_XCNT(j)  (256  + 64 * (j))
#define XB_XSUB(j)  (1280 + 64 * (j))
#define XB_XGEN(j)  (2304 + 64 * (j))
#define XB_TOP      3328
#define XB_TOPGEN   3392
#define XCD_BAR_WORDS 3456
#define XB_SPIN_CAP (1u << 18)
__device__ __forceinline__ unsigned xb_ld(unsigned* p)              { return __hip_atomic_load(p, __ATOMIC_RELAXED, __HIP_MEMORY_SCOPE_AGENT); }
__device__ __forceinline__ unsigned xb_add(unsigned* p, unsigned v) { return __hip_atomic_fetch_add(p, v, __ATOMIC_RELAXED, __HIP_MEMORY_SCOPE_AGENT); }
__device__ __forceinline__ unsigned xb_xcc_id() { return (unsigned)__builtin_amdgcn_s_getreg((3 << 11) | 20) & 0xFu; }
#define XB_SPIN(cond, bar) do { unsigned _sp = 0; while (cond) { __builtin_amdgcn_s_sleep(1); \
    if ((++_sp & 255u) == 0u) { if (xb_ld(&(bar)[XB_TMO])) break; if (_sp > XB_SPIN_CAP) { atomicAdd(&(bar)[XB_TMO], 1u); break; } } } } while (0)
struct XcdBarrier { unsigned* bar; unsigned x; volatile LAS unsigned* st; };
__device__ __forceinline__ XcdBarrier xcd_barrier_post(unsigned* bar, volatile LAS unsigned* st) {
    XcdBarrier b; b.bar = bar; b.x = xb_xcc_id(); b.st = st;
    if (threadIdx.x == 0) (void)xb_add(&bar[XB_XCNT(b.x)], 1u);
    return b;
}
__device__ __forceinline__ void xcd_barrier_complete(unsigned* bar, unsigned x, unsigned& nloc, unsigned& nx) {
    const unsigned G = gridDim.x * gridDim.y * gridDim.z;
    unsigned sum, cnt, mine, sp = 0u;
    for (;;) {
        sum = 0u; cnt = 0u; mine = 0u;
#pragma unroll
        for (unsigned j = 0; j < 16; ++j) { const unsigned c = xb_ld(&bar[XB_XCNT(j)]); sum += c; cnt += (c > 0u) ? 1u : 0u; mine = (j == x) ? c : mine; }
        if (sum == G) break;
        __builtin_amdgcn_s_sleep(1);
        if ((++sp & 255u) == 0u) { if (xb_ld(&bar[XB_TMO])) break; if (sp > XB_SPIN_CAP) { atomicAdd(&bar[XB_TMO], 1u); break; } }
    }
    nloc = mine > 0u ? mine : 1u; nx = cnt > 0u ? cnt : 1u;
}
__device__ __forceinline__ void xcd_barrier(const XcdBarrier& b) {
    asm volatile("s_waitcnt vmcnt(0)" ::: "memory");
    __syncthreads();
    if (threadIdx.x == 0) {
        unsigned* bar = b.bar;
        __builtin_amdgcn_s_waitcnt(0);
        unsigned nloc = b.st[0], nx = b.st[1];
        if (nloc == 0u) { xcd_barrier_complete(bar, b.x, nloc, nx); b.st[0] = nloc; b.st[1] = nx; }
        const unsigned old = xb_add(&bar[XB_XSUB(b.x)], 1u);
        const unsigned gen = old / nloc;
        if (old + 1u == (gen + 1u) * nloc) {
            __builtin_amdgcn_fence(__ATOMIC_RELEASE, "agent");
            asm volatile("s_waitcnt vmcnt(0)" ::: "memory");
            const unsigned og = xb_add(&bar[XB_TOP], 1u);
            const unsigned tg = og / nx;
            if (og + 1u == (tg + 1u) * nx) xb_add(&bar[XB_TOPGEN], 1u);
            else XB_SPIN(xb_ld(&bar[XB_TOPGEN]) == tg, bar);
            __builtin_amdgcn_fence(__ATOMIC_ACQUIRE, "agent");
            xb_add(&bar[XB_XGEN(b.x)], 1u);
            asm volatile("s_waitcnt vmcnt(0)" ::: "memory");
        } else {
            XB_SPIN(xb_ld(&bar[XB_XGEN(b.x)]) == gen, bar);
            __builtin_amdgcn_fence(__ATOMIC_ACQUIRE, "agent");
            asm volatile("s_waitcnt vmcnt(0)" ::: "memory");
        }
    }
    __syncthreads();
}

namespace pg8 {
#define PG8_LAS __attribute__((address_space(3)))
typedef unsigned short bf16_t;
typedef short bf16x8 __attribute__((ext_vector_type(8)));
typedef float f32x4 __attribute__((ext_vector_type(4)));
typedef unsigned u32x4 __attribute__((ext_vector_type(4)));
constexpr int BM = 256, BK = 64, HALF = 128, HTB = HALF * BK * 2  , STAGE_BYTES = 8 * HTB, NXCD = 8, WGM = 8;

__host__ __device__ __forceinline__ int lds_byte(int r, int c) { const int st = (r >> 4) * 2 + (c >> 5), rr = r & 15, cc = c & 31, ob = rr * 64 + cc * 2; return st * 1024 + (ob ^ (((ob >> 9) & 1) << 5)); }
__host__ __device__ __forceinline__ void stage_rc(int b, int& R, int& C) { const int st = b / 1024, sb = b % 1024, swz = sb ^ (((sb >> 9) & 1) << 5); R = (st >> 1) * 16 + swz / 64; C = (st & 1) * 32 + (swz % 64) / 2; }
__host__ __device__ __forceinline__ int perm32(int rho) { const int n = rho >> 4, i = rho & 15; return 8 * (i >> 2) + 4 * n + (i & 3); }

struct Unit { int pm, pn, ao; int tag = 0; };
struct Gemm { const bf16_t* A; const bf16_t* Bt; int M, N, K, lda, ldb; const int* src; };

struct StaticOrder {
    int nM, nN, nwg, G, c;
    __host__ __device__ void init(int M, int N, int G_, int c_) { nM = M / BM; nN = N / BM; nwg = nM * nN; G = G_; c = c_; }
    __host__ __device__ bool next(int i, Unit& u) const {
        const long L = (long)i * G + c; if (L >= nwg) return false;
        int wgid = (int)L; { const int q = nwg / NXCD, r = nwg % NXCD, xcd = wgid % NXCD, off = wgid / NXCD; wgid = (xcd < r ? xcd * (q + 1) : r * (q + 1) + (xcd - r) * q) + off; }
        const int nig = WGM * nN, gid = wgid / nig, fm = gid * WGM, gsz = (nM - fm) < WGM ? (nM - fm) : WGM;
        u.pm = fm + ((wgid % nig) % gsz); u.pn = (wgid % nig) / gsz; u.ao = 0; return true;
    }
    __device__ __forceinline__ void a_ready(const Unit&) const {}
    __device__ __forceinline__ void done(const Unit&) const {}
};

__device__ __forceinline__ unsigned cvt_pk_bf16(float lo, float hi) { unsigned r; asm volatile("v_cvt_pk_bf16_f32 %0, %1, %2" : "=v"(r) : "v"(lo), "v"(hi)); return r; }
typedef float f32x2 __attribute__((ext_vector_type(2)));
__device__ __forceinline__ f32x2 gelu_pk(f32x2 v) {
    const f32x2 av = __builtin_elementwise_abs(v), d = av * 0.2316418882f + 1.0f;
    f32x2 t; t.x = __builtin_amdgcn_rcpf(d.x); t.y = __builtin_amdgcn_rcpf(d.y);
    f32x2 q = t * 0.5307027145f + (-0.7265760135f); q = q * t + 0.7107068705f; q = q * t + (-0.142248368f); q = q * t + 0.127414796f; q = q * t;
    const f32x2 s = (v * v) * (-0.72134752044f);
    f32x2 e; e.x = __builtin_amdgcn_exp2f(s.x); e.y = __builtin_amdgcn_exp2f(s.y);
    const f32x2 m = v * (q * e), r = v - m;
    f32x2 o; o.x = v.x < 0.f ? m.x : r.x; o.y = v.y < 0.f ? m.y : r.y; return o;
}

template <int ACT  > struct EpiBf16 {
    static constexpr bool PERM = true, AFTER_DRAIN = false; static_assert(ACT == 0 || ACT == 1, "EpiBf16: ACT is 0 (none) or 1 (gelu_pk)");
    bf16_t* O; int ldc; const float* bias; int split_cols; size_t split_stride; float scale0;
    __device__ __forceinline__ void operator()(const f32x4 (&acc)[2][2][4][2], const Unit& u, int wr, int wc, int fr, int fq) const {
        const int row0 = u.pm * BM + wr * 64 + fr; int colt = u.pn * BM; bf16_t* base = O;
        float sc = 1.f; if (split_cols) { const int t = colt / split_cols; base += (size_t)t * split_stride; colt -= t * split_cols; if (t == 0) sc = scale0; }
        const int col0 = colt + wc * 32 + 8 * fq, bcol0 = u.pn * BM + wc * 32 + 8 * fq;
        f32x4 bv[2][2];
#pragma unroll
        for (int bj = 0; bj < 2; ++bj)
#pragma unroll
            for (int n = 0; n < 2; ++n) bv[bj][n] = bias ? *(const f32x4*)(bias + bcol0 + bj * HALF + 4 * n) : (f32x4){0.f, 0.f, 0.f, 0.f};
#pragma unroll
        for (int ai = 0; ai < 2; ++ai)
#pragma unroll
            for (int m = 0; m < 4; ++m) { bf16_t* rowp = base + (size_t)(row0 + ai * HALF + m * 16) * ldc + col0;
#pragma unroll
                for (int bj = 0; bj < 2; ++bj) { f32x4 v0 = acc[ai][bj][m][0] + bv[bj][0], v1 = acc[ai][bj][m][1] + bv[bj][1];
                    if (ACT == 1) { f32x2 a = gelu_pk((f32x2){v0[0], v0[1]}), b = gelu_pk((f32x2){v0[2], v0[3]}), c = gelu_pk((f32x2){v1[0], v1[1]}), d = gelu_pk((f32x2){v1[2], v1[3]});
                        v0 = (f32x4){a.x, a.y, b.x, b.y}; v1 = (f32x4){c.x, c.y, d.x, d.y}; }
                    v0 = v0 * sc; v1 = v1 * sc; u32x4 w; w.x = cvt_pk_bf16(v0[0], v0[1]); w.y = cvt_pk_bf16(v0[2], v0[3]); w.z = cvt_pk_bf16(v1[0], v1[1]); w.w = cvt_pk_bf16(v1[2], v1[3]);
                    *(u32x4*)(rowp + bj * HALF) = w; } }
    }
};
template <class Epi, class Sched, bool ALIGN_EPI, bool SP2, int KK, int LDA, int LDB, bool GATHER = false>
__device__ __forceinline__ void gemm_phase(PG8_LAS unsigned char* lds, const Gemm g, const Sched& S, const Epi& E) {
    const int tid = threadIdx.x, wid = __builtin_amdgcn_readfirstlane(tid >> 6), lane = tid & 63, wr = wid >> 2, wc = wid & 3, fr = lane & 15, fq = lane >> 4;
    constexpr int K = KK, nt = K / BK; static_assert(nt % 2 == 0 && nt >= 2, "K must be a multiple of 128");
    unsigned voffA[2], voffB[2];
#pragma unroll
    for (int i = 0; i < 2; ++i) { int R, C; stage_rc(tid * 16 + i * 8192, R, C); const int Rb = Epi::PERM ? ((R & ~31) + perm32(R & 31)) : R;
        voffA[i] = (unsigned)(R * LDA + C) * 2u; voffB[i] = (unsigned)(Rb * LDB + C) * 2u; }
    constexpr size_t kstep = (size_t)(BK * 2);
    constexpr size_t hstepA = (size_t)HALF * LDA * 2, hstepB = (size_t)HALF * LDB * 2;
    constexpr size_t tstepA = 2 * hstepA, tstepB = 2 * hstepB;
    const unsigned ldsw = (unsigned)wid * 1024u;
    const int aoff = lds_byte(wr * 64 + fr, fq * 8), boff = lds_byte(wc * 32 + fr, fq * 8);
#define PG8_SA(b, h) (((b) * 2 + (h)) * HTB)
#define PG8_SB(b, h) ((4 + (b) * 2 + (h)) * HTB)
#define PG8_STAGE(bufoff, gbase, voff) do { _Pragma("unroll") for (int _i = 0; _i < 2; ++_i) \
        __builtin_amdgcn_global_load_lds((const unsigned*)((const char*)(gbase) + (voff)[_i]), (PG8_LAS unsigned*)(lds + (bufoff) + ldsw + _i * 8192), 16, 0, 0); } while (0)
#define PG8_STA(bufoff, basep, h, nx) do { if constexpr (GATHER) { if (nx) PG8_STAGE(bufoff, basep, offN[h]); else PG8_STAGE(bufoff, basep, offC[h]); } else PG8_STAGE(bufoff, (basep) + (h) * hstepA, voffA); } while (0)
#define PG8_LDA(dst, b, h) do { _Pragma("unroll") for (int m = 0; m < 4; ++m) _Pragma("unroll") for (int k = 0; k < 2; ++k) dst[m][k] = *(const PG8_LAS bf16x8*)(lds + PG8_SA(b, h) + aoff + m * 2048 + k * 1024); } while (0)
#define PG8_LDB(dst, b, h) do { _Pragma("unroll") for (int n = 0; n < 2; ++n) _Pragma("unroll") for (int k = 0; k < 2; ++k) dst[n][k] = *(const PG8_LAS bf16x8*)(lds + PG8_SB(b, h) + boff + n * 2048 + k * 1024); } while (0)
#define PG8_MMA(ai, bj, At, Bt) do { __builtin_amdgcn_s_setprio(1); _Pragma("unroll") for (int m = 0; m < 4; ++m) _Pragma("unroll") for (int n = 0; n < 2; ++n) _Pragma("unroll") for (int k = 0; k < 2; ++k) \
        acc[ai][bj][m][n] = __builtin_amdgcn_mfma_f32_16x16x32_bf16(Bt[n][k], At[m][k], acc[ai][bj][m][n], 0, 0, 0); __builtin_amdgcn_s_setprio(0); } while (0)
#define PG8_WAIT_V(n) asm volatile("s_waitcnt vmcnt(" #n ")" ::: "memory")
#define PG8_WAIT_L(n) asm volatile("s_waitcnt lgkmcnt(" #n ")" ::: "memory")
#define PG8_BAR __builtin_amdgcn_s_barrier()
#define PG8_SCHED __builtin_amdgcn_sched_barrier(0)
    Unit cur, nxt; int ui = 0;
    if (!S.next(0, cur)) return;
    f32x4 acc[2][2][4][2];
#pragma unroll
    for (int a = 0; a < 2; ++a)
#pragma unroll
        for (int b = 0; b < 2; ++b)
#pragma unroll
            for (int m = 0; m < 4; ++m)
#pragma unroll
                for (int n = 0; n < 2; ++n) acc[a][b][m][n] = (f32x4){0.f, 0.f, 0.f, 0.f};
    bf16x8 At[4][2], B0[2][2], B1[2][2];
    const char* cA = GATHER ? (const char*)g.A : (const char*)g.A + (size_t)cur.pm * tstepA + cur.ao; const char* cB = (const char*)g.Bt + (size_t)cur.pn * tstepB;
    unsigned offC[2][2], offN[2][2];
    auto unit_offs = [&](const Unit& u_, unsigned (&o_)[2][2]) {
#pragma unroll
        for (int h_ = 0; h_ < 2; ++h_)
#pragma unroll
            for (int i_ = 0; i_ < 2; ++i_) { int R_, C_; stage_rc(tid * 16 + i_ * 8192, R_, C_); o_[h_][i_] = ((unsigned)g.src[u_.pm * BM + h_ * HALF + R_] * (unsigned)LDA + (unsigned)C_) * 2u; } };
    if constexpr (GATHER) { unit_offs(cur, offC); _Pragma("unroll") for (int h_ = 0; h_ < 2; ++h_) _Pragma("unroll") for (int i_ = 0; i_ < 2; ++i_) offN[h_][i_] = offC[h_][i_]; }
    S.a_ready(cur);
    if constexpr (SP2) {
        PG8_STAGE(PG8_SB(0, 0), cB, voffB); PG8_STAGE(PG8_SB(0, 1), cB + hstepB, voffB); PG8_STA(PG8_SA(0, 0), cA, 0, false); PG8_STA(PG8_SA(0, 1), cA, 1, false);
        if (wr == 1) PG8_BAR;
        PG8_WAIT_V(2); PG8_BAR;
        PG8_STAGE(PG8_SB(1, 0), cB + kstep, voffB); PG8_STA(PG8_SA(1, 0), cA + kstep, 0, false); PG8_STAGE(PG8_SB(1, 1), cB + hstepB + kstep, voffB);
        PG8_WAIT_V(6); PG8_BAR;
    } else {
        PG8_STAGE(PG8_SB(0, 0), cB, voffB); PG8_STAGE(PG8_SA(0, 0), cA, voffA); PG8_STAGE(PG8_SB(0, 1), cB + hstepB, voffB); PG8_STAGE(PG8_SA(0, 1), cA + hstepA, voffA);
        if (wr == 1) PG8_BAR;
        PG8_WAIT_V(4); PG8_BAR;
        PG8_STAGE(PG8_SB(1, 0), cB + kstep, voffB); PG8_STAGE(PG8_SA(1, 0), cA + kstep, voffA); PG8_STAGE(PG8_SB(1, 1), cB + hstepB + kstep, voffB);
        PG8_WAIT_V(6); PG8_BAR;
    }
    for (;;) {
        const bool has_next = S.next(ui + 1, nxt);
        const char* nA = GATHER ? cA : (has_next ? (const char*)g.A + (size_t)nxt.pm * tstepA + nxt.ao : cA);
        if constexpr (GATHER) { if (has_next) unit_offs(nxt, offN); } const char* nB = has_next ? (const char*)g.Bt + (size_t)nxt.pn * tstepB : cB;
_Pragma("unroll 1")
        for (int t = 0; t < nt; t += 2) {
            const bool last = (t == nt - 2);
            const char* a1 = cA + (size_t)(t + 1) * kstep;
            const char* a2 = last ? nA : cA + (size_t)(t + 2) * kstep; const char* b2 = last ? nB : cB + (size_t)(t + 2) * kstep;
            const char* a3 = a2 + kstep; const char* b3 = b2 + kstep;
            if (last && has_next) S.a_ready(nxt);
            if constexpr (SP2) {
            PG8_LDB(B0, 0, 0); PG8_LDB(B1, 0, 1); PG8_SCHED; PG8_LDA(At, 0, 0); PG8_STA(PG8_SA(1, 1), a1, 1, false);
            PG8_WAIT_V(8); PG8_WAIT_L(0); PG8_BAR; PG8_MMA(0, 0, At, B0); PG8_MMA(0, 1, At, B1); PG8_BAR; PG8_SCHED;
            PG8_LDA(At, 0, 1); PG8_STAGE(PG8_SB(0, 0), b2, voffB); PG8_STAGE(PG8_SB(0, 1), b2 + hstepB, voffB); PG8_STA(PG8_SA(0, 0), a2, 0, last);
            PG8_WAIT_V(8); PG8_WAIT_L(0); PG8_BAR; PG8_MMA(1, 0, At, B0); PG8_MMA(1, 1, At, B1); PG8_BAR; PG8_SCHED;
            PG8_LDB(B0, 1, 0); PG8_LDB(B1, 1, 1); PG8_SCHED; PG8_LDA(At, 1, 0); PG8_STA(PG8_SA(0, 1), a2, 1, last);
            PG8_WAIT_V(8); PG8_WAIT_L(0); PG8_BAR; PG8_MMA(0, 0, At, B0); PG8_MMA(0, 1, At, B1); PG8_BAR; PG8_SCHED;
            PG8_LDA(At, 1, 1); PG8_STAGE(PG8_SB(1, 0), b3, voffB); PG8_STAGE(PG8_SB(1, 1), b3 + hstepB, voffB); PG8_STA(PG8_SA(1, 0), a3, 0, last);
            PG8_WAIT_V(8); PG8_WAIT_L(0); PG8_BAR; PG8_MMA(1, 0, At, B0); PG8_MMA(1, 1, At, B1); PG8_BAR; PG8_SCHED;
            } else {
            PG8_LDB(B0, 0, 0); PG8_SCHED; PG8_LDA(At, 0, 0); PG8_STAGE(PG8_SA(1, 1), a1 + hstepA, voffA);
            PG8_WAIT_L(8); PG8_BAR; PG8_WAIT_L(0); PG8_MMA(0, 0, At, B0); PG8_BAR; PG8_SCHED;
            PG8_LDB(B1, 0, 1); PG8_STAGE(PG8_SB(0, 0), b2, voffB);
            PG8_BAR; PG8_WAIT_L(0); PG8_MMA(0, 1, At, B1); PG8_BAR;
            PG8_LDA(At, 0, 1); PG8_STAGE(PG8_SA(0, 0), a2, voffA);
            PG8_BAR; PG8_WAIT_L(0); PG8_MMA(1, 0, At, B0); PG8_BAR; PG8_SCHED;
            PG8_STAGE(PG8_SB(0, 1), b2 + hstepB, voffB);
            PG8_WAIT_V(6); PG8_BAR; PG8_MMA(1, 1, At, B1); PG8_BAR;
            PG8_LDB(B0, 1, 0); PG8_SCHED; PG8_LDA(At, 1, 0); PG8_STAGE(PG8_SA(0, 1), a2 + hstepA, voffA);
            PG8_WAIT_L(8); PG8_BAR; PG8_WAIT_L(0); PG8_MMA(0, 0, At, B0); PG8_BAR; PG8_SCHED;
            PG8_LDB(B1, 1, 1); PG8_STAGE(PG8_SB(1, 0), b3, voffB);
            PG8_BAR; PG8_WAIT_L(0); PG8_MMA(0, 1, At, B1); PG8_BAR;
            PG8_LDA(At, 1, 1); PG8_STAGE(PG8_SA(1, 0), a3, voffA);
            PG8_BAR; PG8_WAIT_L(0); PG8_MMA(1, 0, At, B0); PG8_BAR; PG8_SCHED;
            PG8_STAGE(PG8_SB(1, 1), b3 + hstepB, voffB);
            PG8_WAIT_V(6); PG8_BAR; PG8_MMA(1, 1, At, B1); PG8_BAR;
            }
        }
        if constexpr (ALIGN_EPI) { if (wr == 0) PG8_BAR; }
        if constexpr (!Epi::AFTER_DRAIN) { E(acc, cur, wr, wc, fr, fq); S.done(cur); }
        if (!has_next) break;
#pragma unroll
        for (int a = 0; a < 2; ++a)
#pragma unroll
            for (int b = 0; b < 2; ++b)
#pragma unroll
                for (int m = 0; m < 4; ++m)
#pragma unroll
                    for (int n = 0; n < 2; ++n) acc[a][b][m][n] = (f32x4){0.f, 0.f, 0.f, 0.f};
        cur = nxt; cA = nA; cB = nB; ++ui;
        if constexpr (GATHER) { _Pragma("unroll") for (int h_ = 0; h_ < 2; ++h_) _Pragma("unroll") for (int i_ = 0; i_ < 2; ++i_) offC[h_][i_] = offN[h_][i_]; }
        if constexpr (ALIGN_EPI) { if (wr == 1) PG8_BAR; }
    }
    PG8_WAIT_V(0);
    if constexpr (!ALIGN_EPI) { if (wr == 0) PG8_BAR; }
    PG8_BAR;
    if constexpr (Epi::AFTER_DRAIN) { E.fused(acc, cur, wr, wc, fr, fq, lds, wid, lane); S.done(cur); }
#undef PG8_SA
#undef PG8_SB
#undef PG8_STAGE
#undef PG8_STA
#undef PG8_LDA
#undef PG8_LDB
#undef PG8_MMA
#undef PG8_WAIT_V
#undef PG8_WAIT_L
#undef PG8_BAR
#undef PG8_SCHED
}
}

namespace pg8 {
struct EpiF32Res {
    static constexpr bool PERM = true, AFTER_DRAIN = false;
    const float* base; float* out; int ldc; bf16_t* obf; const float* rowscale;
    __device__ __forceinline__ void operator()(const f32x4 (&acc)[2][2][4][2], const Unit& u, int wr, int wc, int fr, int fq) const {
        const int col0 = u.pn * BM + wc * 32 + 8 * fq;
#pragma unroll
        for (int ai = 0; ai < 2; ++ai)
#pragma unroll
            for (int m = 0; m < 4; ++m) { const int row_ = u.pm * BM + ai * HALF + wr * 64 + m * 16 + fr; const size_t off = (size_t)row_ * ldc + col0; const float rs_ = rowscale[row_];
#pragma unroll
                for (int bj = 0; bj < 2; ++bj) { const f32x4 b0 = *(const f32x4*)(base + off + bj * HALF), b1 = *(const f32x4*)(base + off + bj * HALF + 4);
                    const f32x4 r0 = b0 + acc[ai][bj][m][0] * rs_, r1 = b1 + acc[ai][bj][m][1] * rs_;
                    if (out) { *(f32x4*)(out + off + bj * HALF) = r0; *(f32x4*)(out + off + bj * HALF + 4) = r1; }
                    if (obf) { u32x4 w_; w_.x = cvt_pk_bf16(r0[0], r0[1]); w_.y = cvt_pk_bf16(r0[2], r0[3]); w_.z = cvt_pk_bf16(r1[0], r1[1]); w_.w = cvt_pk_bf16(r1[2], r1[3]); *(u32x4*)(obf + off + bj * HALF) = w_; } } }
    }
};
}

namespace pg8 {
struct EpiBf16RS {
    static constexpr bool PERM = true, AFTER_DRAIN = false;
    bf16_t* O; int ldc; const float* rowscale; int split_cols; size_t split_stride; int ldc_hi;
    const PG8_LAS float* lrs;
    __device__ __forceinline__ void operator()(const f32x4 (&acc)[2][2][4][2], const Unit& u, int wr, int wc, int fr, int fq) const {
        const int row0 = u.pm * BM + wr * 64 + fr; int colt = u.pn * BM; bf16_t* base = O; int ldc = this->ldc;
        if (split_cols) { const int t = colt / split_cols; base += (size_t)t * split_stride; colt -= t * split_cols; if (t > 0 && ldc_hi) ldc = ldc_hi; }
        const int col0 = colt + wc * 32 + 8 * fq;
#pragma unroll
        for (int ai = 0; ai < 2; ++ai)
#pragma unroll
            for (int m = 0; m < 4; ++m) { const int row = row0 + ai * HALF + m * 16; const float sc = lrs ? lrs[256 * u.tag + (row - u.pm * BM)] : (rowscale ? rowscale[row] : 1.f); bf16_t* rowp = base + (size_t)row * ldc + col0;
#pragma unroll
                for (int bj = 0; bj < 2; ++bj) { const f32x4 v0 = acc[ai][bj][m][0] * sc, v1 = acc[ai][bj][m][1] * sc;
                    u32x4 w; w.x = cvt_pk_bf16(v0[0], v0[1]); w.y = cvt_pk_bf16(v0[2], v0[3]); w.z = cvt_pk_bf16(v1[0], v1[1]); w.w = cvt_pk_bf16(v1[2], v1[3]);
                    *(u32x4*)(rowp + bj * HALF) = w; } }
    }
};
struct TagOrder { StaticOrder so;
    __device__ __forceinline__ bool next(int i, Unit& u) const { if (!so.next(i, u)) return false; u.tag = i; return true; }
    __device__ __forceinline__ void a_ready(const Unit&) const {}
    __device__ __forceinline__ void done(const Unit&) const {}
};
struct LoraOrder { StaticOrder so;
    __device__ __forceinline__ bool next(int i, Unit& u) const { if (!so.next(i, u)) return false; u.ao = (u.pn >= 4) ? 256 : 0; return true; }
    __device__ __forceinline__ void a_ready(const Unit&) const {}
    __device__ __forceinline__ void done(const Unit&) const {}
};
}
#ifndef PG8_SP2
#define PG8_SP2 true
#endif
#ifndef PG8_ALIGN
#define PG8_ALIGN true
#endif

typedef unsigned v4u __attribute__((ext_vector_type(4)));
typedef float f32x4 __attribute__((ext_vector_type(4)));
#define GAS __attribute__((address_space(1)))
#define LDS_WAIT() asm volatile("s_waitcnt lgkmcnt(0)" ::: "memory")
__device__ __forceinline__ unsigned pk2(float lo, float hi) { return (unsigned)f2bf(lo) | ((unsigned)f2bf(hi) << 16); }
__device__ __forceinline__ void p0_transpose_item(const float* W, int ldw, int N, const float* kgain, bf16_t* WT, int ldt, int row_off, LAS float* scr, int item, int lane) {
    const int nblk = N / 32, kb = item / nblk, nb = item % nblk, k0 = 64 * kb, n0 = 32 * nb;
    float tv[32];
#pragma unroll
    for (int i = 0; i < 32; ++i) { const int kk = 2 * i + (lane >> 5); tv[i] = W[(size_t)(k0 + kk) * ldw + n0 + (lane & 31)]; }
#pragma unroll
    for (int i = 0; i < 32; ++i) { const int kk = 2 * i + (lane >> 5); float v = tv[i]; if (kgain) v *= kgain[k0 + kk]; scr[kk * 33 + (lane & 31)] = v; }
    LDS_WAIT(); asm volatile("" ::: "memory");
    const int c = lane & 7;
#pragma unroll
    for (int j = 0; j < 4; ++j) { const int n = (lane >> 3) + 8 * j; const LAS float* sp = scr + (8 * c) * 33 + n;
        v4u o; o.x = pk2(sp[0 * 33], sp[1 * 33]); o.y = pk2(sp[2 * 33], sp[3 * 33]); o.z = pk2(sp[4 * 33], sp[5 * 33]); o.w = pk2(sp[6 * 33], sp[7 * 33]);
        *(v4u*)(WT + (size_t)(row_off + n0 + n) * ldt + k0 + 8 * c) = o; }
    LDS_WAIT(); asm volatile("" ::: "memory");
}
__device__ __forceinline__ float wave_sum_dpp(float x) {
    x += __int_as_float(__builtin_amdgcn_update_dpp(0, __float_as_int(x), 0xB1, 0xF, 0xF, true));
    x += __int_as_float(__builtin_amdgcn_update_dpp(0, __float_as_int(x), 0x4E, 0xF, 0xF, true));
    x += __int_as_float(__builtin_amdgcn_update_dpp(0, __float_as_int(x), 0x141, 0xF, 0xF, true));
    x += __int_as_float(__builtin_amdgcn_update_dpp(0, __float_as_int(x), 0x140, 0xF, 0xF, true));
    x += __int_as_float(__builtin_amdgcn_ds_swizzle(__float_as_int(x), 0x401F));
    auto rr = __builtin_amdgcn_permlane32_swap(__float_as_uint(x), __float_as_uint(x), false, false);
    return __uint_as_float(rr[0]) + __uint_as_float(rr[1]);
}
__device__ __forceinline__ float wave_sum(float v) {
#pragma unroll
    for (int o = 1; o < 64; o <<= 1) v += __shfl_xor(v, o);
    return v;
}
__device__ __forceinline__ void rms_row_to_bf16(const float* xrow, bf16_t* orow, int lane) {
    const f32x4* xr = (const f32x4*)xrow + lane;
    f32x4 v[4]; float s = 0.f;
#pragma unroll
    for (int j = 0; j < 4; ++j) { v[j] = xr[64 * j]; s += (v[j].x * v[j].x + v[j].y * v[j].y) + (v[j].z * v[j].z + v[j].w * v[j].w); }
    const float rstd = rsqrtf(wave_sum(s) * (1.f / D) + 1e-6f);
    unsigned long long* o8 = (unsigned long long*)orow + lane;
#pragma unroll
    for (int j = 0; j < 4; ++j) o8[64 * j] = (unsigned long long)pk2(v[j].x * rstd, v[j].y * rstd) | ((unsigned long long)pk2(v[j].z * rstd, v[j].w * rstd) << 32);
}
constexpr int PW = 2304;
struct ProW { const float *x, *w_in, *g_mix, *w_o, *w_uq, *g_cq, *w_uk, *w_uv, *g_ckv, *w2, *a2, *g2, *w_group, *w_expert, *g_ffn, *g_mo; bf16_t *XN, *W_in_t, *W_o_t, *W_uq_t, *W_ukv_t, *W_lora_t; float* WrT; };
__device__ __forceinline__ void ph_prologue(LAS unsigned char* lds, const ProW& w) {
    const int otid_ = otid();
    const int lane = otid_ & 63, wave = otid_ >> 6;
    LAS float* scr = (LAS float*)(lds + wave * 16384);
    const int gw = blockIdx.x * 8 + wave, NGW = gridDim.x * 8;
    constexpr int I_IN = (D / 64) * (INW / 32), I_O = (D / 64) * (D / 32), I_UQ = (QR / 64) * (768 / 32), I_UK = (KVR / 64) * (512 / 32), I_W2 = 512 / 32, I_G2 = 2 * (512 / 32);
    constexpr int E1 = I_IN, E2 = E1 + I_O, E3 = E2 + I_UQ, E4 = E3 + I_UK, E5 = E4 + I_UK, E6 = E5 + I_W2, E7 = E6 + I_W2, E8 = E7 + I_G2;
    for (int it = gw; it < E8; it += NGW) {
        if (it < E1) p0_transpose_item(w.w_in, INW, INW, w.g_mix, w.W_in_t, D, 0, scr, it, lane);
        else if (it < E2) p0_transpose_item(w.w_o, D, D, (it - E1) / (D / 32) < 8 ? w.g_mo : nullptr, w.W_o_t, D, 0, scr, it - E1, lane);
        else if (it < E3) p0_transpose_item(w.w_uq, 768, 768, w.g_cq, w.W_uq_t, QR, 0, scr, it - E2, lane);
        else if (it < E4) p0_transpose_item(w.w_uk, 512, 512, w.g_ckv, w.W_ukv_t, KVR, 0, scr, it - E3, lane);
        else if (it < E5) p0_transpose_item(w.w_uv, 512, 512, w.g_ckv, w.W_ukv_t, KVR, 512, scr, it - E4, lane);
        else if (it < E6) p0_transpose_item(w.w2, 512, 512, nullptr, w.W_lora_t, 128, 0, scr, it - E5, lane);
        else if (it < E7) p0_transpose_item(w.a2, 512, 512, nullptr, w.W_lora_t + 64, 128, 512, scr, it - E6, lane);
        else p0_transpose_item(w.g2, 512, 512, nullptr, w.W_lora_t + 1024 * 128, 128, 0, scr, it - E7, lane);
    }
    for (int i = blockIdx.x * NTHR + otid_; i < (PW - INW) * D / 8; i += gridDim.x * NTHR) ((v4u*)(w.W_in_t + (size_t)INW * D))[i] = (v4u){0u, 0u, 0u, 0u};
    for (int i = blockIdx.x * NTHR + otid_; i < 1024 * 16; i += gridDim.x * NTHR) { const int row = i >> 4, c8 = (i & 15) * 8;
        const bool data = (row < 512) ? (c8 < 64) : (c8 >= 64);
        if (!data) ((v4u*)w.W_lora_t)[i] = (v4u){0u, 0u, 0u, 0u}; }
    for (int i = blockIdx.x * NTHR + otid_; i < 48 * D; i += gridDim.x * NTHR) { const int o = i / D, k = i % D;
        const float v_ = (o < 4) ? w.w_group[k * 4 + o] * w.g_ffn[k] : (o < 36) ? w.w_expert[k * 32 + (o - 4)] * w.g_ffn[k] : 0.f;
        const bf16_t hi_ = f2bf(v_); const float r1_ = v_ - bf2f(hi_); const bf16_t mid_ = f2bf(r1_); const float r2_ = r1_ - bf2f(mid_); const bf16_t lo_ = f2bf(r2_);
        bf16_t* W3 = (bf16_t*)w.WrT; W3[i] = hi_; W3[48 * D + i] = mid_; W3[2 * 48 * D + i] = lo_; }
    for (int m0 = gw; m0 < T; m0 += 2 * NGW) {
        f32x4 v[2][4]; float s[2] = {0.f, 0.f};
#pragma unroll
        for (int k = 0; k < 2; ++k) { const f32x4* xr = (const f32x4*)(w.x + (size_t)(m0 + k * NGW) * D) + lane;
#pragma unroll
            for (int j = 0; j < 4; ++j) v[k][j] = xr[64 * j]; }
        __builtin_amdgcn_sched_barrier(0);
#pragma unroll
        for (int k = 0; k < 2; ++k) {
#pragma unroll
            for (int j = 0; j < 4; ++j) s[k] += (v[k][j].x * v[k][j].x + v[k][j].y * v[k][j].y) + (v[k][j].z * v[k][j].z + v[k][j].w * v[k][j].w);
            const float rstd = rsqrtf(wave_sum_dpp(s[k]) * (1.f / D) + 1e-6f);
            unsigned long long* o8 = (unsigned long long*)(w.XN + (size_t)(m0 + k * NGW) * D) + lane;
#pragma unroll
            for (int j = 0; j < 4; ++j) o8[64 * j] = (unsigned long long)pk2(v[k][j].x * rstd, v[k][j].y * rstd) | ((unsigned long long)pk2(v[k][j].z * rstd, v[k][j].w * rstd) << 32); } }
}

constexpr int MOE_ROWS = 2 * T + NE * 256;
constexpr int MOE_MAXT = MOE_ROWS / 256;
constexpr int UP_OFF = 131072 + 1024;
namespace pg8 {
template <int NJ> struct MoeOrder {
    const int* tile_e; int nunits, G, c;
    __device__ __forceinline__ bool next(int i, Unit& u) const { const int L = i * G + c; if (L >= nunits) return false; u.pm = L / NJ; u.pn = tile_e[u.pm] * NJ + (L % NJ); u.ao = 0; return true; }
    __device__ __forceinline__ void a_ready(const Unit&) const {}
    __device__ __forceinline__ void done(const Unit&) const {}
};
struct EpiSwiGLU {
    static constexpr bool PERM = true, AFTER_DRAIN = false;
    bf16_t* HID; const float* roww; const float* rowrs;
    __device__ __forceinline__ void operator()(const f32x4 (&acc)[2][2][4][2], const Unit& u, int wr, int wc, int fr, int fq) const {
        const int row0 = u.pm * BM + wr * 64 + fr, hc0 = (u.pn & 1) * 128 + wc * 32 + 8 * fq;
#pragma unroll
        for (int ai = 0; ai < 2; ++ai)
#pragma unroll
            for (int m = 0; m < 4; ++m) { const int row = row0 + ai * HALF + m * 16; const float w = roww[row], rs_ = rowrs[row];
                float h[8];
#pragma unroll
                for (int n = 0; n < 2; ++n)
#pragma unroll
                    for (int q = 0; q < 4; ++q) { const float g = acc[ai][0][m][n][q] * rs_, up = acc[ai][1][m][n][q] * rs_;
                        h[n * 4 + q] = g * __builtin_amdgcn_rcpf(1.f + __builtin_amdgcn_exp2f(-1.4426950408889634f * g)) * up * w; }
                u32x4 o; o.x = cvt_pk_bf16(h[0], h[1]); o.y = cvt_pk_bf16(h[2], h[3]); o.z = cvt_pk_bf16(h[4], h[5]); o.w = cvt_pk_bf16(h[6], h[7]);
                *(u32x4*)(HID + (size_t)row * 256 + hc0) = o; }
    }
};
template <int NJ> struct EpiBf16Mod {
    static constexpr bool PERM = true, AFTER_DRAIN = false;
    bf16_t* O; int ldc;
    __device__ __forceinline__ void operator()(const f32x4 (&acc)[2][2][4][2], const Unit& u, int wr, int wc, int fr, int fq) const {
        const int row0 = u.pm * BM + wr * 64 + fr, col0 = (u.pn % NJ) * BM + wc * 32 + 8 * fq;
#pragma unroll
        for (int ai = 0; ai < 2; ++ai)
#pragma unroll
            for (int m = 0; m < 4; ++m) { bf16_t* rowp = O + (size_t)(row0 + ai * HALF + m * 16) * ldc + col0;
#pragma unroll
                for (int bj = 0; bj < 2; ++bj) { const f32x4 v0 = acc[ai][bj][m][0], v1 = acc[ai][bj][m][1];
                    u32x4 w; w.x = cvt_pk_bf16(v0[0], v0[1]); w.y = cvt_pk_bf16(v0[2], v0[3]); w.z = cvt_pk_bf16(v1[0], v1[1]); w.w = cvt_pk_bf16(v1[2], v1[3]);
                    *(u32x4*)(rowp + bj * HALF) = w; } }
    }
};
}

__device__ __forceinline__ void ph_moe_weights(LAS unsigned char* lds, const float* g_ffn, const float* w_gate, const float* w_up, const float* w_down, bf16_t* Wgu_t, bf16_t* Wd_t) {
    const int otid_ = otid();
    const int lane = otid_ & 63, wave = otid_ >> 6, gw = blockIdx.x * 8 + wave, NGW = gridDim.x * 8;
    LAS float* scr = (LAS float*)(lds + wave * 16384);
    constexpr int IPE = (D / 64) * (DE / 32);
    for (int it = gw; it < 2 * NE * IPE; it += NGW) {
        const int mat = it / (NE * IPE), r = it % (NE * IPE), e = r / IPE, item = r % IPE;
        const int nb = item % (DE / 32), n0 = 32 * nb;
        const int row_off = e * 512 + (n0 / 128) * 256 + (n0 % 128) + (mat ? 128 : 0) - n0;
        p0_transpose_item((mat ? w_up : w_gate) + (size_t)e * D * DE, DE, DE, g_ffn, Wgu_t, D, row_off, scr, item, lane);
    }
}
__device__ __forceinline__ void ph_moe_wd_part(LAS unsigned char* lds, const float* w_down, bf16_t* Wd_t, int first) {
    const int otid_ = otid();
    const int lane = otid_ & 63, wave = otid_ >> 6;
    if ((int)blockIdx.x < first) return;
    LAS float* scr = (LAS float*)(lds + wave * 16384);
    constexpr int IPE = (DE / 64) * (D / 32);
    const int gw = ((int)blockIdx.x - first) * 8 + wave, NGW = ((int)gridDim.x - first) * 8;
    for (int it = gw; it < NE * IPE; it += NGW) { const int e = it / IPE, item = it % IPE;
        p0_transpose_item(w_down + (size_t)e * DE * D, D, D, nullptr, Wd_t, DE, e * D, scr, item, lane); }
}
__device__ __forceinline__ void ph_moe_route(LAS unsigned char* lds, const bf16_t* X1, const float* g_ffn, const float* WrT, const float* b_group, const float* b_expert, int* EID, float* EW, float* RSF, int* CNT) {
    const int otid_ = otid();
    const int tid = otid_, lane = tid & 63, wave = tid >> 6, G = gridDim.x, b = blockIdx.x, TPB = T / G;
    LAS int* hist = (LAS int*)(lds + UP_OFF);
    if (tid < 32) hist[tid] = 0;
    __syncthreads();
    typedef float rt_f32x4 __attribute__((ext_vector_type(4)));
    LAS float* lg = (LAS float*)(lds + wave * 4096);
    for (int i0 = wave * 16; i0 < TPB; i0 += 128) {
        const int t0 = b * TPB + i0, r16 = lane & 15, q = lane >> 4;
        const bf16_t* xrow = X1 + (size_t)(t0 + r16) * D + 8 * q;
        constexpr int RT_PITCH = 272, RT_BUF = 144 * RT_PITCH;
        LAS unsigned char* wl = lds + 32768;
        const bf16_t* W3 = (const bf16_t*)WrT;
        typedef short rt_bf16x8 __attribute__((ext_vector_type(8)));
        rt_f32x4 acc0 = {0.f, 0.f, 0.f, 0.f}, acc1 = acc0, acc2 = acc0; float ss = 0.f;
        v4u xq[2][4]; v4u wst[5];
#define RT_LDA(buf, qt) do { _Pragma("unroll") for (int j_ = 0; j_ < 4; ++j_) xq[buf][j_] = *(const v4u*)(xrow + 32 * (4 * (qt) + j_)); } while (0)
        const bf16_t* wg[5];
#pragma unroll
        for (int i_ = 0; i_ < 5; ++i_) { const int p_ = tid + 512 * i_; wg[i_] = W3 + (size_t)((p_ < 2304 ? p_ : 0) >> 4) * D + 8 * (p_ & 15); asm volatile("" : "+v"(wg[i_])); }
#define RT_LDW(c_) do { _Pragma("unroll") for (int i_ = 0; i_ < 5; ++i_) { const int p_ = tid + 512 * i_; if (i_ < 4 || p_ < 2304) wst[i_] = *(const v4u*)(wg[i_] + 128 * (c_)); } } while (0)
#define RT_STW(b_) do { _Pragma("unroll") for (int i_ = 0; i_ < 5; ++i_) { const int p_ = tid + 512 * i_; if (i_ < 4 || p_ < 2304) *(LAS v4u*)(wl + (b_) * RT_BUF + (p_ >> 4) * RT_PITCH + 16 * (p_ & 15)) = wst[i_]; } } while (0)
        RT_LDW(0); RT_LDA(0, 0); RT_STW(0);
        LDS_BARRIER();
#pragma unroll
        for (int qt = 0; qt < 8; ++qt) {
            if (qt < 7) { RT_LDW(qt + 1); RT_LDA((qt + 1) & 1, qt + 1); }
            __builtin_amdgcn_sched_barrier(0);
            const LAS unsigned char* wr_ = wl + (qt & 1) * RT_BUF + r16 * RT_PITCH + 16 * q;
#pragma unroll
            for (int j = 0; j < 4; ++j) {
                v4u wv[9];
#pragma unroll
                for (int i_ = 0; i_ < 9; ++i_) wv[i_] = *(const LAS v4u*)(wr_ + ((i_ / 3) * 48 + 16 * (i_ % 3)) * RT_PITCH + 64 * j);
                __builtin_amdgcn_sched_barrier(0);
                const v4u xw = xq[qt & 1][j];
                const float xf[8] = {__uint_as_float(xw.x << 16), __uint_as_float(xw.x & 0xffff0000u), __uint_as_float(xw.y << 16), __uint_as_float(xw.y & 0xffff0000u),
                                     __uint_as_float(xw.z << 16), __uint_as_float(xw.z & 0xffff0000u), __uint_as_float(xw.w << 16), __uint_as_float(xw.w & 0xffff0000u)};
#pragma unroll
                for (int sp = 0; sp < 8; ++sp) ss += xf[sp] * xf[sp];
                const rt_bf16x8 xa = __builtin_bit_cast(rt_bf16x8, xw);
#pragma unroll
                for (int pi = 0; pi < 3; ++pi) { const int pl = 2 - pi;
                    acc0 = __builtin_amdgcn_mfma_f32_16x16x32_bf16(xa, __builtin_bit_cast(rt_bf16x8, wv[3 * pl]), acc0, 0, 0, 0);
                    acc1 = __builtin_amdgcn_mfma_f32_16x16x32_bf16(xa, __builtin_bit_cast(rt_bf16x8, wv[3 * pl + 1]), acc1, 0, 0, 0);
                    acc2 = __builtin_amdgcn_mfma_f32_16x16x32_bf16(xa, __builtin_bit_cast(rt_bf16x8, wv[3 * pl + 2]), acc2, 0, 0, 0); }
                __builtin_amdgcn_sched_barrier(0);
            }
            if (qt < 7) RT_STW((qt + 1) & 1);
            LDS_BARRIER();
        }
#undef RT_LDA
#undef RT_LDW
#undef RT_STW
        ss += __shfl_xor(ss, 16); ss += __shfl_xor(ss, 32);
        WAVE_SYNC();
#pragma unroll
        for (int r = 0; r < 4; ++r) { const int tk = q * 4 + r; lg[tk * 48 + r16] = acc0[r]; lg[tk * 48 + 16 + r16] = acc1[r]; lg[tk * 48 + 32 + r16] = acc2[r]; }
        if (lane < 16) lg[768 + lane] = ss;
        WAVE_SYNC();
        if (lane < 16) {
            const int t = t0 + lane; const LAS float* ac = lg + lane * 48;
            const float rs = rsqrtf(lg[768 + lane] / D + 1e-6f);
            float gl[4]; int gs = 0; float gm = -INFINITY;
            _Pragma("unroll") for (int g = 0; g < 4; ++g) { gl[g] = ac[g] * rs + b_group[g]; if (gl[g] > gm) { gm = gl[g]; gs = g; } }
            float den = 0.f; _Pragma("unroll") for (int g = 0; g < 4; ++g) den += expf(gl[g] - gm);
            const float gp = 1.f / den;
            float el[8];
            _Pragma("unroll") for (int e = 0; e < 8; ++e) el[e] = ac[4 + gs * 8 + e] * rs + b_expert[gs * 8 + e];
            int i1 = 0; float v1 = el[0];
            _Pragma("unroll") for (int e = 1; e < 8; ++e) if (el[e] > v1) { v1 = el[e]; i1 = e; }
            int i2 = -1; float v2 = -INFINITY;
            _Pragma("unroll") for (int e = 0; e < 8; ++e) if (e != i1 && el[e] > v2) { v2 = el[e]; i2 = e; }
            const float e2 = expf(v2 - v1), w1 = 1.f / (1.f + e2), w2 = e2 / (1.f + e2);
            const int ea = gs * 8 + i1, eb = gs * 8 + i2;
            EID[t * 2] = ea; EID[t * 2 + 1] = eb; EW[t * 2] = w1 * gp; EW[t * 2 + 1] = w2 * gp; RSF[t] = rs;
            __hip_atomic_fetch_add(hist + ea, 1, __ATOMIC_RELAXED, __HIP_MEMORY_SCOPE_WORKGROUP);
            __hip_atomic_fetch_add(hist + eb, 1, __ATOMIC_RELAXED, __HIP_MEMORY_SCOPE_WORKGROUP);
        }
        WAVE_SYNC();
    }
    __syncthreads();
    if (tid < 32) CNT[b * 32 + tid] = hist[tid];
}

__device__ __forceinline__ void ph_moe_scatter(LAS unsigned char* lds, const float* RSF, const int* EID, const float* EW, const int* CNT,
                                               int* POS, float* ROWW, int* SRC, float* ROWRS, int* TILE_E) {
    const int otid_ = otid();
    const int tid = otid_, lane = tid & 63, wave = tid >> 6, G = gridDim.x, b = blockIdx.x, TPB = T / G;
    LAS int* up = (LAS int*)(lds + UP_OFF);
    LAS int* tot = up, *pre = up + 32, *base = up + 64, *ptot = up + 128, *ppre = up + 128 + 512, *epair = up + 128 + 1024;
    { const int e = tid & 31, g = tid >> 5; int st = 0, sp = 0;
      for (int bb = g; bb < G; bb += 16) { const int c = CNT[bb * 32 + e]; st += c; if (bb < b) sp += c; }
      ptot[g * 32 + e] = st; ppre[g * 32 + e] = sp; }
    __syncthreads();
    if (tid < 32) { int st = 0, sp = 0; for (int g = 0; g < 16; ++g) { st += ptot[g * 32 + tid]; sp += ppre[g * 32 + tid]; } tot[tid] = st; pre[tid] = sp; }
    __syncthreads();
    if (tid == 0) { int acc = 0; for (int e = 0; e < NE; ++e) { base[e] = acc; acc += (tot[e] + 255) / 256 * 256; } base[32] = acc; }
    if (tid < 2 * TPB) epair[tid] = EID[(size_t)b * TPB * 2 + tid];
    __syncthreads();
    if (b == 0) { const int ntiles = base[32] / 256;
        if (tid == 0) TILE_E[MOE_MAXT] = ntiles;
        for (int tile = tid; tile < ntiles; tile += NTHR) { int e = 0; for (int q = 1; q < NE; ++q) if (base[q] <= tile * 256) e = q; TILE_E[tile] = e; } }
    if (tid < 2 * TPB) { const int e = epair[tid]; int rank = 0; for (int j = 0; j < tid; ++j) rank += (epair[j] == e) ? 1 : 0;
        const int dest = base[e] + pre[e] + rank; const size_t pi = (size_t)b * TPB * 2 + tid; const int tok = b * TPB + (tid >> 1);
        POS[pi] = dest; ROWW[dest] = EW[pi]; SRC[dest] = tok; ROWRS[dest] = RSF[tok]; }
    if (b < NE) { const int e = b;
        for (int r = base[e] + tot[e] + tid; r < base[e + 1]; r += NTHR) { SRC[r] = 0; ROWW[r] = 0.f; ROWRS[r] = 0.f; } }
}

__device__ __forceinline__ void ph_moe_combine(float* OUT, const bf16_t* X1, const bf16_t* YS, const int* POS) {
    const int otid_ = otid();
    const int lane = otid_ & 63, gw = blockIdx.x * 8 + (otid_ >> 6), NGW = gridDim.x * 8;
#pragma unroll 2
    for (int t = gw; t < T; t += NGW) {
        const int p0 = POS[t * 2], p1 = POS[t * 2 + 1];
        f32x4* orow = (f32x4*)(OUT + (size_t)t * D) + lane;
        const unsigned long long* x0 = (const unsigned long long*)(X1 + (size_t)t * D) + lane;
        const unsigned long long* y0 = (const unsigned long long*)(YS + (size_t)p0 * D) + lane; const unsigned long long* y1 = (const unsigned long long*)(YS + (size_t)p1 * D) + lane;
#pragma unroll
        for (int j = 0; j < 4; ++j) { const unsigned long long x = x0[64 * j], a = y0[64 * j], c = y1[64 * j]; f32x4 v;
            v.x = __uint_as_float((unsigned)(x << 16)) + __uint_as_float((unsigned)(a << 16)) + __uint_as_float((unsigned)(c << 16));
            v.y = __uint_as_float((unsigned)x & 0xffff0000u) + __uint_as_float((unsigned)a & 0xffff0000u) + __uint_as_float((unsigned)c & 0xffff0000u);
            v.z = __uint_as_float((unsigned)(x >> 32) << 16) + __uint_as_float((unsigned)(a >> 32) << 16) + __uint_as_float((unsigned)(c >> 32) << 16);
            v.w = __uint_as_float((unsigned)(x >> 32) & 0xffff0000u) + __uint_as_float((unsigned)(a >> 32) & 0xffff0000u) + __uint_as_float((unsigned)(c >> 32) & 0xffff0000u);
            orow[64 * j] = v; }
    }
}

namespace att {
typedef short bf16x8 __attribute__((ext_vector_type(8)));
typedef short s16x4 __attribute__((ext_vector_type(4)));
typedef float f32x16 __attribute__((ext_vector_type(16)));
typedef unsigned u32x4 __attribute__((ext_vector_type(4)));
typedef float f32x4v __attribute__((ext_vector_type(4)));
constexpr int DQ = 96, DV = 64, QS = 768, KS = 768, VS = 512, OS = 1024;
constexpr int NW = 8, QBLK = 32, KVBLK = 64, QB = NW * QBLK, NQB = S / QB;
constexpr int SHM_V = 8192, SHM_K = 16384;
constexpr int NSLOT = 3;
constexpr int O_WSF = NSLOT * (SHM_V + SHM_K), LDS_BYTES = O_WSF + NW * 64 * 4;
#define KSWZ(row, colB) ((row) * 256 + ((colB) ^ (((row) & 15) << 4)))
#define SBAR() __builtin_amdgcn_sched_barrier(0)
__device__ __forceinline__ int v_st(int k, int c) { const int kk = k; return ((kk >> 3) * 2 + (c >> 5)) * 512 + ((kk & 7) * 32 + (c & 31)) * 2; }
__device__ __forceinline__ int v_rd_base(int lane) { return ((lane & 3) << 3) | (((lane >> 2) & 3) << 6) | (((lane >> 4) & 1) << 5) | (((lane >> 5) & 1) << 8); }
constexpr int v_rd_off(int d0, int ks, int half) { return d0 * 512 + ks * 2048 + half * 1024; }
__device__ __forceinline__ int crow(int r, int hi) { return (r & 3) + 8 * (r >> 2) + 4 * hi; }
__device__ __forceinline__ unsigned cvtpk(float lo, float hi) { unsigned r; asm volatile("v_cvt_pk_bf16_f32 %0, %1, %2" : "=v"(r) : "v"(lo), "v"(hi)); return r; }
__device__ __forceinline__ bf16x8 load8(const bf16_t* p) { return *reinterpret_cast<const bf16x8*>(p); }
__device__ __forceinline__ void mask_tile(f32x16& p0, f32x16& p1, int dq) {
    const float NEG = -__builtin_inff();
#pragma unroll
    for (int r = 0; r < 16; ++r) { const int c = (r & 3) + 8 * (r >> 2); if (dq - c < 0) p0[r] = NEG; if (dq - c - 32 < 0) p1[r] = NEG; }
}
constexpr float THRL = 8.f;
__device__ __forceinline__ float rowmax(const f32x16& p0, const f32x16& p1) {
    float a = fmaxf(fmaxf(p0[0], p0[1]), p1[0]), b = fmaxf(fmaxf(p0[2], p0[3]), p1[1]); a = fmaxf(fmaxf(a, p1[2]), p1[3]);
#pragma unroll
    for (int r = 4; r < 16; r += 4) { a = fmaxf(fmaxf(a, p0[r]), p0[r + 1]); b = fmaxf(fmaxf(b, p0[r + 2]), p0[r + 3]); a = fmaxf(fmaxf(a, p1[r]), p1[r + 1]); b = fmaxf(fmaxf(b, p1[r + 2]), p1[r + 3]); }
    const float m = fmaxf(a, b);
    auto rr = __builtin_amdgcn_permlane32_swap(__float_as_uint(m), __float_as_uint(m), false, false);
    return fmaxf(__uint_as_float(rr[0]), __uint_as_float(rr[1]));
}
__device__ __forceinline__ float bf16r(float x) { return __uint_as_float(cvtpk(x, 0.f) << 16); }
__device__ __forceinline__ s16x4 bias_frag(float v, int hi) { typedef unsigned u32x2b __attribute__((ext_vector_type(2))); u32x2b w = {hi ? 0u : (cvtpk(v, 0.f) & 0xffffu), 0u}; return __builtin_bit_cast(s16x4, w); }
template <bool FIRST>
__device__ __forceinline__ void partialSM(f32x16& p0, f32x16& p1, float& mhat, float& alpha, s16x4& q7, int hi) {
    const float rm = rowmax(p0, p1);
    alpha = 1.f;
    if (FIRST) { mhat = bf16r(rm); q7 = bias_frag(-mhat, hi);
#pragma unroll
        for (int r = 0; r < 16; ++r) { p0[r] -= mhat; p1[r] -= mhat; } }
    else if (__builtin_expect(__any(rm > THRL), 0)) { const float mn = bf16r(mhat + fmaxf(rm, 0.f)), dd = mn - mhat; alpha = __builtin_amdgcn_exp2f(-dd); mhat = mn; q7 = bias_frag(-mhat, hi);
#pragma unroll
        for (int r = 0; r < 16; ++r) { p0[r] -= dd; p1[r] -= dd; } }
#pragma unroll
    for (int r = 0; r < 16; ++r) p0[r] = __builtin_amdgcn_exp2f(p0[r]);
}
__device__ __forceinline__ void finishSM(f32x16& p0, f32x16& p1, float alpha, float& l_reg, bf16x8& pa0, bf16x8& pa1, bf16x8& pa2, bf16x8& pa3) {
#pragma unroll
    for (int r = 0; r < 16; ++r) p1[r] = __builtin_amdgcn_exp2f(p1[r]);
    float s0 = 0.f, s1 = 0.f;
#pragma unroll
    for (int r = 0; r < 16; ++r) { s0 += p0[r]; s1 += p1[r]; }
    float ps = s0 + s1;
    { auto rr = __builtin_amdgcn_permlane32_swap(__float_as_uint(ps), __float_as_uint(ps), false, false); ps = __uint_as_float(rr[0]) + __uint_as_float(rr[1]); }
    l_reg = l_reg * alpha + ps;
#define PK8(P, B_, OUT) do { u32x4 w = {cvtpk(P[B_+0], P[B_+1]), cvtpk(P[B_+2], P[B_+3]), cvtpk(P[B_+4], P[B_+5]), cvtpk(P[B_+6], P[B_+7])}; OUT = *reinterpret_cast<bf16x8*>(&w); } while (0)
    PK8(p0, 0, pa0); PK8(p0, 8, pa1); PK8(p1, 0, pa2); PK8(p1, 8, pa3);
#undef PK8
}
struct KFr { bf16x8 f0[6], f1[6]; };
#ifndef QK_AH_B
#define QK_AH_B 3
#endif
#define QK_ADDR(Ks, d0) ((Ks) + ((d0) < 4 ? KSWZ(r32, (((d0) & 3) * 16 + hi * 8) * 2) : (KSWZ(r32, ((((d0) - 4) & 3) * 16 + hi * 8) * 2) ^ 128)))
#define QK_RD(F, Ks, d0) do { const char* a_ = QK_ADDR(Ks, d0); (F).f0[d0] = *reinterpret_cast<const bf16x8*>(a_); (F).f1[d0] = *reinterpret_cast<const bf16x8*>(a_ + 32 * 256); } while (0)
#define QK_MM(F, d0) do { p0 = __builtin_amdgcn_mfma_f32_32x32x16_bf16((F).f0[d0], qr[d0], p0, 0, 0, 0); p1 = __builtin_amdgcn_mfma_f32_32x32x16_bf16((F).f1[d0], qr[d0], p1, 0, 0, 0); } while (0)
template <int AH> __device__ __forceinline__ void qkt_rd(KFr& F, const char* Ks, int r32, int hi) { QK_RD(F, Ks, 0); if (AH >= 2) QK_RD(F, Ks, 1); if (AH >= 3) QK_RD(F, Ks, 2); SBAR(); }
template <int AH> __device__ __forceinline__ void qkt_mm(KFr& F, f32x16& p0, f32x16& p1, const char* Ks, int r32, int hi, const bf16x8* qr, s16x4 kone, s16x4 q7) {
    p0 = __builtin_amdgcn_mfma_f32_32x32x8bf16_1k(kone, q7, f32x16{}, 0, 0, 0); p1 = __builtin_amdgcn_mfma_f32_32x32x8bf16_1k(kone, q7, f32x16{}, 0, 0, 0);
    if (AH == 1) { QK_RD(F, Ks, 1); QK_RD(F, Ks, 2); SBAR(); }
    if (AH == 2) { QK_RD(F, Ks, 2); SBAR(); }
    QK_MM(F, 0); QK_RD(F, Ks, 3); SBAR();
    QK_MM(F, 1); QK_RD(F, Ks, 4); SBAR();
    QK_MM(F, 2); QK_RD(F, Ks, 5); SBAR();
    QK_MM(F, 3); QK_MM(F, 4); QK_MM(F, 5);
}
__device__ __forceinline__ void qkt(f32x16& p0, f32x16& p1, const char* Ks, int r32, int hi, const bf16x8* qr, s16x4 kone, s16x4 q7) { KFr F; qkt_rd<3>(F, Ks, r32, hi); qkt_mm<3>(F, p0, p1, Ks, r32, hi, qr, kone, q7); }
#undef QK_RD
#undef QK_MM
#undef QK_ADDR
typedef short v4i16_t __attribute__((ext_vector_type(4)));
__device__ __forceinline__ s16x4 vtr(int addr) { return __builtin_bit_cast(s16x4, __builtin_amdgcn_ds_read_tr16_b64_v4i16((__attribute__((address_space(3))) v4i16_t*)(uintptr_t)(unsigned)addr)); }
struct VFr { s16x4 l[2][4], h[2][4]; };
#define PV_RD(F, d_, k_) do { (F).l[d_][k_] = vtr(vb + v_rd_off(d_, 0, 0) + 2048 * (k_)); (F).h[d_][k_] = vtr(vb + v_rd_off(d_, 0, 0) + 2048 * (k_) + 1024); } while (0)
#define PV_MM(F, d_, k_, P_) o[d_] = __builtin_amdgcn_mfma_f32_32x32x16_bf16((bf16x8){(F).l[d_][k_][0], (F).l[d_][k_][1], (F).l[d_][k_][2], (F).l[d_][k_][3], (F).h[d_][k_][0], (F).h[d_][k_][1], (F).h[d_][k_][2], (F).h[d_][k_][3]}, P_, o[d_], 0, 0, 0)
__device__ __forceinline__ void pv_rd(VFr& F, int vb) { PV_RD(F, 0, 0); PV_RD(F, 0, 1); PV_RD(F, 0, 2); PV_RD(F, 0, 3); SBAR(); }
__device__ __forceinline__ void pv_mm(VFr& F, f32x16* o, int vb, bf16x8 pa0, bf16x8 pa1, bf16x8 pa2, bf16x8 pa3) {
    PV_MM(F, 0, 0, pa0); PV_RD(F, 1, 0); SBAR();
    PV_MM(F, 0, 1, pa1); PV_RD(F, 1, 1); SBAR();
    PV_MM(F, 0, 2, pa2); PV_RD(F, 1, 2); SBAR();
    PV_MM(F, 0, 3, pa3); PV_RD(F, 1, 3); SBAR();
    PV_MM(F, 1, 0, pa0); PV_MM(F, 1, 1, pa1); PV_MM(F, 1, 2, pa2); PV_MM(F, 1, 3, pa3);
}
__device__ __forceinline__ void pv_tile(f32x16* o, int vb, bf16x8 pa0, bf16x8 pa1, bf16x8 pa2, bf16x8 pa3) { VFr F; pv_rd(F, vb); pv_mm(F, o, vb, pa0, pa1, pa2, pa3); }
#undef PV_RD
#undef PV_MM
struct BlockRef { const bf16_t* Q; const bf16_t* K; const bf16_t* V; bf16_t* O; float* SS; const int* pos; int P0; };
struct Seam { bf16x8 qr[6]; };
#define VMW() asm volatile("s_waitcnt vmcnt(0)" ::: "memory")
#define VMWN(n) asm volatile("s_waitcnt vmcnt(%0)" :: "i"(n) : "memory")
#define GLDS16(gp, ldsb) __builtin_amdgcn_global_load_lds((const unsigned*)(gp), (__attribute__((address_space(3))) unsigned*)(uintptr_t)(unsigned)(uintptr_t)(ldsb), 16, 0, 0)
#define DMA_IDX() const int krow_ = 4 * wid + (lane >> 4), kcc_ = (lane & 15) ^ (krow_ & 15); \
                  const size_t kof_ = (size_t)krow_ * KS + (kcc_ < 12 ? kcc_ : 0) * 8, vof_ = (size_t)(8 * wid + ((lane & 31) >> 2)) * VS + 32 * (lane >> 5) + 8 * (lane & 3)
#define DMA_K(Kp, k0, sl) do { GLDS16((Kp) + (size_t)(k0) * KS + kof_, K_lds + (sl) * SHM_K + (4 * wid) * 256); GLDS16((Kp) + (size_t)((k0) + 32) * KS + kof_, K_lds + (sl) * SHM_K + (32 + 4 * wid) * 256); } while (0)
#define DMA_V(Vp, k0, sl) GLDS16((Vp) + (size_t)(k0) * VS + vof_, V_lds + (sl) * SHM_V + wid * 1024)
__device__ __forceinline__ void prime(const BlockRef& cur, char* lds, Seam& S) {
    const int tid = otid(), wid = __builtin_amdgcn_readfirstlane(tid >> 6), lane = tid & 63, r32 = lane & 31, hi = lane >> 5;
    DMA_IDX(); (void)vof_; char* K_lds = lds + NSLOT * SHM_V;
#pragma unroll
    for (int d0 = 0; d0 < 6; ++d0) S.qr[d0] = load8(cur.Q + (size_t)(wid * QBLK + r32) * QS + d0 * 16 + hi * 8);
    DMA_K(cur.K, 0, 0); VMW();
    LDS_BARRIER();
}
__device__ __forceinline__ void block(const BlockRef& cur, const BlockRef& nxt, char* lds, Seam& S, const float* g_qn) {
    const int tid = otid(), wid = __builtin_amdgcn_readfirstlane(tid >> 6), lane = tid & 63, r32 = lane & 31, hi = lane >> 5;
    { const float pf = (float)cur.pos[wid * QBLK + r32];
      float x[6][8]; float ss = 0.f;
#pragma unroll
      for (int d0 = 0; d0 < 6; ++d0) { const u32x4 w = __builtin_bit_cast(u32x4, S.qr[d0]);
#pragma unroll
          for (int j = 0; j < 4; ++j) { x[d0][2 * j] = __uint_as_float(w[j] << 16); x[d0][2 * j + 1] = __uint_as_float(w[j] & 0xffff0000u); ss += x[d0][2 * j] * x[d0][2 * j] + x[d0][2 * j + 1] * x[d0][2 * j + 1]; } }
      { auto rr = __builtin_amdgcn_permlane32_swap(__float_as_uint(ss), __float_as_uint(ss), false, false); ss = __uint_as_float(rr[0]) + __uint_as_float(rr[1]); }
      const float rn = rsqrtf(ss * (1.f / DQ) + 1e-6f);
#pragma unroll
      for (int d0 = 0; d0 < 6; ++d0) { const f32x4v g0 = *(const f32x4v*)(g_qn + 16 * d0 + 8 * hi), g1 = *(const f32x4v*)(g_qn + 16 * d0 + 8 * hi + 4);
#pragma unroll
          for (int e = 0; e < 4; ++e) { x[d0][e] *= rn * g0[e]; x[d0][4 + e] *= rn * g1[e]; } }
#pragma unroll
      for (int e = 0; e < 8; ++e) { const float invf = ((const float*)(lds + O_WSF))[8 * hi + e];
          const float rev = __builtin_amdgcn_fractf(pf * invf * 0.15915494309189535f); const float cs = __builtin_amdgcn_cosf(rev), sn = __builtin_amdgcn_sinf(rev);
          const float a = x[4][e], b = x[5][e]; x[4][e] = a * cs - b * sn; x[5][e] = b * cs + a * sn; }
      constexpr float C2q = 0.10206207261596577f * 1.4426950408889634f;
#pragma unroll
      for (int d0 = 0; d0 < 6; ++d0) { u32x4 w = {cvtpk(x[d0][0] * C2q, x[d0][1] * C2q), cvtpk(x[d0][2] * C2q, x[d0][3] * C2q), cvtpk(x[d0][4] * C2q, x[d0][5] * C2q), cvtpk(x[d0][6] * C2q, x[d0][7] * C2q)};
          S.qr[d0] = __builtin_bit_cast(bf16x8, w); } }
    const bool grpB = wid >= 4;
    const int NT = cur.P0 / KVBLK + QB / KVBLK;
    const int qlo = cur.P0 + wid * QBLK, qm = qlo + r32 - 4 * hi;
    char* V_lds = lds; char* K_lds = lds + NSLOT * SHM_V;
    float mhat = 0.f, l_reg = 0; f32x16 o[2] = {};
    DMA_IDX();
    const int vb0 = (int)(uintptr_t)V_lds + v_rd_base(lane);
    const bf16_t* Kh = cur.K; const bf16_t* Vh = cur.V;
#define RESC(a) do { if (__any((a) < 1.f)) { \
                     _Pragma("unroll") for (int d_ = 0; d_ < 2; ++d_) _Pragma("unroll") for (int r = 0; r < 16; ++r) o[d_][r] *= (a); } } while (0)
#define KBASE(t) ((t) * KVBLK)
#define MASKT(P0_, P1_, t) do { const int kb_ = KBASE(t); if (__builtin_amdgcn_readfirstlane(kb_ + KVBLK - 1 > qlo)) { asm volatile("; diagonal tile" ::); mask_tile(P0_, P1_, qm - kb_); } } while (0)
    constexpr int NQL = 6;
    f32x16 pA0, pA1, pB0, pB1; float alA, alB; bf16x8 pa0, pa1, pa2, pa3;
    DMA_V(Vh, 0, 0); DMA_K(Kh, KBASE(1), 1); DMA_V(Vh, KBASE(1), 1);
    const s16x4 kone = bias_frag(1.0f, hi); s16x4 q7 = s16x4{0, 0, 0, 0};
    SBAR(); qkt(pA0, pA1, K_lds, r32, hi, S.qr, kone, q7);
    MASKT(pA0, pA1, 0); partialSM<true>(pA0, pA1, mhat, alA, q7, hi);
    VMW();
    LDS_BARRIER();
    int s0 = 0, s1 = 1, s2 = 2;
#define ROT() do { const int t_ = s0; s0 = s1; s1 = s2; s2 = t_; } while (0)
#define STEP(PX0, PX1, alX, PY0, PY1, alY, t) do { \
        if ((t) + 1 < NT) { DMA_K(Kh, KBASE((t) + 1), s2); DMA_V(Vh, KBASE((t) + 1), s2); } SBAR(); \
        if (!grpB) { \
            qkt(PX0, PX1, K_lds + s1 * SHM_K, r32, hi, S.qr, kone, q7); \
            finishSM(PY0, PY1, alY, l_reg, pa0, pa1, pa2, pa3); \
            pv_tile(o, vb0 + s0 * SHM_V, pa0, pa1, pa2, pa3); \
            MASKT(PX0, PX1, (t)); partialSM<false>(PX0, PX1, mhat, alX, q7, hi); \
            VMW(); \
        } else { \
            KFr kf_; qkt_rd<QK_AH_B>(kf_, K_lds + s1 * SHM_K, r32, hi); \
            finishSM(PY0, PY1, alY, l_reg, pa0, pa1, pa2, pa3); SBAR(); \
            qkt_mm<QK_AH_B>(kf_, PX0, PX1, K_lds + s1 * SHM_K, r32, hi, S.qr, kone, q7); \
            VFr vf_; pv_rd(vf_, vb0 + s0 * SHM_V); \
            MASKT(PX0, PX1, (t)); partialSM<false>(PX0, PX1, mhat, alX, q7, hi); SBAR(); \
            pv_mm(vf_, o, vb0 + s0 * SHM_V, pa0, pa1, pa2, pa3); \
            VMW(); \
        } \
        RESC(alX); LDS_BARRIER(); ROT(); } while (0)
    for (int t = 1; t + 1 < NT; t += 2) {
        STEP(pB0, pB1, alB, pA0, pA1, alA, t);
        STEP(pA0, pA1, alA, pB0, pB1, alB, t + 1);
    }
    STEP(pB0, pB1, alB, pA0, pA1, alA, NT - 1);
    DMA_K(nxt.K, 0, 0); SBAR();
#pragma unroll
    for (int d0 = 0; d0 < 6; ++d0) S.qr[d0] = load8(nxt.Q + (size_t)(wid * QBLK + r32) * QS + d0 * 16 + hi * 8);
    SBAR();
    finishSM(pB0, pB1, alB, l_reg, pa0, pa1, pa2, pa3); SBAR();
    pv_tile(o, vb0 + s0 * SHM_V, pa0, pa1, pa2, pa3);
    SBAR(); VMWN(NQL); SBAR();
    { const float rl = __builtin_amdgcn_rcpf(l_reg);
      { float ss = 0.f;
#pragma unroll
        for (int d0 = 0; d0 < 2; ++d0)
#pragma unroll
            for (int r = 0; r < 16; ++r) { const float v_ = o[d0][r] * rl; ss += v_ * v_; }
        auto rr = __builtin_amdgcn_permlane32_swap(__float_as_uint(ss), __float_as_uint(ss), false, false); ss = __uint_as_float(rr[0]) + __uint_as_float(rr[1]);
        if (hi == 0) cur.SS[(size_t)(wid * QBLK + r32) * 8] = ss; }
      bf16_t* Ow = cur.O + (size_t)(wid * QBLK + r32) * OS + 8 * hi;
#pragma unroll
      for (int d0 = 0; d0 < 2; ++d0)
#pragma unroll
          for (int gp = 0; gp < 2; ++gp) { const int ra = 8 * gp, rb = 8 * gp + 4;
              const unsigned a0 = cvtpk(o[d0][ra] * rl, o[d0][ra + 1] * rl), a1 = cvtpk(o[d0][ra + 2] * rl, o[d0][ra + 3] * rl);
              const unsigned b0 = cvtpk(o[d0][rb] * rl, o[d0][rb + 1] * rl), b1 = cvtpk(o[d0][rb + 2] * rl, o[d0][rb + 3] * rl);
              auto s0_ = __builtin_amdgcn_permlane32_swap(a0, b0, false, false); auto s1_ = __builtin_amdgcn_permlane32_swap(a1, b1, false, false);
              u32x4 w = {s0_[0], s1_[0], s0_[1], s1_[1]};
              *(u32x4*)(Ow + d0 * 32 + 16 * gp) = w; } }
    LDS_BARRIER();
#undef RESC
#undef KBASE
#undef MASKT
#undef STEP
#undef ROT
}
#undef VMW
#undef VMWN
#undef GLDS16
#undef DMA_IDX
#undef DMA_K
#undef DMA_V
constexpr int NITEM = NQB * 4;
__device__ __forceinline__ BlockRef ref_of(int label, int j, const bf16_t* Q, const bf16_t* K, const bf16_t* V, bf16_t* O, float* SSQ, const int* pos) {
    const int qb = NQB - 1 - (j >> 2), bh = label + 8 * (j & 3), b = bh / H, h = bh % H;
    BlockRef r; const size_t row0 = (size_t)b * S;
    r.Q = Q + (row0 + (size_t)qb * QB) * QS + h * DQ; r.O = O + (row0 + (size_t)qb * QB) * OS + h * DV;
    r.K = K + row0 * KS + h * DQ; r.V = V + row0 * VS + h * DV; r.P0 = qb * QB; r.SS = SSQ + (row0 + (size_t)qb * QB) * 8 + h; r.pos = pos + row0 + (size_t)qb * QB;
    return r;
}
__device__ __forceinline__ int pull(unsigned* ctr, char* lds, int slot) {
    volatile int* w = (volatile int*)(lds + LDS_BYTES) + slot;
    if (threadIdx.x == 0) *w = (int)__hip_atomic_fetch_add(ctr, 1u, __ATOMIC_RELAXED, __HIP_MEMORY_SCOPE_AGENT);
    LDS_BARRIER();
    return __builtin_amdgcn_readfirstlane(*w);
}
__device__ __forceinline__ void phase(char* lds, unsigned* qctr  , const bf16_t* Q, const bf16_t* K, const bf16_t* V, bf16_t* O, float* SSQ, const int* pos, const float* g_qn) {
    const int label = (int)blockIdx.x & 7; unsigned* ctr = qctr + 64 * label;
    if (threadIdx.x < 16) ((float*)(lds + O_WSF))[threadIdx.x] = 1.0f / powf(10000.0f, (float)threadIdx.x / 16.0f);
    int n = 0;
    int cj = pull(ctr, lds, (n++) & 3); if (cj >= NITEM) return;
    BlockRef cur = ref_of(label, cj, Q, K, V, O, SSQ, pos);
    Seam Sm;
    prime(cur, lds, Sm);
    for (;;) {
        const int nj = pull(ctr, lds, (n++) & 3);
        const bool last = nj >= NITEM;
        const BlockRef nxt = last ? cur : ref_of(label, nj, Q, K, V, O, SSQ, pos);
        block(cur, nxt, lds, Sm, g_qn);
        if (last) break;
        cur = nxt;
    }
}
#undef KSWZ
#undef SBAR
}

struct Params {
    const float* x; const int* pos;
    const float *g_mix, *w_in, *g_cq, *w_uq, *g_ckv, *w_uk, *w_uv, *g_qn, *g_kn, *g_mla_out;
    const float *rw_mu, *rw_w0, *rw_w2, *rw_a0, *rw_a2, *rw_g2, *rw_k_k, *rw_k_a, *rw_r_k, *rw_lnx_g, *rw_lnx_b;
    const float *w_o, *g_ffn, *w_group, *b_group, *w_expert, *b_expert, *w_gate, *w_up, *w_down;
    float* out; unsigned char* ws;
    int ph_lo, ph_hi;
};
constexpr size_t MiB = 1u << 20;
constexpr size_t WS_CTL = 0, CTL_ZERO_BYTES = 64 * 1024;
constexpr size_t WS_SMALL = 1 * MiB;
constexpr size_t WS_PROJ = 4 * MiB;
constexpr size_t WS_MIX = 148 * MiB;
constexpr size_t WS_RX = 212 * MiB;
constexpr size_t WS_WO = 502 * MiB;
constexpr int CW_BAR = 4096, CW_ATTQ = 2048;

__device__ __forceinline__ void ph_mla_prep(const bf16_t* PROJ, bf16_t* Q, const bf16_t* KN, bf16_t* K, bf16_t* V, const int* pos, const float* g_qn, const float* g_kn) {
    const int otid_ = otid();
    const int lane = otid_ & 63, gw = blockIdx.x * 8 + (otid_ >> 6), NGW = gridDim.x * 8;
    const int h = lane >> 3, sub = lane & 7;
    typedef unsigned u32x2_t __attribute__((ext_vector_type(2)));
    float invf[4];
#pragma unroll
    for (int q = 0; q < 4; ++q) invf[q] = 1.0f / powf(10000.0f, (float)((4 * sub + q) & 15) / 16.0f);
    float gq[3][4], gk[3][4];
#pragma unroll
    for (int m = 0; m < 3; ++m) { const f32x4 a = *(const f32x4*)(g_qn + 32 * m + 4 * sub), b2 = *(const f32x4*)(g_kn + 32 * m + 4 * sub);
        gq[m][0] = a.x; gq[m][1] = a.y; gq[m][2] = a.z; gq[m][3] = a.w; gk[m][0] = b2.x; gk[m][1] = b2.y; gk[m][2] = b2.z; gk[m][3] = b2.w; }
#define UNPK4(u, f) do { f[0] = __uint_as_float((u).x << 16); f[1] = __uint_as_float((u).x & 0xffff0000u); f[2] = __uint_as_float((u).y << 16); f[3] = __uint_as_float((u).y & 0xffff0000u); } while (0)
    for (int t0 = gw; t0 < T; t0 += 4 * NGW) {
        u32x2_t kn0[4], kn1[4], kr[4]; int ps[4];
#pragma unroll
        for (int k = 0; k < 4; ++k) { const int t = t0 + k * NGW; const bf16_t* knp = KN + (size_t)t * 512 + h * NOPE + 4 * sub;
            kn0[k] = *(const u32x2_t*)knp; kn1[k] = *(const u32x2_t*)(knp + 32); kr[k] = *(const u32x2_t*)(PROJ + (size_t)t * PW + 384 + 4 * sub); ps[k] = pos[t]; }
        __builtin_amdgcn_sched_barrier(0);
#pragma unroll
        for (int k = 0; k < 4; ++k) { const int t = t0 + k * NGW;
            const float pf = (float)ps[k];
            float cs[4], sn[4];
#pragma unroll
            for (int q = 0; q < 4; ++q) { const float rev = __builtin_amdgcn_fractf(pf * invf[q] * 0.15915494309189535f); cs[q] = __builtin_amdgcn_cosf(rev); sn[q] = __builtin_amdgcn_sinf(rev); }
            float x[3][4]; UNPK4(kn0[k], x[0]); UNPK4(kn1[k], x[1]); UNPK4(kr[k], x[2]);
            float ss = 0.f;
#pragma unroll
            for (int m = 0; m < 3; ++m)
#pragma unroll
                for (int q = 0; q < 4; ++q) ss += x[m][q] * x[m][q];
            ss += __int_as_float(__builtin_amdgcn_update_dpp(0, __float_as_int(ss), 0xB1, 0xF, 0xF, true));
            ss += __int_as_float(__builtin_amdgcn_update_dpp(0, __float_as_int(ss), 0x4E, 0xF, 0xF, true));
            ss += __int_as_float(__builtin_amdgcn_update_dpp(0, __float_as_int(ss), 0x141, 0xF, 0xF, true));
            const float rn = rsqrtf(ss * (1.f / QK) + 1e-6f);
#pragma unroll
            for (int m = 0; m < 3; ++m)
#pragma unroll
                for (int q = 0; q < 4; ++q) x[m][q] = x[m][q] * rn * gk[m][q];
            float oth[4];
#pragma unroll
            for (int q = 0; q < 4; ++q) oth[q] = __shfl_xor(x[2][q], 4);
#pragma unroll
            for (int q = 0; q < 4; ++q) x[2][q] = (sub < 4) ? (x[2][q] * cs[q] - oth[q] * sn[q]) : (x[2][q] * cs[q] + oth[q] * sn[q]);
            bf16_t* kp = K + (size_t)t * 768 + h * QK + 4 * sub;
#pragma unroll
            for (int m = 0; m < 3; ++m) { u32x2_t o; o.x = pk2(x[m][0], x[m][1]); o.y = pk2(x[m][2], x[m][3]); *(u32x2_t*)(kp + 32 * m) = o; } }
    }
#undef UNPK4
}

__device__ __forceinline__ void ph_mla_norm(bf16_t* MIX, const float* g, int gw, int NGW) {
    const int otid_ = otid();
    const int lane = otid_ & 63;
    const f32x4 g0 = *(const f32x4*)(g + lane * 8), g1 = *(const f32x4*)(g + lane * 8 + 4);
    for (int row0 = gw; row0 < T; row0 += 4 * NGW) {
        v4u u[4];
#pragma unroll
        for (int k = 0; k < 4; ++k) u[k] = *((const v4u*)(MIX + (size_t)(row0 + k * NGW) * 1024) + lane);
        __builtin_amdgcn_sched_barrier(0);
#pragma unroll
        for (int k = 0; k < 4; ++k) { float v[8];
            v[0] = __uint_as_float(u[k].x << 16); v[1] = __uint_as_float(u[k].x & 0xffff0000u); v[2] = __uint_as_float(u[k].y << 16); v[3] = __uint_as_float(u[k].y & 0xffff0000u);
            v[4] = __uint_as_float(u[k].z << 16); v[5] = __uint_as_float(u[k].z & 0xffff0000u); v[6] = __uint_as_float(u[k].w << 16); v[7] = __uint_as_float(u[k].w & 0xffff0000u);
            float s = 0.f;
            _Pragma("unroll") for (int i = 0; i < 8; ++i) s += v[i] * v[i];
            const float r = rsqrtf(wave_sum_dpp(s) * (1.f / 512.f) + 1e-6f);
            v4u o; o.x = pk2(v[0] * r * g0.x, v[1] * r * g0.y); o.y = pk2(v[2] * r * g0.z, v[3] * r * g0.w); o.z = pk2(v[4] * r * g1.x, v[5] * r * g1.y); o.w = pk2(v[6] * r * g1.z, v[7] * r * g1.w);
            *((v4u*)(MIX + (size_t)(row0 + k * NGW) * 1024) + lane) = o; }
    }
}

__device__ __forceinline__ void ph_rw_prep1(const bf16_t* PROJ, const float* mu, bf16_t* LIN) {
    const int otid_ = otid();
    const int lane = otid_ & 63, gw = blockIdx.x * 8 + (otid_ >> 6), NGW = gridDim.x * 8;
    typedef unsigned u32x2_t __attribute__((ext_vector_type(2)));
    const int c = 1536 + 4 * lane; const f32x4 m4 = *(const f32x4*)(mu + c);
    for (int t0 = gw; t0 < T; t0 += 4 * NGW) {
        u32x2_t fcv[4], fpv[4];
#pragma unroll
        for (int k = 0; k < 4; ++k) { const int t = t0 + k * NGW; const bf16_t* cur = PROJ + (size_t)t * PW + MLA_IN + c;
            fcv[k] = *(const u32x2_t*)cur; fpv[k] = *(const u32x2_t*)(cur - ((t % S) ? PW : 0)); if ((t % S) == 0) { fpv[k].x = 0u; fpv[k].y = 0u; } }
        __builtin_amdgcn_sched_barrier(0);
#pragma unroll
        for (int k = 0; k < 4; ++k) { const int t = t0 + k * NGW; const u32x2_t fc = fcv[k], fp = fpv[k];
            float f[4] = {__uint_as_float(fc.x << 16), __uint_as_float(fc.x & 0xffff0000u), __uint_as_float(fc.y << 16), __uint_as_float(fc.y & 0xffff0000u)};
            const float q[4] = {__uint_as_float(fp.x << 16), __uint_as_float(fp.x & 0xffff0000u), __uint_as_float(fp.y << 16), __uint_as_float(fp.y & 0xffff0000u)};
            f[0] += (q[0] - f[0]) * m4.x; f[1] += (q[1] - f[1]) * m4.y; f[2] += (q[2] - f[2]) * m4.z; f[3] += (q[3] - f[3]) * m4.w;
            if (lane < 16 || lane >= 32) { const float sc_ = lane < 16 ? -2.8853900817779268f : -1.4426950408889634f;
                _Pragma("unroll") for (int e = 0; e < 4; ++e) { const float sg = __builtin_amdgcn_rcpf(1.f + __builtin_amdgcn_exp2f(f[e] * sc_)); f[e] = lane < 16 ? 2.f * sg - 1.f : sg; } }
            u32x2_t o; o.x = pk2(f[0], f[1]); o.y = pk2(f[2], f[3]);
            *(u32x2_t*)(LIN + (size_t)t * 256 + 4 * lane) = o; }
    }
}

constexpr int RC = 64, NCH = S / RC, NCHUNK = NB * RH * NCH;
typedef short rw_bf16x8 __attribute__((ext_vector_type(8)));
typedef float rw_f32x16 __attribute__((ext_vector_type(16)));
typedef float rw_f32x2 __attribute__((ext_vector_type(2)));
typedef __bf16 rw_bf16x2 __attribute__((ext_vector_type(2)));
__device__ __forceinline__ unsigned rw_cvtpk(float lo, float hi) { rw_f32x2 v = {lo, hi}; rw_bf16x2 b = __builtin_convertvector(v, rw_bf16x2); return __builtin_bit_cast(unsigned, b); }
__device__ __forceinline__ int rw_crow(int r, int hi) { return (r & 3) + 8 * (r >> 2) + 4 * hi; }

template <int KIND>
__device__ __forceinline__ void rw_chunk_task(LAS float* shw, int cid, int lane, const bf16_t* R, const bf16_t* K1, const bf16_t* V1, const bf16_t* KK, const bf16_t* BB, const float* DEC,
                                              bf16_t* OutT  , bf16_t* YT  ) {
    constexpr int PB = 4, SLOT = 384;
    const int bh = cid / NCH, c = cid % NCH, b = bh / RH, h = bh % RH;
    float st[64];
    _Pragma("unroll") for (int j = 0; j < 64; ++j) st[j] = (KIND == 0 && j == lane) ? 1.f : 0.f;
    const size_t base = ((size_t)b * S + (size_t)c * RC) * 512 + h * 64 + lane;
    bf16_t* yo = YT + (size_t)cid * 4096 + lane;
    float pr[PB], pk[PB], pkk[PB], pb[PB], pd[PB], pv[PB];
#define RW_LOAD_BLK(s0) do { _Pragma("unroll") for (int u = 0; u < PB; ++u) { const size_t a_ = base + (size_t)((s0) + u) * 512; \
        pr[u] = bf2f(R[a_]); pk[u] = bf2f(K1[a_]); pkk[u] = bf2f(KK[a_]); pb[u] = bf2f(BB[a_]); pd[u] = DEC[a_]; pv[u] = KIND ? bf2f(V1[a_]) : 0.f; } } while (0)
#define RW_WRITE_BLK(hf) do { _Pragma("unroll") for (int u = 0; u < PB; ++u) { LAS float* d_ = shw + ((hf) * PB + u) * SLOT + lane; \
        d_[0] = pr[u]; d_[64] = pk[u]; d_[128] = pkk[u]; d_[192] = pb[u]; d_[256] = pd[u]; d_[320] = pv[u]; } } while (0)
    RW_LOAD_BLK(0); RW_WRITE_BLK(0);
    for (int n = 0; n < RC / PB; ++n) {
        const int hf = n & 1;
        if (n + 1 < RC / PB) RW_LOAD_BLK((n + 1) * PB);
        WAVE_SYNC();
#pragma unroll 1
        for (int u = 0; u < PB; ++u) {
            const LAS float* o_ = shw + (hf * PB + u) * SLOT;
            const float vv = KIND ? o_[320 + lane] : 0.f;
            float sa0 = 0.f, sa1 = 0.f;
            _Pragma("unroll") for (int j = 0; j < 64; j += 2) { sa0 += st[j] * o_[128 + j]; sa1 += st[j + 1] * o_[129 + j]; }
            const float sa = -(sa0 + sa1);
            float y0 = 0.f, y1 = 0.f;
            _Pragma("unroll") for (int j = 0; j < 64; j += 2) {
                _Pragma("unroll") for (int q = 0; q < 2; ++q) { float v = st[j + q] * o_[256 + j + q] + sa * o_[192 + j + q]; if (KIND) v += vv * o_[64 + j + q]; st[j + q] = v; }
                y0 += st[j] * o_[j]; y1 += st[j + 1] * o_[j + 1]; }
            yo[(n * PB + u) * 64] = f2bf(y0 + y1);
        }
        if (n + 1 < RC / PB) RW_WRITE_BLK(hf ^ 1);
    }
#undef RW_LOAD_BLK
#undef RW_WRITE_BLK
    WAVE_SYNC();
    if (KIND == 0) { bf16_t* po = OutT + (size_t)cid * 4096 + lane;
        _Pragma("unroll") for (int j = 0; j < 64; ++j) po[j * 64] = f2bf(st[j]); }
    else { unsigned* lo = (unsigned*)(OutT + (size_t)cid * 4096 + lane * 64);
        _Pragma("unroll") for (int j = 0; j < 64; j += 2) lo[j >> 1] = rw_cvtpk(st[j], st[j + 1]); }
}
__device__ __forceinline__ void ph_rw_chunk(LAS unsigned char* lds, const bf16_t* R, const bf16_t* K1, const bf16_t* V1, const bf16_t* KK, const bf16_t* BB, const float* DEC,
                                            bf16_t* PcT, bf16_t* LcB, bf16_t* QcT, bf16_t* YlT) {
    const int lane = threadIdx.x & 63, wid = threadIdx.x >> 6;
    LAS float* shw = (LAS float*)(lds + wid * 12288);
    const int gw = blockIdx.x * 8 + wid, NGW = gridDim.x * 8;
    for (int task = gw; task < NCHUNK * 2; task += NGW) {
        const int cid = task >> 1;
        if (task & 1) rw_chunk_task<1>(shw, cid, lane, R, K1, V1, KK, BB, DEC, LcB, YlT);
        else rw_chunk_task<0>(shw, cid, lane, R, K1, V1, KK, BB, DEC, PcT, QcT);
    }
}

namespace ch {
typedef short bf16x8 __attribute__((ext_vector_type(8)));
typedef short s16x4 __attribute__((ext_vector_type(4)));
typedef float f32x16 __attribute__((ext_vector_type(16)));
typedef unsigned u32x2 __attribute__((ext_vector_type(2)));
constexpr int P = 72, MBY = 64 * P * 2;
constexpr int O_AB = 0 * MBY, O_RB = 1 * MBY, O_BB = 2 * MBY, O_KB = 3 * MBY, O_BT = 4 * MBY, O_KT = 5 * MBY, O_VT = 6 * MBY, O_PA = 7 * MBY, O_PB = 8 * MBY, O_TA = 9 * MBY, O_TB = 10 * MBY,
              O_MAK = 11 * MBY, O_MBR = 12 * MBY, O_W1 = O_BB, O_A2 = O_KB, O_GC = O_PA, O_HC = O_PB, O_SCR = 13 * MBY  , O_GCV = O_SCR + 4096  ;
static_assert(O_GCV + 256 <= 131072, "chunk phase LDS");
__device__ __forceinline__ int crow(int r, int hi) { return (r & 3) + 8 * (r >> 2) + 4 * hi; }
__device__ __forceinline__ unsigned cvtpk(float lo, float hi) { typedef float f2 __attribute__((ext_vector_type(2))); typedef __bf16 b2 __attribute__((ext_vector_type(2))); f2 v = {lo, hi}; b2 b = __builtin_convertvector(v, b2); return __builtin_bit_cast(unsigned, b); }
__device__ __forceinline__ bf16x8 frag_kc(const LAS unsigned char* M, int i0, int k0, int l31, int hi) { return *(const LAS bf16x8*)(M + ((i0 + l31) * P + k0 + 8 * hi) * 2); }
typedef short v4i16_t __attribute__((ext_vector_type(4)));
__device__ __forceinline__ bf16x8 frag_ks(const LAS unsigned char* M, int i0, int k0, int lane) {
    const LAS unsigned char* a = M + ((k0 + 8 * (lane >> 5) + ((lane >> 2) & 3)) * P + i0 + 16 * ((lane >> 4) & 1) + 4 * (lane & 3)) * 2;
    const s16x4 lo = __builtin_bit_cast(s16x4, __builtin_amdgcn_ds_read_tr16_b64_v4i16((LAS v4i16_t*)a));
    const s16x4 h4 = __builtin_bit_cast(s16x4, __builtin_amdgcn_ds_read_tr16_b64_v4i16((LAS v4i16_t*)(a + 4 * P * 2)));
    return (bf16x8){lo[0], lo[1], lo[2], lo[3], h4[0], h4[1], h4[2], h4[3]};
}
#define CH_MFMA(a, b, c) __builtin_amdgcn_mfma_f32_32x32x16_bf16((a), (b), (c), 0, 0, 0)
#define CH_PROD4(acc, FA, FB) do { bf16x8 fa_[4], fb_[4]; \
        _Pragma("unroll") for (int ks = 0; ks < 4; ++ks) { fa_[ks] = FA; fb_[ks] = FB; } \
        __builtin_amdgcn_sched_barrier(0); \
        _Pragma("unroll") for (int ks = 0; ks < 4; ++ks) acc = CH_MFMA(fa_[ks], fb_[ks], acc); } while (0)
#define CH_PROD2(acc, FA, FB, K0) do { bf16x8 fa_[2], fb_[2]; \
        _Pragma("unroll") for (int kq = 0; kq < 2; ++kq) { const int ks = (K0) + kq; fa_[kq] = FA; fb_[kq] = FB; } \
        __builtin_amdgcn_sched_barrier(0); \
        _Pragma("unroll") for (int kq = 0; kq < 2; ++kq) acc = CH_MFMA(fa_[kq], fb_[kq], acc); } while (0)
__device__ __forceinline__ float red32(float x) {
    x += __int_as_float(__builtin_amdgcn_update_dpp(0, __float_as_int(x), 0xB1, 0xF, 0xF, true));
    x += __int_as_float(__builtin_amdgcn_update_dpp(0, __float_as_int(x), 0x4E, 0xF, 0xF, true));
    x += __int_as_float(__builtin_amdgcn_update_dpp(0, __float_as_int(x), 0x141, 0xF, 0xF, true));
    x += __int_as_float(__builtin_amdgcn_update_dpp(0, __float_as_int(x), 0x140, 0xF, 0xF, true));
    x += __int_as_float(__builtin_amdgcn_ds_swizzle(__float_as_int(x), 0x401F));
    return x;
}
__device__ __forceinline__ void st_lds(LAS unsigned char* ZT, const f32x16& a, int wr, int wc, int l31, int hi) {
#pragma unroll
    for (int g = 0; g < 4; ++g) { u32x2 w; w.x = cvtpk(a[4 * g], a[4 * g + 1]); w.y = cvtpk(a[4 * g + 2], a[4 * g + 3]); *(LAS u32x2*)(ZT + ((32 * wc + l31) * P + 32 * wr + 8 * g + 4 * hi) * 2) = w; }
}
__device__ __forceinline__ void st_glb(bf16_t* G, const f32x16& a, int wr, int wc, int l31, int hi) {
#pragma unroll
    for (int g = 0; g < 4; ++g) { u32x2 w; w.x = cvtpk(a[4 * g], a[4 * g + 1]); w.y = cvtpk(a[4 * g + 2], a[4 * g + 3]); *(u32x2*)(G + (32 * wc + l31) * 64 + 32 * wr + 8 * g + 4 * hi) = w; }
}
__device__ __forceinline__ void mask_tile(f32x16& a, int wr, int wc, int l31, int hi, bool inclusive) {
    const int col = 32 * wc + l31;
#pragma unroll
    for (int r = 0; r < 16; ++r) { const int row = 32 * wr + crow(r, hi); const bool keep = inclusive ? (row <= col) : (row < col); if (!keep) a[r] = 0.f; }
}
struct In { const bf16_t *PROJ, *WA; const float *mu, *w0, *a0, *k_k, *k_a, *r_k; float* BON; bf16_t* V1S; };
struct Pre { unsigned kp[5], rr[5], vv[5], wp[4], ap[4]; };
__device__ __forceinline__ void load_pre(Pre& q, const In& in, int cid, int tid) {
    const int bh = cid / NCH, c = cid % NCH, b = bh / RH, h = bh % RH, kp = tid & 31, tg = tid >> 5;
    const size_t row = (size_t)b * S + (size_t)c * RC + 4 * tg; const int ch = h * 64 + 2 * kp;
    const bool seq_start = (c == 0 && tg == 0);
#pragma unroll
    for (int u = 0; u < 5; ++u) { const size_t a0 = (row + u - ((u == 0 && seq_start) ? 0 : 1)) * PW + MLA_IN + ch;
        q.rr[u] = *(const unsigned*)(in.PROJ + a0); q.kp[u] = *(const unsigned*)(in.PROJ + a0 + 512); q.vv[u] = *(const unsigned*)(in.PROJ + a0 + 1024); }
    if (seq_start) { q.rr[0] = 0u; q.kp[0] = 0u; q.vv[0] = 0u; }
#pragma unroll
    for (int u = 0; u < 4; ++u) { const size_t a1 = (row + u) * 1024 + ch; q.wp[u] = *(const unsigned*)(in.WA + a1); q.ap[u] = *(const unsigned*)(in.WA + a1 + 512); }
}
__device__ __forceinline__ float lo16(unsigned w) { return __uint_as_float(w << 16); }
__device__ __forceinline__ float hi16(unsigned w) { return __uint_as_float(w & 0xffff0000u); }

__device__ __forceinline__ void phase(LAS unsigned char* lds, const In in, bf16_t* PcTa, bf16_t* PcTb  , bf16_t* LcB, bf16_t* QcT, bf16_t* YlT) {
    const int tid = otid(), lane = tid & 63, wid = __builtin_amdgcn_readfirstlane(tid >> 6), l31 = lane & 31, hi = lane >> 5;
    const int grp = wid >> 2, tp = wid & 3, wr = tp >> 1, wc = tp & 1, kpr = tid & 31, tg = tid >> 5;
    typedef float f32x2v __attribute__((ext_vector_type(2)));
    LAS float* scr = (LAS float*)(lds + O_SCR); LAS float* gcv = (LAS float*)(lds + O_GCV);
    const int xl = blockIdx.x & 7, rr = blockIdx.x >> 3, NPB = NCHUNK / (int)gridDim.x;
    auto cid_of = [&](int i) { const int m = i * 32 + rr; return (xl + 8 * (m & 3)) * NCH + (NCH - 1 - (m >> 2)); };
    if (gridDim.x != 256) return;
    const int tri = (wr == wc) ? (wr ? 2 : 1) : (wr < wc ? 0 : 3);
    if (grp == 0 && tri == 3) { f32x16 z = f32x16{}; st_lds(lds + O_TB, z, wr, wc, l31, hi); }
    int it = 0; int cid = cid_of(0);
    Pre pq; load_pre(pq, in, cid, tid);
    float ckk0, ckk1, cka0, cka1, crk0, crk1, ca00, ca01, cw00, cw01, mr0, mr1, mk0, mk1, mv0, mv1;
    float nkk0[4], nkk1[4], nbb0[4], nbb1[4], nkq0[4], nkq1[4], nld0[4], nld1[4], nrs0[4], nrs1[4]; unsigned nvsh[4];
    auto ld_consts = [&](int dcid) { const int hc_ = ((dcid / NCH) % RH) * 64 + 2 * kpr; ckk0 = in.k_k[hc_]; ckk1 = in.k_k[hc_ + 1]; cka0 = in.k_a[hc_]; cka1 = in.k_a[hc_ + 1]; crk0 = in.r_k[hc_]; crk1 = in.r_k[hc_ + 1];
          ca00 = in.a0[hc_]; ca01 = in.a0[hc_ + 1]; cw00 = in.w0[hc_]; cw01 = in.w0[hc_ + 1];
          mr0 = in.mu[hc_]; mr1 = in.mu[hc_ + 1]; mk0 = in.mu[512 + hc_]; mk1 = in.mu[512 + hc_ + 1]; mv0 = in.mu[1024 + hc_]; mv1 = in.mu[1024 + hc_ + 1]; };
    auto derive = [&](const int u, int dcid) {
            const int bh_ = dcid / NCH, cc_ = dcid % NCH, b_ = bh_ / RH, h_ = bh_ % RH;
            float k0 = lo16(pq.kp[u + 1]), k1 = hi16(pq.kp[u + 1]); k0 += (lo16(pq.kp[u]) - k0) * mk0; k1 += (hi16(pq.kp[u]) - k1) * mk1;
            float r0_ = lo16(pq.rr[u + 1]), r1_ = hi16(pq.rr[u + 1]); r0_ += (lo16(pq.rr[u]) - r0_) * mr0; r1_ += (hi16(pq.rr[u]) - r1_) * mr1; nrs0[u] = r0_; nrs1[u] = r1_;
            float v0_ = lo16(pq.vv[u + 1]), v1_ = hi16(pq.vv[u + 1]); v0_ += (lo16(pq.vv[u]) - v0_) * mv0; v1_ += (hi16(pq.vv[u]) - v1_) * mv1; nvsh[u] = cvtpk(v0_, v1_);
            *(unsigned*)(in.V1S + ((size_t)b_ * S + (size_t)cc_ * RC + 4 * tg + u) * 512 + h_ * 64 + 2 * kpr) = nvsh[u];
            const float q0 = k0 * ckk0, q1 = k1 * ckk1; float ss = q0 * q0 + q1 * q1;
            ss = red32(ss);
            const float inv = rsqrtf(ss + 1e-12f);
            const float a0v = __builtin_amdgcn_rcpf(1.f + __expf(-(ca00 + lo16(pq.ap[u])))), a1v = __builtin_amdgcn_rcpf(1.f + __expf(-(ca01 + hi16(pq.ap[u]))));
            const float w0v = -__logf(1.f + __expf(-(cw00 + lo16(pq.wp[u])))) - 0.5f, w1v = -__logf(1.f + __expf(-(cw01 + hi16(pq.wp[u])))) - 0.5f;
            nld0[u] = -__expf(w0v); nld1[u] = -__expf(w1v);
            nkk0[u] = q0 * inv; nkk1[u] = q1 * inv; nbb0[u] = nkk0[u] * a0v; nbb1[u] = nkk1[u] * a1v;
            nkq0[u] = k0 * (1.f + (a0v - 1.f) * cka0); nkq1[u] = k1 * (1.f + (a1v - 1.f) * cka1);
            float bon = nrs0[u] * nkq0[u] * crk0 + nrs1[u] * nkq1[u] * crk1;
            bon = red32(bon);
            if (kpr == 0) in.BON[((size_t)b_ * S + (size_t)cc_ * RC + 4 * tg + u) * RH + h_] = bon; };
    ld_consts(cid);
#pragma unroll
    for (int u = 0; u < 4; ++u) derive(u, cid);
    for (; it < NPB; ++it, cid = (it < NPB ? cid_of(it) : 0)) {
        float kk0[4], kk1[4], bb0[4], bb1[4], kq0[4], kq1[4], ld0[4], ld1[4], rs0[4], rs1[4]; unsigned vsh[4];
#pragma unroll
        for (int u = 0; u < 4; ++u) { kk0[u] = nkk0[u]; kk1[u] = nkk1[u]; bb0[u] = nbb0[u]; bb1[u] = nbb1[u]; kq0[u] = nkq0[u]; kq1[u] = nkq1[u]; ld0[u] = nld0[u]; ld1[u] = nld1[u]; rs0[u] = nrs0[u]; rs1[u] = nrs1[u]; vsh[u] = nvsh[u]; }
        float cl0[4], cl1[4]; { float a0 = 0.f, a1 = 0.f;
#pragma unroll
            for (int u = 0; u < 4; ++u) { a0 += ld0[u]; a1 += ld1[u]; cl0[u] = a0; cl1[u] = a1; } }
        *(LAS f32x2v*)(scr + tg * 64 + 2 * kpr) = (f32x2v){cl0[3], cl1[3]};
        LDS_BARRIER();
        float off0 = 0.f, off1 = 0.f, tot0 = 0.f, tot1 = 0.f;
#pragma unroll
        for (int q = 0; q < 16; ++q) { const f32x2v v = *(const LAS f32x2v*)(scr + q * 64 + 2 * kpr); tot0 += v.x; tot1 += v.y; if (q < tg) { off0 += v.x; off1 += v.y; } }
        if (tg == 0) *(LAS f32x2v*)(gcv + 2 * kpr) = (f32x2v){__expf(tot0), __expf(tot1)};
#pragma unroll
        for (int u = 0; u < 4; ++u) {
            const int t = 4 * tg + u; const float ci0 = off0 + cl0[u], ci1 = off1 + cl1[u];
            const float ex0 = __expf(ci0 - ld0[u]), ei0 = __expf(ci0), en0 = __expf(-ci0), et0 = __expf(tot0 - ci0);
            const float ex1 = __expf(ci1 - ld1[u]), ei1 = __expf(ci1), en1 = __expf(-ci1), et1 = __expf(tot1 - ci1);
            const int o = (t * P + 2 * kpr) * 2;
            *(LAS unsigned*)(lds + O_AB + o) = cvtpk(-kk0[u] * ex0, -kk1[u] * ex1); *(LAS unsigned*)(lds + O_RB + o) = cvtpk(rs0[u] * ei0, rs1[u] * ei1);
            *(LAS unsigned*)(lds + O_BB + o) = cvtpk(bb0[u] * en0, bb1[u] * en1); *(LAS unsigned*)(lds + O_KB + o) = cvtpk(kq0[u] * en0, kq1[u] * en1);
            *(LAS unsigned*)(lds + O_BT + o) = cvtpk(bb0[u] * et0, bb1[u] * et1); *(LAS unsigned*)(lds + O_KT + o) = cvtpk(kq0[u] * et0, kq1[u] * et1);
            *(LAS unsigned*)(lds + O_VT + o) = vsh[u];
        }
        const int cur = cid;
        const bool more = it + 1 < NPB; const int ncid = more ? cid_of(it + 1) : 0;
        if (more) { load_pre(pq, in, ncid, tid); ld_consts(ncid); }
        LDS_BARRIER();
        const size_t cb = (size_t)cur * 4096;
        f32x16 keep;
        { f32x16 a0 = f32x16{}, a1 = f32x16{};
          const LAS unsigned char* Am = lds + (grp == 0 ? O_BB : O_KB);
          bf16x8 af[4], b0[4], b1[4];
#pragma unroll
          for (int ks = 0; ks < 4; ++ks) { af[ks] = frag_kc(Am, 32 * wr, 16 * ks, l31, hi); b0[ks] = frag_kc(lds + O_AB, 32 * wc, 16 * ks, l31, hi); b1[ks] = frag_kc(lds + O_RB, 32 * wc, 16 * ks, l31, hi); }
          __builtin_amdgcn_sched_barrier(0);
#pragma unroll
          for (int ks = 0; ks < 4; ++ks) { a0 = CH_MFMA(af[ks], b0[ks], a0); a1 = CH_MFMA(af[ks], b1[ks], a1); }
          mask_tile(a0, wr, wc, l31, hi, false); mask_tile(a1, wr, wc, l31, hi, true);
          if (grp == 0) { st_lds(lds + O_PA, a0, wr, wc, l31, hi); st_lds(lds + O_MBR, a1, wr, wc, l31, hi);
              keep = a0;
#pragma unroll
              for (int r = 0; r < 16; ++r) if (32 * wr + crow(r, hi) == 32 * wc + l31) keep[r] += 1.f;
              st_lds(lds + O_TA, keep, wr, wc, l31, hi); }
          else { st_lds(lds + O_MAK, a0, wr, wc, l31, hi); keep = a1; } }
        LDS_BARRIER();
#pragma unroll
        for (int st = 0; st < 6; ++st) {
            const LAS unsigned char* Pc_ = lds + ((st & 1) ? O_PB : O_PA); LAS unsigned char* Pn_ = lds + ((st & 1) ? O_PA : O_PB);
            const LAS unsigned char* Tc_ = lds + ((st & 1) ? O_TA : O_TB); LAS unsigned char* Tn_ = lds + ((st & 1) ? O_TB : O_TA);
            if (grp == 0) { if (st >= 1 && tri != 3) {
                if (tri == 0) CH_PROD4(keep, frag_ks(Tc_, 32 * wr, 16 * ks, lane), frag_kc(Pc_, 32 * wc, 16 * ks, l31, hi));
                else if (tri == 1) CH_PROD2(keep, frag_ks(Tc_, 32 * wr, 16 * ks, lane), frag_kc(Pc_, 32 * wc, 16 * ks, l31, hi), 0);
                else CH_PROD2(keep, frag_ks(Tc_, 32 * wr, 16 * ks, lane), frag_kc(Pc_, 32 * wc, 16 * ks, l31, hi), 2);
                st_lds(Tn_, keep, wr, wc, l31, hi); } }
            else if (st < 5) { f32x16 a = f32x16{};
                if (tri == 0) CH_PROD4(a, frag_ks(Pc_, 32 * wr, 16 * ks, lane), frag_kc(Pc_, 32 * wc, 16 * ks, l31, hi));
                else if (tri == 1) CH_PROD2(a, frag_ks(Pc_, 32 * wr, 16 * ks, lane), frag_kc(Pc_, 32 * wc, 16 * ks, l31, hi), 0);
                else if (tri == 2) CH_PROD2(a, frag_ks(Pc_, 32 * wr, 16 * ks, lane), frag_kc(Pc_, 32 * wc, 16 * ks, l31, hi), 2);
                if (tri != 3 || st == 0) st_lds(Pn_, a, wr, wc, l31, hi); }
            if (st >= 1 && st <= 4 && more) derive(st - 1, ncid);
            LDS_BARRIER();
        }
        const LAS unsigned char* TmT = lds + O_TB;
        { f32x16 a = f32x16{}; const LAS unsigned char* Am = lds + (grp == 0 ? O_MAK : O_AB);
          if (wc == 0) CH_PROD2(a, frag_ks(Am, 32 * wr, 16 * ks, lane), frag_kc(TmT, 32 * wc, 16 * ks, l31, hi), 0);
          else CH_PROD4(a, frag_ks(Am, 32 * wr, 16 * ks, lane), frag_kc(TmT, 32 * wc, 16 * ks, l31, hi));
          st_lds(lds + (grp == 0 ? O_W1 : O_A2), a, wr, wc, l31, hi); }
        LDS_BARRIER();
        { f32x16 a0, a1;
          if (grp == 1) { a0 = keep; a1 = f32x16{}; }
          else { a1 = f32x16{};
#pragma unroll
              for (int g = 0; g < 4; ++g) { const u32x2 w = *(const LAS u32x2*)(lds + O_RB + ((32 * wc + l31) * P + 32 * wr + 8 * g + 4 * hi) * 2);
                  a0[4 * g] = lo16(w.x); a0[4 * g + 1] = hi16(w.x); a0[4 * g + 2] = lo16(w.y); a0[4 * g + 3] = hi16(w.y); }
              const float gc = gcv[32 * wc + l31];
#pragma unroll
              for (int r = 0; r < 16; ++r) if (32 * wr + crow(r, hi) == 32 * wc + l31) a1[r] = gc; }
          const LAS unsigned char* Am = lds + (grp == 1 ? O_W1 : O_A2);
          { bf16x8 af[4], b0[4], b1[4], kt[2];
#pragma unroll
            for (int ks = 0; ks < 4; ++ks) { af[ks] = frag_ks(Am, 32 * wr, 16 * ks, lane); b0[ks] = frag_kc(lds + O_MBR, 32 * wc, 16 * ks, l31, hi); b1[ks] = frag_ks(lds + O_BT, 32 * wc, 16 * ks, lane); }
            if (grp == 1) { kt[0] = frag_ks(lds + O_KT, 32 * wc, 32 * wr, lane); kt[1] = frag_ks(lds + O_KT, 32 * wc, 32 * wr + 16, lane); }
            __builtin_amdgcn_sched_barrier(0);
#pragma unroll
            for (int ks = 0; ks < 4; ++ks) { a0 = CH_MFMA(af[ks], b0[ks], a0); a1 = CH_MFMA(af[ks], b1[ks], a1); }
            if (grp == 1) {
#pragma unroll
                for (int i = 0; i < 2; ++i) { bf16x8 idf;
#pragma unroll
                    for (int j = 0; j < 8; ++j) idf[j] = (16 * i + 8 * hi + j == l31) ? (short)0x3F80 : (short)0;
                    a1 = CH_MFMA(idf, kt[i], a1); } } }
          if (grp == 1) {
              st_lds(lds + O_GC, a0, wr, wc, l31, hi); st_lds(lds + O_HC, a1, wr, wc, l31, hi); }
          else { st_glb(QcT + cb, a0, wr, wc, l31, hi); st_glb(cur < NCHUNK / 2 ? PcTa + cb : PcTb + (cb - (size_t)(NCHUNK / 2) * 4096), a1, wr, wc, l31, hi); } }
        LDS_BARRIER();
        { f32x16 a = f32x16{};
          if (grp == 0) {
              CH_PROD4(a, frag_ks(lds + O_VT, 32 * wr, 16 * ks, lane), frag_kc(lds + O_GC, 32 * wc, 16 * ks, l31, hi));
              st_glb(YlT + cb, a, wr, wc, l31, hi); }
          else {
              CH_PROD4(a, frag_kc(lds + O_HC, 32 * wr, 16 * ks, l31, hi), frag_ks(lds + O_VT, 32 * wc, 16 * ks, lane));
              st_glb(LcB + cb, a, wr, wc, l31, hi); } }
        LDS_BARRIER();
    }
}
#undef CH_MFMA
#undef CH_PROD4
#undef CH_PROD2
}

constexpr int SQ_DEPTH = 8, SQ_NSLOT = SQ_DEPTH + 2, SQ_SLOT = 12288;
__device__ __forceinline__ void rw_glds16(const void* gsrc, unsigned lds_dst) { unsigned keep;
    asm volatile("s_mov_b32 %0, m0\n\ts_mov_b32 m0, %2\n\ts_nop 0\n\tglobal_load_lds_dwordx4 %1, off\n\ts_mov_b32 m0, %0" : "=&s"(keep) : "v"(gsrc), "s"(lds_dst) : "memory"); }
__device__ __forceinline__ void ph_rw_seq(LAS unsigned char* lds, const bf16_t* PcTa, const bf16_t* PcTb, const bf16_t* LcB, bf16_t* SC) {
    const bf16_t* PcT = (blockIdx.x & 7) + 8 * ((blockIdx.x >> 3) >> 1) < NB * RH / 2 ? PcTa : PcTb - (size_t)(NCHUNK / 2) * 4096;
    const int otid_ = otid();
    if (blockIdx.x >= NB * RH * 2) return;
    const int lane = otid_ & 63, wid = __builtin_amdgcn_readfirstlane(otid_ >> 6), l31 = lane & 31, hi = lane >> 5;
    const int xl_ = blockIdx.x & 7, j_ = blockIdx.x >> 3, bh = xl_ + 8 * (j_ >> 1), vh = j_ & 1, v = 32 * vh + l31;
    typedef unsigned rw_u32x2 __attribute__((ext_vector_type(2)));
    typedef unsigned rw_u32x4 __attribute__((ext_vector_type(4)));
    const unsigned lds0 = (unsigned)(uintptr_t)lds;
#define SQ_PIECE(c_, p_) do { const size_t cb_ = ((size_t)bh * NCH + (c_)) * 4096; const unsigned sl_ = lds0 + (unsigned)((c_) % SQ_NSLOT) * SQ_SLOT; \
        const bf16_t* src_ = ((p_) < 8) ? (PcT + cb_ + (p_) * 512 + lane * 8) : (LcB + cb_ + (size_t)(32 * vh) * 64 + ((p_) - 8) * 512 + lane * 8); \
        rw_glds16(src_, (unsigned)__builtin_amdgcn_readfirstlane(sl_ + (p_) * 1024)); } while (0)
#define SQ_ISSUE(c_) do { SQ_PIECE(c_, wid); if (wid < 4) SQ_PIECE(c_, wid + 8); } while (0)
    rw_f32x16 acc[2]; acc[0] = rw_f32x16{}; acc[1] = rw_f32x16{};
#pragma unroll
    for (int c = 0; c < SQ_DEPTH; ++c) SQ_ISSUE(c);
    for (int c = 0; c < NCH - 1; ++c) {
        if (c + SQ_DEPTH < NCH) {
            SQ_ISSUE(c + SQ_DEPTH);
            if (wid < 4) asm volatile("s_waitcnt vmcnt(%0)" :: "i"(SQ_DEPTH * 2) : "memory"); else asm volatile("s_waitcnt vmcnt(%0)" :: "i"(SQ_DEPTH) : "memory");
        } else asm volatile("s_waitcnt vmcnt(0)" ::: "memory");
        asm volatile("s_waitcnt lgkmcnt(0)\n\ts_barrier" ::: "memory");
        if (wid == 0) {
            const size_t cb = ((size_t)bh * NCH + c) * 4096;
            const LAS unsigned char* sl = lds + (c % SQ_NSLOT) * SQ_SLOT;
            rw_u32x2 lw[2][4], af[2][2][2][2];
            _Pragma("unroll") for (int wr = 0; wr < 2; ++wr) { const LAS unsigned char* prow = sl + (32 * wr + l31) * 128;
                _Pragma("unroll") for (int t = 0; t < 2; ++t) _Pragma("unroll") for (int sx = 0; sx < 2; ++sx) {
                    af[wr][t][sx][0] = *(const LAS rw_u32x2*)(prow + (32 * t + 16 * sx + 4 * hi) * 2); af[wr][t][sx][1] = *(const LAS rw_u32x2*)(prow + (32 * t + 16 * sx + 8 + 4 * hi) * 2); } }
            _Pragma("unroll") for (int wr = 0; wr < 2; ++wr) _Pragma("unroll") for (int g = 0; g < 4; ++g) lw[wr][g] = *(const LAS rw_u32x2*)(sl + 8192 + l31 * 128 + (32 * wr + 8 * g + 4 * hi) * 2);
            __builtin_amdgcn_sched_barrier(0);
            rw_bf16x8 bfr[2][2];
            _Pragma("unroll") for (int t = 0; t < 2; ++t) _Pragma("unroll") for (int sx = 0; sx < 2; ++sx) {
                rw_u32x4 pk = {rw_cvtpk(acc[t][8 * sx], acc[t][8 * sx + 1]), rw_cvtpk(acc[t][8 * sx + 2], acc[t][8 * sx + 3]), rw_cvtpk(acc[t][8 * sx + 4], acc[t][8 * sx + 5]), rw_cvtpk(acc[t][8 * sx + 6], acc[t][8 * sx + 7])};
                bfr[t][sx] = __builtin_bit_cast(rw_bf16x8, pk);
                *(rw_u32x2*)(SC + cb + v * 64 + 32 * t + 16 * sx + 4 * hi) = (rw_u32x2){pk.x, pk.y}; *(rw_u32x2*)(SC + cb + v * 64 + 32 * t + 16 * sx + 8 + 4 * hi) = (rw_u32x2){pk.z, pk.w}; }
            rw_f32x16 nacc[2];
            _Pragma("unroll") for (int wr = 0; wr < 2; ++wr) {
                _Pragma("unroll") for (int g = 0; g < 4; ++g) { const rw_u32x2 w = lw[wr][g];
                    nacc[wr][4 * g] = __uint_as_float(w.x << 16); nacc[wr][4 * g + 1] = __uint_as_float(w.x & 0xffff0000u); nacc[wr][4 * g + 2] = __uint_as_float(w.y << 16); nacc[wr][4 * g + 3] = __uint_as_float(w.y & 0xffff0000u); }
                _Pragma("unroll") for (int t = 0; t < 2; ++t) _Pragma("unroll") for (int sx = 0; sx < 2; ++sx) {
                    const rw_u32x2 a0 = af[wr][t][sx][0], a1 = af[wr][t][sx][1];
                    rw_u32x4 pk = {a0.x, a0.y, a1.x, a1.y};
                    nacc[wr] = __builtin_amdgcn_mfma_f32_32x32x16_bf16(__builtin_bit_cast(rw_bf16x8, pk), bfr[t][sx], nacc[wr], 0, 0, 0); }
            }
            acc[0] = nacc[0]; acc[1] = nacc[1];
        }
    }
    if (wid == 0) {
        const size_t cb = ((size_t)bh * NCH + (NCH - 1)) * 4096;
        _Pragma("unroll") for (int t = 0; t < 2; ++t) _Pragma("unroll") for (int g = 0; g < 4; ++g) {
            rw_u32x2 w; w.x = rw_cvtpk(acc[t][4 * g], acc[t][4 * g + 1]); w.y = rw_cvtpk(acc[t][4 * g + 2], acc[t][4 * g + 3]);
            *(rw_u32x2*)(SC + cb + v * 64 + 32 * t + 8 * g + 4 * hi) = w; }
    }
#undef SQ_PIECE
#undef SQ_ISSUE
}

__device__ __forceinline__ void ph_rw_out(const bf16_t* SC, const bf16_t* QcT, const bf16_t* YlT, const bf16_t* V1, const bf16_t* LOUT, const float* BON,
                                          const float* lnx_g, const float* lnx_b, bf16_t* MIX, const float* SSQ, float* RSTD) {
    const int otid_ = otid();
    const int lane = otid_ & 63, l31 = lane & 31, hi = lane >> 5;
    const int gw = blockIdx.x * 8 + (otid_ >> 6), NGW = gridDim.x * 8;
    typedef unsigned rw_u32x2 __attribute__((ext_vector_type(2)));
    for (int task = gw; task < NCHUNK * 2; task += NGW) {
        const int cid = task >> 1, th = task & 1, bh = cid / NCH, c = cid % NCH, b = bh / RH, h = bh % RH;
        const size_t cb = (size_t)cid * 4096;
        const int tl = 32 * th + l31;
        const size_t trow = (size_t)b * S + (size_t)c * RC + tl;
        rw_f32x16 acc[2];
        _Pragma("unroll") for (int u = 0; u < 2; ++u) _Pragma("unroll") for (int g = 0; g < 4; ++g) { const rw_u32x2 w = *(const rw_u32x2*)(YlT + cb + tl * 64 + 32 * u + 8 * g + 4 * hi);
            acc[u][4 * g] = __uint_as_float(w.x << 16); acc[u][4 * g + 1] = __uint_as_float(w.x & 0xffff0000u); acc[u][4 * g + 2] = __uint_as_float(w.y << 16); acc[u][4 * g + 3] = __uint_as_float(w.y & 0xffff0000u); }
        rw_bf16x8 bq[4], as[2][4];
        _Pragma("unroll") for (int ks = 0; ks < 4; ++ks) { bq[ks] = *(const rw_bf16x8*)(QcT + cb + tl * 64 + 16 * ks + 8 * hi);
            _Pragma("unroll") for (int u = 0; u < 2; ++u) as[u][ks] = *(const rw_bf16x8*)(SC + cb + (32 * u + l31) * 64 + 16 * ks + 8 * hi); }
        rw_u32x2 vvr[2][4], ggr[2][4]; f32x4 lgr[2][4], lbr[2][4];
        _Pragma("unroll") for (int u = 0; u < 2; ++u) _Pragma("unroll") for (int g = 0; g < 4; ++g) { const int c0 = h * 64 + 32 * u + 8 * g + 4 * hi;
            vvr[u][g] = *(const rw_u32x2*)(V1 + trow * 512 + c0); ggr[u][g] = *(const rw_u32x2*)(LOUT + trow * 512 + c0); }
        const float bon = BON[trow * RH + h];
        const f32x4 sq0 = *(const f32x4*)(SSQ + trow * 8), sq1 = *(const f32x4*)(SSQ + trow * 8 + 4);
        _Pragma("unroll") for (int u = 0; u < 2; ++u) _Pragma("unroll") for (int g = 0; g < 4; ++g) { const int c0 = h * 64 + 32 * u + 8 * g + 4 * hi;
            lgr[u][g] = *(const f32x4*)(lnx_g + c0); lbr[u][g] = *(const f32x4*)(lnx_b + c0); }
        __builtin_amdgcn_sched_barrier(0);
        _Pragma("unroll") for (int ks = 0; ks < 4; ++ks)
            _Pragma("unroll") for (int u = 0; u < 2; ++u) acc[u] = __builtin_amdgcn_mfma_f32_32x32x16_bf16(as[u][ks], bq[ks], acc[u], 0, 0, 0);
        float sm = 0.f;
        _Pragma("unroll") for (int u = 0; u < 2; ++u) _Pragma("unroll") for (int r = 0; r < 16; ++r) sm += acc[u][r];
        { auto rr = __builtin_amdgcn_permlane32_swap(__float_as_uint(sm), __float_as_uint(sm), false, false); sm = __uint_as_float(rr[0]) + __uint_as_float(rr[1]); }
        const float mean = sm * (1.f / 64.f);
        float sq = 0.f;
        _Pragma("unroll") for (int u = 0; u < 2; ++u) _Pragma("unroll") for (int r = 0; r < 16; ++r) { const float dd = acc[u][r] - mean; sq += dd * dd; }
        { auto rr = __builtin_amdgcn_permlane32_swap(__float_as_uint(sq), __float_as_uint(sq), false, false); sq = __uint_as_float(rr[0]) + __uint_as_float(rr[1]); }
        const float rstd = rsqrtf(sq * (1.f / 64.f) + 64e-5f);
        const float msq = (((sq0.x + sq0.y) + (sq0.z + sq0.w)) + ((sq1.x + sq1.y) + (sq1.z + sq1.w))) * (1.f / 512.f) + 1e-6f;
        const float inv_rs = sqrtf(msq);
        if (h == 0 && hi == 0) RSTD[trow] = rsqrtf(msq);
        _Pragma("unroll") for (int u = 0; u < 2; ++u) _Pragma("unroll") for (int g = 0; g < 4; ++g) {
            const int v0 = 32 * u + 8 * g + 4 * hi, c0 = h * 64 + v0;
            const f32x4 lg = lgr[u][g], lb = lbr[u][g];
            const rw_u32x2 vv = vvr[u][g], gg = ggr[u][g];
            const float o0 = ((acc[u][4 * g] - mean) * rstd * lg.x + lb.x + bon * __uint_as_float(vv.x << 16)) * __uint_as_float(gg.x << 16) * inv_rs;
            const float o1 = ((acc[u][4 * g + 1] - mean) * rstd * lg.y + lb.y + bon * __uint_as_float(vv.x & 0xffff0000u)) * __uint_as_float(gg.x & 0xffff0000u) * inv_rs;
            const float o2 = ((acc[u][4 * g + 2] - mean) * rstd * lg.z + lb.z + bon * __uint_as_float(vv.y << 16)) * __uint_as_float(gg.y << 16) * inv_rs;
            const float o3 = ((acc[u][4 * g + 3] - mean) * rstd * lg.w + lb.w + bon * __uint_as_float(vv.y & 0xffff0000u)) * __uint_as_float(gg.y & 0xffff0000u) * inv_rs;
            rw_u32x2 w; w.x = rw_cvtpk(o0, o1); w.y = rw_cvtpk(o2, o3);
            *(rw_u32x2*)(MIX + trow * 1024 + 512 + c0) = w; }
    }
}

template <int COL0, int WIDTH>
__device__ __forceinline__ void ph_row_stats(LAS float* tab, const bf16_t* PROJ, const pg8::StaticOrder& so) {
    const int otid_ = otid();
    const int row = otid_ >> 1, hf = otid_ & 1;
    for (int i = 0; i < 2; ++i) { pg8::Unit u; if (!so.next(i, u)) break;
        const v4u* p = (const v4u*)(PROJ + (size_t)(u.pm * 256 + row) * PW + COL0 + (WIDTH / 2) * hf);
        float s = 0.f;
#pragma unroll
        for (int k = 0; k < WIDTH / 16; ++k) { const v4u w = p[k];
            const float a0 = __uint_as_float(w.x << 16), a1 = __uint_as_float(w.x & 0xffff0000u), a2 = __uint_as_float(w.y << 16), a3 = __uint_as_float(w.y & 0xffff0000u);
            const float a4 = __uint_as_float(w.z << 16), a5 = __uint_as_float(w.z & 0xffff0000u), a6 = __uint_as_float(w.w << 16), a7 = __uint_as_float(w.w & 0xffff0000u);
            s += ((a0 * a0 + a1 * a1) + (a2 * a2 + a3 * a3)) + ((a4 * a4 + a5 * a5) + (a6 * a6 + a7 * a7)); }
        s += __int_as_float(__builtin_amdgcn_update_dpp(0, __float_as_int(s), 0xB1, 0xF, 0xF, true));
        if (hf == 0) tab[256 * i + row] = rsqrtf(s * (1.f / WIDTH) + 1e-6f); }
    __syncthreads();
}

constexpr int N_PHASES = 13;
__global__ void __launch_bounds__(NTHR, 2) mk_fwd(Params p) {
    extern __shared__ __attribute__((aligned(16))) unsigned char lds_raw[];
    LAS unsigned char* lds = (LAS unsigned char*)lds_raw;
    volatile LAS unsigned* MISC = (volatile LAS unsigned*)(lds + 131072 + 320);
    { int u0 = threadIdx.x; asm volatile("" : "+v"(u0));
      for (int u = u0; u < (LDS_BYTES - 131072) / 4; u += NTHR) ((LAS unsigned*)(lds + 131072))[u] = 0u; }
    __syncthreads();
    unsigned* ctl = (unsigned*)(p.ws + WS_CTL);
    XcdBarrier bar; bar.bar = ctl + CW_BAR; bar.x = 0; bar.st = nullptr;
    if (!MK_PER_PHASE) bar = xcd_barrier_post(ctl + CW_BAR, MISC + 8);
#define GRID_BAR() do { if (!MK_PER_PHASE) xcd_barrier(bar); } while (0)
#define IN(k) (p.ph_lo <= (k) && (k) < p.ph_hi)
#define BOTH(k) (IN(k) && IN((k) + 1))
    unsigned char* ws = p.ws; unsigned char* ob = (unsigned char*)p.out;
    float* small = (float*)(ws + WS_SMALL);
    float* RSF = small + 3 * T; float* EW = small + 4 * T; int* EID = (int*)(small + 6 * T);
    int* POS = (int*)(small + 8 * T); float* ROWW = small + 10 * T; int* CNT = (int*)(small + 13 * T); int* TILE_E = (int*)(small + 13 * T + 8192);
    float* BON = small + 16 * T;
    bf16_t* PROJ = (bf16_t*)(ws + 4 * MiB);
    bf16_t* QcT = (bf16_t*)(ws + 148 * MiB); bf16_t* YlT = (bf16_t*)(ws + 180 * MiB);
    bf16_t* V1S = (bf16_t*)(ws + 212 * MiB);
    bf16_t* LIN = (bf16_t*)(ws + 244 * MiB);
    bf16_t* KN = (bf16_t*)(ws + 260 * MiB);
    bf16_t* PcTa = (bf16_t*)(ws + 244 * MiB); bf16_t* PcTb = (bf16_t*)(ws + 260 * MiB);
    bf16_t* WA = (bf16_t*)(ws + 292 * MiB);
    bf16_t* SC = (bf16_t*)(ws + 292 * MiB);
    bf16_t* GOUT = (bf16_t*)(ws + 356 * MiB);
    bf16_t* MIX = (bf16_t*)(ws + 388 * MiB);
    bf16_t* LcB = (bf16_t*)(ws + 452 * MiB);
    bf16_t* Wgu_t = (bf16_t*)(ws + 452 * MiB);
    bf16_t* Wd_t = (bf16_t*)(ws + 484 * MiB);
    bf16_t* W_o_t = (bf16_t*)(ws + 502 * MiB); bf16_t* W_uq_t = (bf16_t*)(ws + 504 * MiB); bf16_t* W_ukv_t = (bf16_t*)(ws + 504 * MiB + 512 * 1024); bf16_t* W_lora_t = (bf16_t*)(ws + 505 * MiB);
    float* SSQ = (float*)(ws + 500 * MiB); float* RSTD = (float*)(ws + 501 * MiB);
    float* WrT = (float*)(ws + 506 * MiB);
    bf16_t* XN = (bf16_t*)ob; bf16_t* W_in_t = (bf16_t*)(ob + 64 * MiB);
    bf16_t* Qb = (bf16_t*)ob; bf16_t* Kb = (bf16_t*)(ob + 48 * MiB); bf16_t* Vb = (bf16_t*)(ob + 96 * MiB);
    bf16_t* H2 = (bf16_t*)(ws + 36 * MiB);
    int* SRC = (int*)(ws + 100 * MiB); float* ROWRS = (float*)(ws + 101 * MiB);
    bf16_t* HID = (bf16_t*)(ws + 196 * MiB);
    bf16_t* YS = (bf16_t*)(ws + 232 * MiB);
    const int G = (int)gridDim.x, bx = (int)blockIdx.x;

    if (IN(0)) { ProW w{p.x, p.w_in, p.g_mix, p.w_o, p.w_uq, p.g_cq, p.w_uk, p.w_uv, p.g_ckv, p.rw_w2, p.rw_a2, p.rw_g2, p.w_group, p.w_expert, p.g_ffn, p.g_mla_out, XN, W_in_t, W_o_t, W_uq_t, W_ukv_t, W_lora_t, WrT};
        ph_prologue(lds, w); if (BOTH(0)) GRID_BAR(); }
    if (IN(1)) {
        pg8::Gemm g{XN, W_in_t, T, PW, D, D, D, nullptr}; pg8::StaticOrder So; So.init(T, PW, G, bx);
        pg8::EpiBf16<0> E{PROJ, PW, nullptr, 0, 0, 1.f};
        pg8::gemm_phase<pg8::EpiBf16<0>, pg8::StaticOrder, PG8_ALIGN, PG8_SP2, D, D, D>(lds, g, So, E);
        if (BOTH(1)) GRID_BAR(); }
    if (IN(2)) {
        { pg8::Gemm g{PROJ, W_uq_t, T, 768, QR, PW, QR, nullptr}; pg8::TagOrder So; So.so.init(T, 768, G, bx);
          LAS float* cq_rs = (LAS float*)(lds + 131072 + 4096);
          ph_row_stats<0, QR>(cq_rs, PROJ, So.so);
          pg8::EpiBf16RS E{Qb, 768, nullptr, 0, 0, 0, cq_rs};
          pg8::gemm_phase<pg8::EpiBf16RS, pg8::TagOrder, PG8_ALIGN, PG8_SP2, QR, PW, QR>(lds, g, So, E); }
        { pg8::Gemm g{PROJ + QR, W_ukv_t, T, 1024, KVR, PW, KVR, nullptr}; pg8::TagOrder So; So.so.init(T, 1024, G, bx);
          LAS float* ckv_rs = (LAS float*)(lds + 131072 + 4096);
          ph_row_stats<QR, KVR>(ckv_rs, PROJ, So.so);
          pg8::EpiBf16RS E{KN, 512, nullptr, 512, (size_t)(Vb - KN), 0, ckv_rs};
          pg8::gemm_phase<pg8::EpiBf16RS, pg8::TagOrder, PG8_ALIGN, PG8_SP2, KVR, PW, KVR>(lds, g, So, E); }
        ph_rw_prep1(PROJ, p.rw_mu, LIN);
        if (BOTH(2)) GRID_BAR(); }
    if (IN(3)) {
          ph_mla_prep(PROJ, Qb, KN, Kb, Vb, p.pos, p.g_qn, p.g_kn);
        { pg8::Gemm g{LIN, W_lora_t, T, 1536, 128, 256, 128, nullptr}; pg8::LoraOrder So; So.so.init(T, 1536, G, bx);
          pg8::EpiBf16RS E{WA, 1024, nullptr, 1024, (size_t)(GOUT - WA), 512};
          pg8::gemm_phase<pg8::EpiBf16RS, pg8::LoraOrder, PG8_ALIGN, PG8_SP2, 128, 256, 128>(lds, g, So, E); }
        if (BOTH(3)) GRID_BAR(); }
    if (IN(4)) {
        { ch::In cin{PROJ, WA, p.rw_mu, p.rw_w0, p.rw_a0, p.rw_k_k, p.rw_k_a, p.rw_r_k, BON, V1S}; ch::phase(lds, cin, PcTa, PcTb, LcB, QcT, YlT); }
        if (BOTH(4)) GRID_BAR(); }
    if (IN(5)) {
        if (bx < NB * RH * 2) ph_rw_seq(lds, PcTa, PcTb, LcB, SC);
        att::phase((char*)lds_raw, (unsigned*)ctl + CW_ATTQ, Qb, Kb, Vb, MIX, SSQ, p.pos, p.g_qn);
        if (BOTH(5)) GRID_BAR(); }
    if (IN(6)) { ph_rw_out(SC, QcT, YlT, V1S, GOUT, BON, p.rw_lnx_g, p.rw_lnx_b, MIX, SSQ, RSTD);
        ph_moe_weights(lds, p.g_ffn, p.w_gate, p.w_up, p.w_down, Wgu_t, Wd_t);
        if (BOTH(6)) GRID_BAR(); }
    if (IN(7)) {
        pg8::Gemm g{MIX, W_o_t, T, D, D, D, D, nullptr}; pg8::StaticOrder So; So.init(T, D, G, bx);
        pg8::EpiF32Res E{p.x, nullptr, D, H2, RSTD};
        pg8::gemm_phase<pg8::EpiF32Res, pg8::StaticOrder, PG8_ALIGN, PG8_SP2, D, D, D>(lds, g, So, E);
        if (BOTH(7)) GRID_BAR(); }
    if (IN(8)) { ph_moe_route(lds, H2, p.g_ffn, WrT, p.b_group, p.b_expert, EID, EW, RSF, CNT); if (BOTH(8)) GRID_BAR(); }
    if (IN(9)) { ph_moe_scatter(lds, RSF, EID, EW, CNT, POS, ROWW, SRC, ROWRS, TILE_E); if (BOTH(9)) GRID_BAR(); }
    if (IN(10)) {
        const int ntiles = TILE_E[MOE_MAXT];
        pg8::Gemm g{H2, Wgu_t, 0, 0, D, D, D, SRC}; pg8::MoeOrder<2> So{TILE_E, ntiles * 2, G, bx};
        pg8::EpiSwiGLU E{HID, ROWW, ROWRS};
        pg8::gemm_phase<pg8::EpiSwiGLU, pg8::MoeOrder<2>, PG8_ALIGN, PG8_SP2, D, D, D, true>(lds, g, So, E);
        ph_moe_wd_part(lds, p.w_down, Wd_t, 64);
        if (BOTH(10)) GRID_BAR(); }
    if (IN(11)) {
        const int ntiles = TILE_E[MOE_MAXT];
        pg8::Gemm g{HID, Wd_t, 0, 0, DE, DE, DE, nullptr}; pg8::MoeOrder<4> So{TILE_E, ntiles * 4, G, bx};
        pg8::EpiBf16Mod<4> E{YS, D};
        pg8::gemm_phase<pg8::EpiBf16Mod<4>, pg8::MoeOrder<4>, PG8_ALIGN, PG8_SP2, DE, DE, DE>(lds, g, So, E);
        if (BOTH(11)) GRID_BAR(); }
    if (IN(12)) { ph_moe_combine(p.out, H2, YS, POS); }
}

extern "C" void kernel_launch(void* const* d_in, const int* in_sizes, int n_in, void* d_out, int out_size, void* d_ws, size_t ws_size, hipStream_t stream) {
    static int grid = 0;
    if (grid == 0) {
        if (n_in != 32 || out_size != T * D || ws_size < 512 * MiB) { fprintf(stderr, "kernel_launch: unexpected shapes (n_in %d out %d ws %zu)\n", n_in, out_size, ws_size); grid = -1; return; }
        int dev = 0, cus = 0, per_cu = 0;
        if (hipGetDevice(&dev) != hipSuccess || hipDeviceGetAttribute(&cus, hipDeviceAttributeMultiprocessorCount, dev) != hipSuccess) { grid = -1; return; }
        if (hipFuncSetAttribute((const void*)mk_fwd, hipFuncAttributeMaxDynamicSharedMemorySize, LDS_BYTES) != hipSuccess) { fprintf(stderr, "kernel_launch: hipFuncSetAttribute failed\n"); grid = -1; return; }
        if (hipOccupancyMaxActiveBlocksPerMultiprocessor(&per_cu, (const void*)mk_fwd, NTHR, LDS_BYTES) != hipSuccess || per_cu < 1) { fprintf(stderr, "kernel_launch: occupancy query says %d blocks/CU\n", per_cu); grid = -1; (void)hipGetLastError(); return; }
        grid = cus;
        if (T % grid != 0 || (T / grid) * 2 > NTHR) { fprintf(stderr, "kernel_launch: unsupported CU count %d\n", cus); grid = -1; return; }
    }
    if (grid < 0) return;
    (void)hipMemsetAsync((char*)d_ws + WS_CTL, 0, CTL_ZERO_BYTES, stream);
    Params p{};
    p.x = (const float*)d_in[0]; p.pos = (const int*)d_in[1];
    p.g_mix = (const float*)d_in[2]; p.w_in = (const float*)d_in[3]; p.g_cq = (const float*)d_in[4]; p.w_uq = (const float*)d_in[5];
    p.g_ckv = (const float*)d_in[6]; p.w_uk = (const float*)d_in[7]; p.w_uv = (const float*)d_in[8]; p.g_qn = (const float*)d_in[9];
    p.g_kn = (const float*)d_in[10]; p.g_mla_out = (const float*)d_in[11]; p.rw_mu = (const float*)d_in[12]; p.rw_w0 = (const float*)d_in[13];
    p.rw_w2 = (const float*)d_in[14]; p.rw_a0 = (const float*)d_in[15]; p.rw_a2 = (const float*)d_in[16]; p.rw_g2 = (const float*)d_in[17];
    p.rw_k_k = (const float*)d_in[18]; p.rw_k_a = (const float*)d_in[19]; p.rw_r_k = (const float*)d_in[20]; p.rw_lnx_g = (const float*)d_in[21];
    p.rw_lnx_b = (const float*)d_in[22]; p.w_o = (const float*)d_in[23]; p.g_ffn = (const float*)d_in[24]; p.w_group = (const float*)d_in[25];
    p.b_group = (const float*)d_in[26]; p.w_expert = (const float*)d_in[27]; p.b_expert = (const float*)d_in[28]; p.w_gate = (const float*)d_in[29];
    p.w_up = (const float*)d_in[30]; p.w_down = (const float*)d_in[31];
    p.out = (float*)d_out; p.ws = (unsigned char*)d_ws;
#if MK_PER_PHASE
    for (int k = 0; k < N_PHASES; ++k) { p.ph_lo = k; p.ph_hi = k + 1; hipLaunchKernelGGL(mk_fwd, dim3(grid), dim3(NTHR), LDS_BYTES, stream, p); }
#else
    p.ph_lo = 0; p.ph_hi = N_PHASES;
    hipLaunchKernelGGL(mk_fwd, dim3(grid), dim3(NTHR), LDS_BYTES, stream, p);
#endif
}
```

```cpp
#include <hip/hip_runtime.h>
#include <stdint.h>
#include <math.h>
#include <cstdio>

#ifndef PROBE_MASK
#define PROBE_MASK 0u
#endif
#define NREP(k) (((PROBE_MASK >> (k)) & 1u) ? 3 : 1)
#ifndef MK_PER_PHASE
#define MK_PER_PHASE 0
#endif

typedef unsigned short bf16_t;
constexpr int NB = 4, S = 8192, D = 1024, T = NB * S;
constexpr int H = 8, NOPE = 64, ROPE = 32, QK = 96, VD = 64, MLAW = 512, QR = 256, KVR = 128;
constexpr int RH = 8, RN = 64, RW = 512;
constexpr int MLA_IN = 416, RWKV_IN = 1792, INW = 2208;
constexpr int NG = 4, EPG = 8, NE = 32, DE = 256;
constexpr int NTHR = 512, LDS_BYTES = 147456;

#define LAS __attribute__((address_space(3)))
#define WAVE_SYNC() asm volatile("s_waitcnt lgkmcnt(0)" ::: "memory")
#define LDS_BARRIER() asm volatile("s_waitcnt lgkmcnt(0)\n\ts_barrier" ::: "memory")

__device__ __forceinline__ float bf2f(bf16_t v) { return __uint_as_float(((unsigned)v) << 16); }
__device__ __forceinline__ bf16_t f2bf(float f) { unsigned u = __float_as_uint(f); return (bf16_t)((u + 0x7fffu + ((u >> 16) & 1u)) >> 16); }
__device__ __forceinline__ float ldf(const float* p) { return *p; }
__device__ __forceinline__ float ldf(const bf16_t* p) { return bf2f(*p); }
__device__ __forceinline__ void stf(float* p, float v) { *p = v; }
__device__ __forceinline__ void stf(bf16_t* p, float v) { *p = f2bf(v); }

__device__ __forceinline__ int otid() { int t = threadIdx.x; asm volatile("" : "+v"(t)); return t; }
#define XB_TMO      128
#define XB_XCNT(j)  (256  + 64 * (j))
#define XB_XSUB(j)  (1280 + 64 * (j))
#define XB_XGEN(j)  (2304 + 64 * (j))
#define XB_TOP      3328
#define XB_TOPGEN   3392
#define XCD_BAR_WORDS 3456
#define XB_SPIN_CAP (1u << 18)
__device__ __forceinline__ unsigned xb_ld(unsigned* p)              { return __hip_atomic_load(p, __ATOMIC_RELAXED, __HIP_MEMORY_SCOPE_AGENT); }
__device__ __forceinline__ unsigned xb_add(unsigned* p, unsigned v) { return __hip_atomic_fetch_add(p, v, __ATOMIC_RELAXED, __HIP_MEMORY_SCOPE_AGENT); }
__device__ __forceinline__ unsigned xb_xcc_id() { return (unsigned)__builtin_amdgcn_s_getreg((3 << 11) | 20) & 0xFu; }
#define XB_SPIN(cond, bar) do { unsigned _sp = 0; while (cond) { __builtin_amdgcn_s_sleep(1); \
    if ((++_sp & 255u) == 0u) { if (xb_ld(&(bar)[XB_TMO])) break; if (_sp > XB_SPIN_CAP) { atomicAdd(&(bar)[XB_TMO], 1u); break; } } } } while (0)
struct XcdBarrier { unsigned* bar; unsigned x; volatile LAS unsigned* st; };
__device__ __forceinline__ XcdBarrier xcd_barrier_post(unsigned* bar, volatile LAS unsigned* st) {
    XcdBarrier b; b.bar = bar; b.x = xb_xcc_id(); b.st = st;
    if (threadIdx.x == 0) (void)xb_add(&bar[XB_XCNT(b.x)], 1u);
    return b;
}
__device__ __forceinline__ void xcd_barrier_complete(unsigned* bar, unsigned x, unsigned& nloc, unsigned& nx) {
    const unsigned G = gridDim.x * gridDim.y * gridDim.z;
    unsigned sum, cnt, mine, sp = 0u;
    for (;;) {
        sum = 0u; cnt = 0u; mine = 0u;
#pragma unroll
        for (unsigned j = 0; j < 16; ++j) { const unsigned c = xb_ld(&bar[XB_XCNT(j)]); sum += c; cnt += (c > 0u) ? 1u : 0u; mine = (j == x) ? c : mine; }
        if (sum == G) break;
        __builtin_amdgcn_s_sleep(1);
        if ((++sp & 255u) == 0u) { if (xb_ld(&bar[XB_TMO])) break; if (sp > XB_SPIN_CAP) { atomicAdd(&bar[XB_TMO], 1u); break; } }
    }
    nloc = mine > 0u ? mine : 1u; nx = cnt > 0u ? cnt : 1u;
}
__device__ __forceinline__ void xcd_barrier(const XcdBarrier& b) {
    asm volatile("s_waitcnt vmcnt(0)" ::: "memory");
    __syncthreads();
    if (threadIdx.x == 0) {
        unsigned* bar = b.bar;
        __builtin_amdgcn_s_waitcnt(0);
        unsigned nloc = b.st[0], nx = b.st[1];
        if (nloc == 0u) { xcd_barrier_complete(bar, b.x, nloc, nx); b.st[0] = nloc; b.st[1] = nx; }
        const unsigned old = xb_add(&bar[XB_XSUB(b.x)], 1u);
        const unsigned gen = old / nloc;
        if (old + 1u == (gen + 1u) * nloc) {
            __builtin_amdgcn_fence(__ATOMIC_RELEASE, "agent");
            asm volatile("s_waitcnt vmcnt(0)" ::: "memory");
            const unsigned og = xb_add(&bar[XB_TOP], 1u);
            const unsigned tg = og / nx;
            if (og + 1u == (tg + 1u) * nx) xb_add(&bar[XB_TOPGEN], 1u);
            else XB_SPIN(xb_ld(&bar[XB_TOPGEN]) == tg, bar);
            __builtin_amdgcn_fence(__ATOMIC_ACQUIRE, "agent");
            xb_add(&bar[XB_XGEN(b.x)], 1u);
            asm volatile("s_waitcnt vmcnt(0)" ::: "memory");
        } else {
            XB_SPIN(xb_ld(&bar[XB_XGEN(b.x)]) == gen, bar);
            __builtin_amdgcn_fence(__ATOMIC_ACQUIRE, "agent");
            asm volatile("s_waitcnt vmcnt(0)" ::: "memory");
        }
    }
    __syncthreads();
}

namespace pg8 {
#define PG8_LAS __attribute__((address_space(3)))
typedef unsigned short bf16_t;
typedef short bf16x8 __attribute__((ext_vector_type(8)));
typedef float f32x4 __attribute__((ext_vector_type(4)));
typedef unsigned u32x4 __attribute__((ext_vector_type(4)));
constexpr int BM = 256, BK = 64, HALF = 128, HTB = HALF * BK * 2  , STAGE_BYTES = 8 * HTB, NXCD = 8, WGM = 8;

__host__ __device__ __forceinline__ int lds_byte(int r, int c) { const int st = (r >> 4) * 2 + (c >> 5), rr = r & 15, cc = c & 31, ob = rr * 64 + cc * 2; return st * 1024 + (ob ^ (((ob >> 9) & 1) << 5)); }
__host__ __device__ __forceinline__ void stage_rc(int b, int& R, int& C) { const int st = b / 1024, sb = b % 1024, swz = sb ^ (((sb >> 9) & 1) << 5); R = (st >> 1) * 16 + swz / 64; C = (st & 1) * 32 + (swz % 64) / 2; }
__host__ __device__ __forceinline__ int perm32(int rho) { const int n = rho >> 4, i = rho & 15; return 8 * (i >> 2) + 4 * n + (i & 3); }

struct Unit { int pm, pn, ao; int tag = 0; };
struct Gemm { const bf16_t* A; const bf16_t* Bt; int M, N, K, lda, ldb; const int* src; };

struct StaticOrder {
    int nM, nN, nwg, G, c;
    __host__ __device__ void init(int M, int N, int G_, int c_) { nM = M / BM; nN = N / BM; nwg = nM * nN; G = G_; c = c_; }
    __host__ __device__ bool next(int i, Unit& u) const {
        const long L = (long)i * G + c; if (L >= nwg) return false;
        int wgid = (int)L; { const int q = nwg / NXCD, r = nwg % NXCD, xcd = wgid % NXCD, off = wgid / NXCD; wgid = (xcd < r ? xcd * (q + 1) : r * (q + 1) + (xcd - r) * q) + off; }
        const int nig = WGM * nN, gid = wgid / nig, fm = gid * WGM, gsz = (nM - fm) < WGM ? (nM - fm) : WGM;
        u.pm = fm + ((wgid % nig) % gsz); u.pn = (wgid % nig) / gsz; u.ao = 0; return true;
    }
    __device__ __forceinline__ void a_ready(const Unit&) const {}
    __device__ __forceinline__ void done(const Unit&) const {}
};

__device__ __forceinline__ unsigned cvt_pk_bf16(float lo, float hi) { unsigned r; asm volatile("v_cvt_pk_bf16_f32 %0, %1, %2" : "=v"(r) : "v"(lo), "v"(hi)); return r; }
typedef float f32x2 __attribute__((ext_vector_type(2)));
__device__ __forceinline__ f32x2 gelu_pk(f32x2 v) {
    const f32x2 av = __builtin_elementwise_abs(v), d = av * 0.2316418882f + 1.0f;
    f32x2 t; t.x = __builtin_amdgcn_rcpf(d.x); t.y = __builtin_amdgcn_rcpf(d.y);
    f32x2 q = t * 0.5307027145f + (-0.7265760135f); q = q * t + 0.7107068705f; q = q * t + (-0.142248368f); q = q * t + 0.127414796f; q = q * t;
    const f32x2 s = (v * v) * (-0.72134752044f);
    f32x2 e; e.x = __builtin_amdgcn_exp2f(s.x); e.y = __builtin_amdgcn_exp2f(s.y);
    const f32x2 m = v * (q * e), r = v - m;
    f32x2 o; o.x = v.x < 0.f ? m.x : r.x; o.y = v.y < 0.f ? m.y : r.y; return o;
}

template <int ACT  > struct EpiBf16 {
    static constexpr bool PERM = true, AFTER_DRAIN = false; static_assert(ACT == 0 || ACT == 1, "EpiBf16: ACT is 0 (none) or 1 (gelu_pk)");
    bf16_t* O; int ldc; const float* bias; int split_cols; size_t split_stride; float scale0;
    __device__ __forceinline__ void operator()(const f32x4 (&acc)[2][2][4][2], const Unit& u, int wr, int wc, int fr, int fq) const {
        const int row0 = u.pm * BM + wr * 64 + fr; int colt = u.pn * BM; bf16_t* base = O;
        float sc = 1.f; if (split_cols) { const int t = colt / split_cols; base += (size_t)t * split_stride; colt -= t * split_cols; if (t == 0) sc = scale0; }
        const int col0 = colt + wc * 32 + 8 * fq, bcol0 = u.pn * BM + wc * 32 + 8 * fq;
        f32x4 bv[2][2];
#pragma unroll
        for (int bj = 0; bj < 2; ++bj)
#pragma unroll
            for (int n = 0; n < 2; ++n) bv[bj][n] = bias ? *(const f32x4*)(bias + bcol0 + bj * HALF + 4 * n) : (f32x4){0.f, 0.f, 0.f, 0.f};
#pragma unroll
        for (int ai = 0; ai < 2; ++ai)
#pragma unroll
            for (int m = 0; m < 4; ++m) { bf16_t* rowp = base + (size_t)(row0 + ai * HALF + m * 16) * ldc + col0;
#pragma unroll
                for (int bj = 0; bj < 2; ++bj) { f32x4 v0 = acc[ai][bj][m][0] + bv[bj][0], v1 = acc[ai][bj][m][1] + bv[bj][1];
                    if (ACT == 1) { f32x2 a = gelu_pk((f32x2){v0[0], v0[1]}), b = gelu_pk((f32x2){v0[2], v0[3]}), c = gelu_pk((f32x2){v1[0], v1[1]}), d = gelu_pk((f32x2){v1[2], v1[3]});
                        v0 = (f32x4){a.x, a.y, b.x, b.y}; v1 = (f32x4){c.x, c.y, d.x, d.y}; }
                    v0 = v0 * sc; v1 = v1 * sc; u32x4 w; w.x = cvt_pk_bf16(v0[0], v0[1]); w.y = cvt_pk_bf16(v0[2], v0[3]); w.z = cvt_pk_bf16(v1[0], v1[1]); w.w = cvt_pk_bf16(v1[2], v1[3]);
                    *(u32x4*)(rowp + bj * HALF) = w; } }
    }
};
template <class Epi, class Sched, bool ALIGN_EPI, bool SP2, int KK, int LDA, int LDB, bool GATHER = false>
__device__ __forceinline__ void gemm_phase(PG8_LAS unsigned char* lds, const Gemm g, const Sched& S, const Epi& E) {
    const int tid = threadIdx.x, wid = __builtin_amdgcn_readfirstlane(tid >> 6), lane = tid & 63, wr = wid >> 2, wc = wid & 3, fr = lane & 15, fq = lane >> 4;
    constexpr int K = KK, nt = K / BK; static_assert(nt % 2 == 0 && nt >= 2, "K must be a multiple of 128");
    unsigned voffA[2], voffB[2];
#pragma unroll
    for (int i = 0; i < 2; ++i) { int R, C; stage_rc(tid * 16 + i * 8192, R, C); const int Rb = Epi::PERM ? ((R & ~31) + perm32(R & 31)) : R;
        voffA[i] = (unsigned)(R * LDA + C) * 2u; voffB[i] = (unsigned)(Rb * LDB + C) * 2u; }
    constexpr size_t kstep = (size_t)(BK * 2);
    constexpr size_t hstepA = (size_t)HALF * LDA * 2, hstepB = (size_t)HALF * LDB * 2;
    constexpr size_t tstepA = 2 * hstepA, tstepB = 2 * hstepB;
    const unsigned ldsw = (unsigned)wid * 1024u;
    const int aoff = lds_byte(wr * 64 + fr, fq * 8), boff = lds_byte(wc * 32 + fr, fq * 8);
#define PG8_SA(b, h) (((b) * 2 + (h)) * HTB)
#define PG8_SB(b, h) ((4 + (b) * 2 + (h)) * HTB)
#define PG8_STAGE(bufoff, gbase, voff) do { _Pragma("unroll") for (int _i = 0; _i < 2; ++_i) \
        __builtin_amdgcn_global_load_lds((const unsigned*)((const char*)(gbase) + (voff)[_i]), (PG8_LAS unsigned*)(lds + (bufoff) + ldsw + _i * 8192), 16, 0, 0); } while (0)
#define PG8_STA(bufoff, basep, h, nx) do { if constexpr (GATHER) { if (nx) PG8_STAGE(bufoff, basep, offN[h]); else PG8_STAGE(bufoff, basep, offC[h]); } else PG8_STAGE(bufoff, (basep) + (h) * hstepA, voffA); } while (0)
#define PG8_LDA(dst, b, h) do { _Pragma("unroll") for (int m = 0; m < 4; ++m) _Pragma("unroll") for (int k = 0; k < 2; ++k) dst[m][k] = *(const PG8_LAS bf16x8*)(lds + PG8_SA(b, h) + aoff + m * 2048 + k * 1024); } while (0)
#define PG8_LDB(dst, b, h) do { _Pragma("unroll") for (int n = 0; n < 2; ++n) _Pragma("unroll") for (int k = 0; k < 2; ++k) dst[n][k] = *(const PG8_LAS bf16x8*)(lds + PG8_SB(b, h) + boff + n * 2048 + k * 1024); } while (0)
#define PG8_MMA(ai, bj, At, Bt) do { __builtin_amdgcn_s_setprio(1); _Pragma("unroll") for (int m = 0; m < 4; ++m) _Pragma("unroll") for (int n = 0; n < 2; ++n) _Pragma("unroll") for (int k = 0; k < 2; ++k) \
        acc[ai][bj][m][n] = __builtin_amdgcn_mfma_f32_16x16x32_bf16(Bt[n][k], At[m][k], acc[ai][bj][m][n], 0, 0, 0); __builtin_amdgcn_s_setprio(0); } while (0)
#define PG8_WAIT_V(n) asm volatile("s_waitcnt vmcnt(" #n ")" ::: "memory")
#define PG8_WAIT_L(n) asm volatile("s_waitcnt lgkmcnt(" #n ")" ::: "memory")
#define PG8_BAR __builtin_amdgcn_s_barrier()
#define PG8_SCHED __builtin_amdgcn_sched_barrier(0)
    Unit cur, nxt; int ui = 0;
    if (!S.next(0, cur)) return;
    f32x4 acc[2][2][4][2];
#pragma unroll
    for (int a = 0; a < 2; ++a)
#pragma unroll
        for (int b = 0; b < 2; ++b)
#pragma unroll
            for (int m = 0; m < 4; ++m)
#pragma unroll
                for (int n = 0; n < 2; ++n) acc[a][b][m][n] = (f32x4){0.f, 0.f, 0.f, 0.f};
    bf16x8 At[4][2], B0[2][2], B1[2][2];
    const char* cA = GATHER ? (const char*)g.A : (const char*)g.A + (size_t)cur.pm * tstepA + cur.ao; const char* cB = (const char*)g.Bt + (size_t)cur.pn * tstepB;
    unsigned offC[2][2], offN[2][2];
    auto unit_offs = [&](const Unit& u_, unsigned (&o_)[2][2]) {
#pragma unroll
        for (int h_ = 0; h_ < 2; ++h_)
#pragma unroll
            for (int i_ = 0; i_ < 2; ++i_) { int R_, C_; stage_rc(tid * 16 + i_ * 8192, R_, C_); o_[h_][i_] = ((unsigned)g.src[u_.pm * BM + h_ * HALF + R_] * (unsigned)LDA + (unsigned)C_) * 2u; } };
    if constexpr (GATHER) { unit_offs(cur, offC); _Pragma("unroll") for (int h_ = 0; h_ < 2; ++h_) _Pragma("unroll") for (int i_ = 0; i_ < 2; ++i_) offN[h_][i_] = offC[h_][i_]; }
    S.a_ready(cur);
    if constexpr (SP2) {
        PG8_STAGE(PG8_SB(0, 0), cB, voffB); PG8_STAGE(PG8_SB(0, 1), cB + hstepB, voffB); PG8_STA(PG8_SA(0, 0), cA, 0, false); PG8_STA(PG8_SA(0, 1), cA, 1, false);
        if (wr == 1) PG8_BAR;
        PG8_WAIT_V(2); PG8_BAR;
        PG8_STAGE(PG8_SB(1, 0), cB + kstep, voffB); PG8_STA(PG8_SA(1, 0), cA + kstep, 0, false); PG8_STAGE(PG8_SB(1, 1), cB + hstepB + kstep, voffB);
        PG8_WAIT_V(6); PG8_BAR;
    } else {
        PG8_STAGE(PG8_SB(0, 0), cB, voffB); PG8_STAGE(PG8_SA(0, 0), cA, voffA); PG8_STAGE(PG8_SB(0, 1), cB + hstepB, voffB); PG8_STAGE(PG8_SA(0, 1), cA + hstepA, voffA);
        if (wr == 1) PG8_BAR;
        PG8_WAIT_V(4); PG8_BAR;
        PG8_STAGE(PG8_SB(1, 0), cB + kstep, voffB); PG8_STAGE(PG8_SA(1, 0), cA + kstep, voffA); PG8_STAGE(PG8_SB(1, 1), cB + hstepB + kstep, voffB);
        PG8_WAIT_V(6); PG8_BAR;
    }
    for (;;) {
        const bool has_next = S.next(ui + 1, nxt);
        const char* nA = GATHER ? cA : (has_next ? (const char*)g.A + (size_t)nxt.pm * tstepA + nxt.ao : cA);
        if constexpr (GATHER) { if (has_next) unit_offs(nxt, offN); } const char* nB = has_next ? (const char*)g.Bt + (size_t)nxt.pn * tstepB : cB;
_Pragma("unroll 1")
        for (int t = 0; t < nt; t += 2) {
            const bool last = (t == nt - 2);
            const char* a1 = cA + (size_t)(t + 1) * kstep;
            const char* a2 = last ? nA : cA + (size_t)(t + 2) * kstep; const char* b2 = last ? nB : cB + (size_t)(t + 2) * kstep;
            const char* a3 = a2 + kstep; const char* b3 = b2 + kstep;
            if (last && has_next) S.a_ready(nxt);
            if constexpr (SP2) {
            PG8_LDB(B0, 0, 0); PG8_LDB(B1, 0, 1); PG8_SCHED; PG8_LDA(At, 0, 0); PG8_STA(PG8_SA(1, 1), a1, 1, false);
            PG8_WAIT_V(8); PG8_WAIT_L(0); PG8_BAR; PG8_MMA(0, 0, At, B0); PG8_MMA(0, 1, At, B1); PG8_BAR; PG8_SCHED;
            PG8_LDA(At, 0, 1); PG8_STAGE(PG8_SB(0, 0), b2, voffB); PG8_STAGE(PG8_SB(0, 1), b2 + hstepB, voffB); PG8_STA(PG8_SA(0, 0), a2, 0, last);
            PG8_WAIT_V(8); PG8_WAIT_L(0); PG8_BAR; PG8_MMA(1, 0, At, B0); PG8_MMA(1, 1, At, B1); PG8_BAR; PG8_SCHED;
            PG8_LDB(B0, 1, 0); PG8_LDB(B1, 1, 1); PG8_SCHED; PG8_LDA(At, 1, 0); PG8_STA(PG8_SA(0, 1), a2, 1, last);
            PG8_WAIT_V(8); PG8_WAIT_L(0); PG8_BAR; PG8_MMA(0, 0, At, B0); PG8_MMA(0, 1, At, B1); PG8_BAR; PG8_SCHED;
            PG8_LDA(At, 1, 1); PG8_STAGE(PG8_SB(1, 0), b3, voffB); PG8_STAGE(PG8_SB(1, 1), b3 + hstepB, voffB); PG8_STA(PG8_SA(1, 0), a3, 0, last);
            PG8_WAIT_V(8); PG8_WAIT_L(0); PG8_BAR; PG8_MMA(1, 0, At, B0); PG8_MMA(1, 1, At, B1); PG8_BAR; PG8_SCHED;
            } else {
            PG8_LDB(B0, 0, 0); PG8_SCHED; PG8_LDA(At, 0, 0); PG8_STAGE(PG8_SA(1, 1), a1 + hstepA, voffA);
            PG8_WAIT_L(8); PG8_BAR; PG8_WAIT_L(0); PG8_MMA(0, 0, At, B0); PG8_BAR; PG8_SCHED;
            PG8_LDB(B1, 0, 1); PG8_STAGE(PG8_SB(0, 0), b2, voffB);
            PG8_BAR; PG8_WAIT_L(0); PG8_MMA(0, 1, At, B1); PG8_BAR;
            PG8_LDA(At, 0, 1); PG8_STAGE(PG8_SA(0, 0), a2, voffA);
            PG8_BAR; PG8_WAIT_L(0); PG8_MMA(1, 0, At, B0); PG8_BAR; PG8_SCHED;
            PG8_STAGE(PG8_SB(0, 1), b2 + hstepB, voffB);
            PG8_WAIT_V(6); PG8_BAR; PG8_MMA(1, 1, At, B1); PG8_BAR;
            PG8_LDB(B0, 1, 0); PG8_SCHED; PG8_LDA(At, 1, 0); PG8_STAGE(PG8_SA(0, 1), a2 + hstepA, voffA);
            PG8_WAIT_L(8); PG8_BAR; PG8_WAIT_L(0); PG8_MMA(0, 0, At, B0); PG8_BAR; PG8_SCHED;
            PG8_LDB(B1, 1, 1); PG8_STAGE(PG8_SB(1, 0), b3, voffB);
            PG8_BAR; PG8_WAIT_L(0); PG8_MMA(0, 1, At, B1); PG8_BAR;
            PG8_LDA(At, 1, 1); PG8_STAGE(PG8_SA(1, 0), a3, voffA);
            PG8_BAR; PG8_WAIT_L(0); PG8_MMA(1, 0, At, B0); PG8_BAR; PG8_SCHED;
            PG8_STAGE(PG8_SB(1, 1), b3 + hstepB, voffB);
            PG8_WAIT_V(6); PG8_BAR; PG8_MMA(1, 1, At, B1); PG8_BAR;
            }
        }
        if constexpr (ALIGN_EPI) { if (wr == 0) PG8_BAR; }
        if constexpr (!Epi::AFTER_DRAIN) { E(acc, cur, wr, wc, fr, fq); S.done(cur); }
        if (!has_next) break;
#pragma unroll
        for (int a = 0; a < 2; ++a)
#pragma unroll
            for (int b = 0; b < 2; ++b)
#pragma unroll
                for (int m = 0; m < 4; ++m)
#pragma unroll
                    for (int n = 0; n < 2; ++n) acc[a][b][m][n] = (f32x4){0.f, 0.f, 0.f, 0.f};
        cur = nxt; cA = nA; cB = nB; ++ui;
        if constexpr (GATHER) { _Pragma("unroll") for (int h_ = 0; h_ < 2; ++h_) _Pragma("unroll") for (int i_ = 0; i_ < 2; ++i_) offC[h_][i_] = offN[h_][i_]; }
        if constexpr (ALIGN_EPI) { if (wr == 1) PG8_BAR; }
    }
    PG8_WAIT_V(0);
    if constexpr (!ALIGN_EPI) { if (wr == 0) PG8_BAR; }
    PG8_BAR;
    if constexpr (Epi::AFTER_DRAIN) { E.fused(acc, cur, wr, wc, fr, fq, lds, wid, lane); S.done(cur); }
#undef PG8_SA
#undef PG8_SB
#undef PG8_STAGE
#undef PG8_STA
#undef PG8_LDA
#undef PG8_LDB
#undef PG8_MMA
#undef PG8_WAIT_V
#undef PG8_WAIT_L
#undef PG8_BAR
#undef PG8_SCHED
}
}

namespace pg8 {
struct EpiF32Res {
    static constexpr bool PERM = true, AFTER_DRAIN = false;
    const float* base; float* out; int ldc; bf16_t* obf; const float* rowscale;
    __device__ __forceinline__ void operator()(const f32x4 (&acc)[2][2][4][2], const Unit& u, int wr, int wc, int fr, int fq) const {
        const int col0 = u.pn * BM + wc * 32 + 8 * fq;
#pragma unroll
        for (int ai = 0; ai < 2; ++ai) {
            f32x4 xb[4][2][2]; float rs4[4];
#pragma unroll
            for (int m = 0; m < 4; ++m) { const int row_ = u.pm * BM + ai * HALF + wr * 64 + m * 16 + fr; const size_t off = (size_t)row_ * ldc + col0; rs4[m] = rowscale[row_];
#pragma unroll
                for (int bj = 0; bj < 2; ++bj) { xb[m][bj][0] = *(const f32x4*)(base + off + bj * HALF); xb[m][bj][1] = *(const f32x4*)(base + off + bj * HALF + 4); } }
            __builtin_amdgcn_sched_barrier(0);
#pragma unroll
            for (int m = 0; m < 4; ++m) { const int row_ = u.pm * BM + ai * HALF + wr * 64 + m * 16 + fr; const size_t off = (size_t)row_ * ldc + col0; const float rs_ = rs4[m];
#pragma unroll
                for (int bj = 0; bj < 2; ++bj) {
                    const f32x4 r0 = xb[m][bj][0] + acc[ai][bj][m][0] * rs_, r1 = xb[m][bj][1] + acc[ai][bj][m][1] * rs_;
                    if (out) { *(f32x4*)(out + off + bj * HALF) = r0; *(f32x4*)(out + off + bj * HALF + 4) = r1; }
                    if (obf) { u32x4 w_; w_.x = cvt_pk_bf16(r0[0], r0[1]); w_.y = cvt_pk_bf16(r0[2], r0[3]); w_.z = cvt_pk_bf16(r1[0], r1[1]); w_.w = cvt_pk_bf16(r1[2], r1[3]); *(u32x4*)(obf + off + bj * HALF) = w_; } } } }
    }
};
}

namespace pg8 {
struct EpiBf16RS {
    static constexpr bool PERM = true, AFTER_DRAIN = false;
    bf16_t* O; int ldc; const float* rowscale; int split_cols; size_t split_stride; int ldc_hi;
    const PG8_LAS float* lrs;
    __device__ __forceinline__ void operator()(const f32x4 (&acc)[2][2][4][2], const Unit& u, int wr, int wc, int fr, int fq) const {
        const int row0 = u.pm * BM + wr * 64 + fr; int colt = u.pn * BM; bf16_t* base = O; int ldc = this->ldc;
        if (split_cols) { const int t = colt / split_cols; base += (size_t)t * split_stride; colt -= t * split_cols; if (t > 0 && ldc_hi) ldc = ldc_hi; }
        const int col0 = colt + wc * 32 + 8 * fq;
#pragma unroll
        for (int ai = 0; ai < 2; ++ai)
#pragma unroll
            for (int m = 0; m < 4; ++m) { const int row = row0 + ai * HALF + m * 16; const float sc = lrs ? lrs[256 * u.tag + (row - u.pm * BM)] : (rowscale ? rowscale[row] : 1.f); bf16_t* rowp = base + (size_t)row * ldc + col0;
#pragma unroll
                for (int bj = 0; bj < 2; ++bj) { const f32x4 v0 = acc[ai][bj][m][0] * sc, v1 = acc[ai][bj][m][1] * sc;
                    u32x4 w; w.x = cvt_pk_bf16(v0[0], v0[1]); w.y = cvt_pk_bf16(v0[2], v0[3]); w.z = cvt_pk_bf16(v1[0], v1[1]); w.w = cvt_pk_bf16(v1[2], v1[3]);
                    *(u32x4*)(rowp + bj * HALF) = w; } }
    }
};
struct TagOrder { StaticOrder so;
    __device__ __forceinline__ bool next(int i, Unit& u) const { if (!so.next(i, u)) return false; u.tag = i; return true; }
    __device__ __forceinline__ void a_ready(const Unit&) const {}
    __device__ __forceinline__ void done(const Unit&) const {}
};
struct LoraOrder { StaticOrder so;
    __device__ __forceinline__ bool next(int i, Unit& u) const { if (!so.next(i, u)) return false; u.ao = (u.pn >= 4) ? 256 : 0; return true; }
    __device__ __forceinline__ void a_ready(const Unit&) const {}
    __device__ __forceinline__ void done(const Unit&) const {}
};
}
#ifndef PG8_SP2
#define PG8_SP2 true
#endif
#ifndef PG8_ALIGN
#define PG8_ALIGN true
#endif

typedef unsigned v4u __attribute__((ext_vector_type(4)));
typedef float f32x4 __attribute__((ext_vector_type(4)));
#define GAS __attribute__((address_space(1)))
#define LDS_WAIT() asm volatile("s_waitcnt lgkmcnt(0)" ::: "memory")
__device__ __forceinline__ unsigned pk2(float lo, float hi) { return (unsigned)f2bf(lo) | ((unsigned)f2bf(hi) << 16); }
__device__ __forceinline__ void p0_transpose_item(const float* W, int ldw, int N, const float* kgain, bf16_t* WT, int ldt, int row_off, LAS float* scr, int item, int lane) {
    const int nblk = N / 32, kb = item / nblk, nb = item % nblk, k0 = 64 * kb, n0 = 32 * nb;
    float tv[32];
#pragma unroll
    for (int i = 0; i < 32; ++i) { const int kk = 2 * i + (lane >> 5); tv[i] = W[(size_t)(k0 + kk) * ldw + n0 + (lane & 31)]; }
#pragma unroll
    for (int i = 0; i < 32; ++i) { const int kk = 2 * i + (lane >> 5); float v = tv[i]; if (kgain) v *= kgain[k0 + kk]; scr[kk * 33 + (lane & 31)] = v; }
    LDS_WAIT(); asm volatile("" ::: "memory");
    const int c = lane & 7;
#pragma unroll
    for (int j = 0; j < 4; ++j) { const int n = (lane >> 3) + 8 * j; const LAS float* sp = scr + (8 * c) * 33 + n;
        v4u o; o.x = pk2(sp[0 * 33], sp[1 * 33]); o.y = pk2(sp[2 * 33], sp[3 * 33]); o.z = pk2(sp[4 * 33], sp[5 * 33]); o.w = pk2(sp[6 * 33], sp[7 * 33]);
        *(v4u*)(WT + (size_t)(row_off + n0 + n) * ldt + k0 + 8 * c) = o; }
    LDS_WAIT(); asm volatile("" ::: "memory");
}
__device__ __forceinline__ float wave_sum(float v) {
#pragma unroll
    for (int o = 1; o < 64; o <<= 1) v += __shfl_xor(v, o);
    return v;
}
__device__ __forceinline__ void rms_row_to_bf16(const float* xrow, bf16_t* orow, int lane) {
    const f32x4* xr = (const f32x4*)xrow + lane;
    f32x4 v[4]; float s = 0.f;
#pragma unroll
    for (int j = 0; j < 4; ++j) { v[j] = xr[64 * j]; s += (v[j].x * v[j].x + v[j].y * v[j].y) + (v[j].z * v[j].z + v[j].w * v[j].w); }
    const float rstd = rsqrtf(wave_sum(s) * (1.f / D) + 1e-6f);
    unsigned long long* o8 = (unsigned long long*)orow + lane;
#pragma unroll
    for (int j = 0; j < 4; ++j) o8[64 * j] = (unsigned long long)pk2(v[j].x * rstd, v[j].y * rstd) | ((unsigned long long)pk2(v[j].z * rstd, v[j].w * rstd) << 32);
}
constexpr int PW = 2304;
struct ProW { const float *x, *w_in, *g_mix, *w_o, *w_uq, *g_cq, *w_uk, *w_uv, *g_ckv, *w2, *a2, *g2, *w_group, *w_expert, *g_ffn, *g_mo; bf16_t *XN, *W_in_t, *W_o_t, *W_uq_t, *W_ukv_t, *W_lora_t; float* WrT; };
__device__ __forceinline__ void ph_prologue(LAS unsigned char* lds, const ProW& w) {
    const int otid_ = otid();
    const int lane = otid_ & 63, wave = otid_ >> 6;
    LAS float* scr = (LAS float*)(lds + wave * 16384);
    const int gw = blockIdx.x * 8 + wave, NGW = gridDim.x * 8;
    constexpr int I_IN = (D / 64) * (INW / 32), I_O = (D / 64) * (D / 32), I_UQ = (QR / 64) * (768 / 32), I_UK = (KVR / 64) * (512 / 32), I_W2 = 512 / 32, I_G2 = 2 * (512 / 32);
    constexpr int E1 = I_IN, E2 = E1 + I_O, E3 = E2 + I_UQ, E4 = E3 + I_UK, E5 = E4 + I_UK, E6 = E5 + I_W2, E7 = E6 + I_W2, E8 = E7 + I_G2;
    for (int it = gw; it < E8; it += NGW) {
        if (it < E1) p0_transpose_item(w.w_in, INW, INW, w.g_mix, w.W_in_t, D, 0, scr, it, lane);
        else if (it < E2) p0_transpose_item(w.w_o, D, D, (it - E1) / (D / 32) < 8 ? w.g_mo : nullptr, w.W_o_t, D, 0, scr, it - E1, lane);
        else if (it < E3) p0_transpose_item(w.w_uq, 768, 768, w.g_cq, w.W_uq_t, QR, 0, scr, it - E2, lane);
        else if (it < E4) p0_transpose_item(w.w_uk, 512, 512, w.g_ckv, w.W_ukv_t, KVR, 0, scr, it - E3, lane);
        else if (it < E5) p0_transpose_item(w.w_uv, 512, 512, w.g_ckv, w.W_ukv_t, KVR, 512, scr, it - E4, lane);
        else if (it < E6) p0_transpose_item(w.w2, 512, 512, nullptr, w.W_lora_t, 128, 0, scr, it - E5, lane);
        else if (it < E7) p0_transpose_item(w.a2, 512, 512, nullptr, w.W_lora_t + 64, 128, 512, scr, it - E6, lane);
        else p0_transpose_item(w.g2, 512, 512, nullptr, w.W_lora_t + 1024 * 128, 128, 0, scr, it - E7, lane);
    }
    for (int i = blockIdx.x * NTHR + otid_; i < (PW - INW) * D / 8; i += gridDim.x * NTHR) ((v4u*)(w.W_in_t + (size_t)INW * D))[i] = (v4u){0u, 0u, 0u, 0u};
    for (int i = blockIdx.x * NTHR + otid_; i < 1024 * 16; i += gridDim.x * NTHR) { const int row = i >> 4, c8 = (i & 15) * 8;
        const bool data = (row < 512) ? (c8 < 64) : (c8 >= 64);
        if (!data) ((v4u*)w.W_lora_t)[i] = (v4u){0u, 0u, 0u, 0u}; }
    for (int i = blockIdx.x * NTHR + otid_; i < 48 * D; i += gridDim.x * NTHR) { const int o = i / D, k = i % D;
        const float v_ = (o < 4) ? w.w_group[k * 4 + o] * w.g_ffn[k] : (o < 36) ? w.w_expert[k * 32 + (o - 4)] * w.g_ffn[k] : 0.f;
        const bf16_t hi_ = f2bf(v_); const float r1_ = v_ - bf2f(hi_); const bf16_t mid_ = f2bf(r1_); const float r2_ = r1_ - bf2f(mid_); const bf16_t lo_ = f2bf(r2_);
        bf16_t* W3 = (bf16_t*)w.WrT; W3[i] = hi_; W3[48 * D + i] = mid_; W3[2 * 48 * D + i] = lo_; }
    for (int m = gw; m < T; m += NGW) rms_row_to_bf16(w.x + (size_t)m * D, w.XN + (size_t)m * D, lane);
}

constexpr int MOE_ROWS = 2 * T + NE * 256;
constexpr int MOE_MAXT = MOE_ROWS / 256;
constexpr int UP_OFF = 131072 + 1024;
namespace pg8 {
template <int NJ> struct MoeOrder {
    const int* tile_e; int nunits, G, c;
    __device__ __forceinline__ bool next(int i, Unit& u) const { const int L = i * G + c; if (L >= nunits) return false; u.pm = L / NJ; u.pn = tile_e[u.pm] * NJ + (L % NJ); u.ao = 0; return true; }
    __device__ __forceinline__ void a_ready(const Unit&) const {}
    __device__ __forceinline__ void done(const Unit&) const {}
};
struct EpiSwiGLU {
    static constexpr bool PERM = true, AFTER_DRAIN = false;
    bf16_t* HID; const float* roww; const float* rowrs;
    __device__ __forceinline__ void operator()(const f32x4 (&acc)[2][2][4][2], const Unit& u, int wr, int wc, int fr, int fq) const {
        const int row0 = u.pm * BM + wr * 64 + fr, hc0 = (u.pn & 1) * 128 + wc * 32 + 8 * fq;
        float wv_[2][4], rv_[2][4];
#pragma unroll
        for (int ai = 0; ai < 2; ++ai)
#pragma unroll
            for (int m = 0; m < 4; ++m) { const int row = row0 + ai * HALF + m * 16; wv_[ai][m] = roww[row]; rv_[ai][m] = rowrs[row]; }
        __builtin_amdgcn_sched_barrier(0);
#pragma unroll
        for (int ai = 0; ai < 2; ++ai)
#pragma unroll
            for (int m = 0; m < 4; ++m) { const int row = row0 + ai * HALF + m * 16; const float w = wv_[ai][m], rs_ = rv_[ai][m];
                float h[8];
#pragma unroll
                for (int n = 0; n < 2; ++n)
#pragma unroll
                    for (int q = 0; q < 4; ++q) { const float g = acc[ai][0][m][n][q] * rs_, up = acc[ai][1][m][n][q] * rs_;
                        h[n * 4 + q] = g * __builtin_amdgcn_rcpf(1.f + __builtin_amdgcn_exp2f(-1.4426950408889634f * g)) * up * w; }
                u32x4 o; o.x = cvt_pk_bf16(h[0], h[1]); o.y = cvt_pk_bf16(h[2], h[3]); o.z = cvt_pk_bf16(h[4], h[5]); o.w = cvt_pk_bf16(h[6], h[7]);
                *(u32x4*)(HID + (size_t)row * 256 + hc0) = o; }
    }
};
template <int NJ> struct EpiBf16Mod {
    static constexpr bool PERM = true, AFTER_DRAIN = false;
    bf16_t* O; int ldc;
    __device__ __forceinline__ void operator()(const f32x4 (&acc)[2][2][4][2], const Unit& u, int wr, int wc, int fr, int fq) const {
        const int row0 = u.pm * BM + wr * 64 + fr, col0 = (u.pn % NJ) * BM + wc * 32 + 8 * fq;
#pragma unroll
        for (int ai = 0; ai < 2; ++ai)
#pragma unroll
            for (int m = 0; m < 4; ++m) { bf16_t* rowp = O + (size_t)(row0 + ai * HALF + m * 16) * ldc + col0;
#pragma unroll
                for (int bj = 0; bj < 2; ++bj) { const f32x4 v0 = acc[ai][bj][m][0], v1 = acc[ai][bj][m][1];
                    u32x4 w; w.x = cvt_pk_bf16(v0[0], v0[1]); w.y = cvt_pk_bf16(v0[2], v0[3]); w.z = cvt_pk_bf16(v1[0], v1[1]); w.w = cvt_pk_bf16(v1[2], v1[3]);
                    *(u32x4*)(rowp + bj * HALF) = w; } }
    }
};
}

__device__ __forceinline__ void ph_moe_weights(LAS unsigned char* lds, const float* g_ffn, const float* w_gate, const float* w_up, const float* w_down, bf16_t* Wgu_t, bf16_t* Wd_t) {
    const int otid_ = otid();
    const int lane = otid_ & 63, wave = otid_ >> 6, gw = blockIdx.x * 8 + wave, NGW = gridDim.x * 8;
    LAS float* scr = (LAS float*)(lds + wave * 16384);
    constexpr int IPE = (D / 64) * (DE / 32);
    for (int it = gw; it < 2 * NE * IPE; it += NGW) {
        const int mat = it / (NE * IPE), r = it % (NE * IPE), e = r / IPE, item = r % IPE;
        const int nb = item % (DE / 32), n0 = 32 * nb;
        const int row_off = e * 512 + (n0 / 128) * 256 + (n0 % 128) + (mat ? 128 : 0) - n0;
        p0_transpose_item((mat ? w_up : w_gate) + (size_t)e * D * DE, DE, DE, g_ffn, Wgu_t, D, row_off, scr, item, lane);
    }
}
__device__ __forceinline__ void ph_moe_wgu_part(LAS unsigned char* lds, const float* g_ffn, const float* w_gate, const float* w_up, bf16_t* Wgu_t, int first, int count) {
    const int otid_ = otid();
    const int lane = otid_ & 63, wave = otid_ >> 6, gw = ((int)blockIdx.x - first) * 8 + wave, NGW = count * 8;
    LAS float* scr = (LAS float*)(lds + wave * 16384);
    constexpr int IPE = (D / 64) * (DE / 32);
    for (int it = gw; it < 2 * NE * IPE; it += NGW) {
        const int mat = it / (NE * IPE), r = it % (NE * IPE), e = r / IPE, item = r % IPE;
        const int nb = item % (DE / 32), n0 = 32 * nb;
        const int row_off = e * 512 + (n0 / 128) * 256 + (n0 % 128) + (mat ? 128 : 0) - n0;
        p0_transpose_item((mat ? w_up : w_gate) + (size_t)e * D * DE, DE, DE, g_ffn, Wgu_t, D, row_off, scr, item, lane);
    }
}
__device__ __forceinline__ void ph_moe_wd_part(LAS unsigned char* lds, const float* w_down, bf16_t* Wd_t, int first) {
    const int otid_ = otid();
    const int lane = otid_ & 63, wave = otid_ >> 6;
    if ((int)blockIdx.x < first) return;
    LAS float* scr = (LAS float*)(lds + wave * 16384);
    constexpr int IPE = (DE / 64) * (D / 32);
    const int gw = ((int)blockIdx.x - first) * 8 + wave, NGW = ((int)gridDim.x - first) * 8;
    for (int it = gw; it < NE * IPE; it += NGW) { const int e = it / IPE, item = it % IPE;
        p0_transpose_item(w_down + (size_t)e * DE * D, D, D, nullptr, Wd_t, DE, e * D, scr, item, lane); }
}
__device__ __forceinline__ void ph_moe_route(LAS unsigned char* lds, const bf16_t* X1, const float* g_ffn, const float* WrT, const float* b_group, const float* b_expert, int* EID, float* EW, float* RSF, int* CNT) {
    const int otid_ = otid();
    const int tid = otid_, lane = tid & 63, wave = tid >> 6, G = gridDim.x, b = blockIdx.x, TPB = T / G;
    LAS int* hist = (LAS int*)(lds + UP_OFF);
    if (tid < 32) hist[tid] = 0;
    __syncthreads();
    typedef float rt_f32x4 __attribute__((ext_vector_type(4)));
    LAS float* lg = (LAS float*)(lds + wave * 4096);
    for (int i0 = wave * 16; i0 < TPB; i0 += 128) {
        const int t0 = b * TPB + i0, r16 = lane & 15, q = lane >> 4;
        const bf16_t* xrow = X1 + (size_t)(t0 + r16) * D + 8 * q;
        constexpr int RT_PITCH = 272, RT_BUF = 144 * RT_PITCH;
        LAS unsigned char* wl = lds + 32768;
        const bf16_t* W3 = (const bf16_t*)WrT;
        typedef short rt_bf16x8 __attribute__((ext_vector_type(8)));
        rt_f32x4 acc0 = {0.f, 0.f, 0.f, 0.f}, acc1 = acc0, acc2 = acc0; float ss = 0.f;
        v4u xq[2][4]; v4u wst[5];
#define RT_LDA(buf, qt) do { _Pragma("unroll") for (int j_ = 0; j_ < 4; ++j_) xq[buf][j_] = *(const v4u*)(xrow + 32 * (4 * (qt) + j_)); } while (0)
        const bf16_t* wg[5];
#pragma unroll
        for (int i_ = 0; i_ < 5; ++i_) { const int p_ = tid + 512 * i_; wg[i_] = W3 + (size_t)((p_ < 2304 ? p_ : 0) >> 4) * D + 8 * (p_ & 15); asm volatile("" : "+v"(wg[i_])); }
#define RT_LDW(c_) do { _Pragma("unroll") for (int i_ = 0; i_ < 5; ++i_) { const int p_ = tid + 512 * i_; if (i_ < 4 || p_ < 2304) wst[i_] = *(const v4u*)(wg[i_] + 128 * (c_)); } } while (0)
#define RT_STW(b_) do { _Pragma("unroll") for (int i_ = 0; i_ < 5; ++i_) { const int p_ = tid + 512 * i_; if (i_ < 4 || p_ < 2304) *(LAS v4u*)(wl + (b_) * RT_BUF + (p_ >> 4) * RT_PITCH + 16 * (p_ & 15)) = wst[i_]; } } while (0)
        RT_LDW(0); RT_LDA(0, 0); RT_STW(0);
        LDS_BARRIER();
#pragma unroll
        for (int qt = 0; qt < 8; ++qt) {
            if (qt < 7) { RT_LDW(qt + 1); RT_LDA((qt + 1) & 1, qt + 1); }
            __builtin_amdgcn_sched_barrier(0);
            const LAS unsigned char* wr_ = wl + (qt & 1) * RT_BUF + r16 * RT_PITCH + 16 * q;
#pragma unroll
            for (int j = 0; j < 4; ++j) {
                v4u wv[9];
#pragma unroll
                for (int i_ = 0; i_ < 9; ++i_) wv[i_] = *(const LAS v4u*)(wr_ + ((i_ / 3) * 48 + 16 * (i_ % 3)) * RT_PITCH + 64 * j);
                __builtin_amdgcn_sched_barrier(0);
                const v4u xw = xq[qt & 1][j];
                const float xf[8] = {__uint_as_float(xw.x << 16), __uint_as_float(xw.x & 0xffff0000u), __uint_as_float(xw.y << 16), __uint_as_float(xw.y & 0xffff0000u),
                                     __uint_as_float(xw.z << 16), __uint_as_float(xw.z & 0xffff0000u), __uint_as_float(xw.w << 16), __uint_as_float(xw.w & 0xffff0000u)};
#pragma unroll
                for (int sp = 0; sp < 8; ++sp) ss += xf[sp] * xf[sp];
                const rt_bf16x8 xa = __builtin_bit_cast(rt_bf16x8, xw);
#pragma unroll
                for (int pi = 0; pi < 3; ++pi) { const int pl = 2 - pi;
                    acc0 = __builtin_amdgcn_mfma_f32_16x16x32_bf16(xa, __builtin_bit_cast(rt_bf16x8, wv[3 * pl]), acc0, 0, 0, 0);
                    acc1 = __builtin_amdgcn_mfma_f32_16x16x32_bf16(xa, __builtin_bit_cast(rt_bf16x8, wv[3 * pl + 1]), acc1, 0, 0, 0);
                    acc2 = __builtin_amdgcn_mfma_f32_16x16x32_bf16(xa, __builtin_bit_cast(rt_bf16x8, wv[3 * pl + 2]), acc2, 0, 0, 0); }
                __builtin_amdgcn_sched_barrier(0);
            }
            if (qt < 7) RT_STW((qt + 1) & 1);
            LDS_BARRIER();
        }
#undef RT_LDA
#undef RT_LDW
#undef RT_STW
        ss += __shfl_xor(ss, 16); ss += __shfl_xor(ss, 32);
        WAVE_SYNC();
#pragma unroll
        for (int r = 0; r < 4; ++r) { const int tk = q * 4 + r; lg[tk * 48 + r16] = acc0[r]; lg[tk * 48 + 16 + r16] = acc1[r]; lg[tk * 48 + 32 + r16] = acc2[r]; }
        if (lane < 16) lg[768 + lane] = ss;
        WAVE_SYNC();
        if (lane < 16) {
            const int t = t0 + lane; const LAS float* ac = lg + lane * 48;
            const float rs = rsqrtf(lg[768 + lane] / D + 1e-6f);
            float gl[4]; int gs = 0; float gm = -INFINITY;
            _Pragma("unroll") for (int g = 0; g < 4; ++g) { gl[g] = ac[g] * rs + b_group[g]; if (gl[g] > gm) { gm = gl[g]; gs = g; } }
            float den = 0.f; _Pragma("unroll") for (int g = 0; g < 4; ++g) den += expf(gl[g] - gm);
            const float gp = 1.f / den;
            float el[8];
            _Pragma("unroll") for (int e = 0; e < 8; ++e) el[e] = ac[4 + gs * 8 + e] * rs + b_expert[gs * 8 + e];
            int i1 = 0; float v1 = el[0];
            _Pragma("unroll") for (int e = 1; e < 8; ++e) if (el[e] > v1) { v1 = el[e]; i1 = e; }
            int i2 = -1; float v2 = -INFINITY;
            _Pragma("unroll") for (int e = 0; e < 8; ++e) if (e != i1 && el[e] > v2) { v2 = el[e]; i2 = e; }
            const float e2 = expf(v2 - v1), w1 = 1.f / (1.f + e2), w2 = e2 / (1.f + e2);
            const int ea = gs * 8 + i1, eb = gs * 8 + i2;
            EID[t * 2] = ea; EID[t * 2 + 1] = eb; EW[t * 2] = w1 * gp; EW[t * 2 + 1] = w2 * gp; RSF[t] = rs;
            __hip_atomic_fetch_add(hist + ea, 1, __ATOMIC_RELAXED, __HIP_MEMORY_SCOPE_WORKGROUP);
            __hip_atomic_fetch_add(hist + eb, 1, __ATOMIC_RELAXED, __HIP_MEMORY_SCOPE_WORKGROUP);
        }
        WAVE_SYNC();
    }
    __syncthreads();
    if (tid < 32) CNT[b * 32 + tid] = hist[tid];
}

__device__ __forceinline__ void ph_moe_scatter(LAS unsigned char* lds, const float* RSF, const int* EID, const float* EW, const int* CNT,
                                               int* POS, float* ROWW, int* SRC, float* ROWRS, int* TILE_E) {
    const int otid_ = otid();
    const int tid = otid_, lane = tid & 63, wave = tid >> 6, G = gridDim.x, b = blockIdx.x, TPB = T / G;
    LAS int* up = (LAS int*)(lds + UP_OFF);
    LAS int* tot = up, *pre = up + 32, *base = up + 64, *ptot = up + 128, *ppre = up + 128 + 512, *epair = up + 128 + 1024;
    { const int e = tid & 31, g = tid >> 5; int st = 0, sp = 0;
      for (int bb = g; bb < G; bb += 16) { const int c = CNT[bb * 32 + e]; st += c; if (bb < b) sp += c; }
      ptot[g * 32 + e] = st; ppre[g * 32 + e] = sp; }
    __syncthreads();
    if (tid < 32) { int st = 0, sp = 0; for (int g = 0; g < 16; ++g) { st += ptot[g * 32 + tid]; sp += ppre[g * 32 + tid]; } tot[tid] = st; pre[tid] = sp; }
    __syncthreads();
    if (tid == 0) { int acc = 0; for (int e = 0; e < NE; ++e) { base[e] = acc; acc += (tot[e] + 255) / 256 * 256; } base[32] = acc; }
    if (tid < 2 * TPB) epair[tid] = EID[(size_t)b * TPB * 2 + tid];
    __syncthreads();
    if (b == 0) { const int ntiles = base[32] / 256;
        if (tid == 0) TILE_E[MOE_MAXT] = ntiles;
        for (int tile = tid; tile < ntiles; tile += NTHR) { int e = 0; for (int q = 1; q < NE; ++q) if (base[q] <= tile * 256) e = q; TILE_E[tile] = e; } }
    if (tid < 2 * TPB) { const int e = epair[tid]; int rank = 0; for (int j = 0; j < tid; ++j) rank += (epair[j] == e) ? 1 : 0;
        const int dest = base[e] + pre[e] + rank; const size_t pi = (size_t)b * TPB * 2 + tid; const int tok = b * TPB + (tid >> 1);
        POS[pi] = dest; ROWW[dest] = EW[pi]; SRC[dest] = tok; ROWRS[dest] = RSF[tok]; }
    if (b < NE) { const int e = b;
        for (int r = base[e] + tot[e] + tid; r < base[e + 1]; r += NTHR) { SRC[r] = 0; ROWW[r] = 0.f; ROWRS[r] = 0.f; } }
}

__device__ __forceinline__ void ph_moe_combine(float* OUT, const bf16_t* X1, const bf16_t* YS, const int* POS) {
    const int otid_ = otid();
    const int lane = otid_ & 63, gw = blockIdx.x * 8 + (otid_ >> 6), NGW = gridDim.x * 8;
    for (int t0 = gw; t0 < T; t0 += 2 * NGW) {
        int pp[2][2];
#pragma unroll
        for (int k = 0; k < 2; ++k) { const int t = t0 + k * NGW; pp[k][0] = POS[t * 2]; pp[k][1] = POS[t * 2 + 1]; }
        unsigned long long xv[2][4], av[2][4], cv[2][4];
#pragma unroll
        for (int k = 0; k < 2; ++k) { const int t = t0 + k * NGW;
            const unsigned long long* x0 = (const unsigned long long*)(X1 + (size_t)t * D) + lane;
            const unsigned long long* y0 = (const unsigned long long*)(YS + (size_t)pp[k][0] * D) + lane; const unsigned long long* y1 = (const unsigned long long*)(YS + (size_t)pp[k][1] * D) + lane;
#pragma unroll
            for (int j = 0; j < 4; ++j) { xv[k][j] = x0[64 * j]; av[k][j] = y0[64 * j]; cv[k][j] = y1[64 * j]; } }
        __builtin_amdgcn_sched_barrier(0);
#pragma unroll
        for (int k = 0; k < 2; ++k) { f32x4* orow = (f32x4*)(OUT + (size_t)(t0 + k * NGW) * D) + lane;
#pragma unroll
            for (int j = 0; j < 4; ++j) { const unsigned long long x = xv[k][j], a = av[k][j], c = cv[k][j]; f32x4 v;
                v.x = __uint_as_float((unsigned)(x << 16)) + __uint_as_float((unsigned)(a << 16)) + __uint_as_float((unsigned)(c << 16));
                v.y = __uint_as_float((unsigned)x & 0xffff0000u) + __uint_as_float((unsigned)a & 0xffff0000u) + __uint_as_float((unsigned)c & 0xffff0000u);
                v.z = __uint_as_float((unsigned)(x >> 32) << 16) + __uint_as_float((unsigned)(a >> 32) << 16) + __uint_as_float((unsigned)(c >> 32) << 16);
                v.w = __uint_as_float((unsigned)(x >> 32) & 0xffff0000u) + __uint_as_float((unsigned)(a >> 32) & 0xffff0000u) + __uint_as_float((unsigned)(c >> 32) & 0xffff0000u);
                orow[64 * j] = v; } }
    }
}

namespace att {
typedef short bf16x8 __attribute__((ext_vector_type(8)));
typedef short s16x4 __attribute__((ext_vector_type(4)));
typedef float f32x16 __attribute__((ext_vector_type(16)));
typedef unsigned u32x4 __attribute__((ext_vector_type(4)));
typedef float f32x4v __attribute__((ext_vector_type(4)));
constexpr int DQ = 96, DV = 64, QS = 768, KS = 768, VS = 512, OS = 1024;
constexpr int NW = 8, QBLK = 32, KVBLK = 64, QB = NW * QBLK, NQB = S / QB;
constexpr int SHM_V = 8192, SHM_K = 16384;
constexpr int NSLOT = 3;
constexpr int O_WSF = NSLOT * (SHM_V + SHM_K), LDS_BYTES = O_WSF + NW * 64 * 4;
#define KSWZ(row, colB) ((row) * 256 + ((colB) ^ (((row) & 15) << 4)))
#define SBAR() __builtin_amdgcn_sched_barrier(0)
__device__ __forceinline__ int v_st(int k, int c) { const int kk = k; return ((kk >> 3) * 2 + (c >> 5)) * 512 + ((kk & 7) * 32 + (c & 31)) * 2; }
__device__ __forceinline__ int v_rd_base(int lane) { return ((lane & 3) << 3) | (((lane >> 2) & 3) << 6) | (((lane >> 4) & 1) << 5) | (((lane >> 5) & 1) << 8); }
constexpr int v_rd_off(int d0, int ks, int half) { return d0 * 512 + ks * 2048 + half * 1024; }
__device__ __forceinline__ int crow(int r, int hi) { return (r & 3) + 8 * (r >> 2) + 4 * hi; }
__device__ __forceinline__ unsigned cvtpk(float lo, float hi) { unsigned r; asm volatile("v_cvt_pk_bf16_f32 %0, %1, %2" : "=v"(r) : "v"(lo), "v"(hi)); return r; }
__device__ __forceinline__ bf16x8 load8(const bf16_t* p) { return *reinterpret_cast<const bf16x8*>(p); }
__device__ __forceinline__ void mask_tile(f32x16& p0, f32x16& p1, int dq) {
    const float NEG = -__builtin_inff();
#pragma unroll
    for (int r = 0; r < 16; ++r) { const int c = (r & 3) + 8 * (r >> 2); if (dq - c < 0) p0[r] = NEG; if (dq - c - 32 < 0) p1[r] = NEG; }
}
constexpr float THRL = 8.f;
__device__ __forceinline__ float rowmax(const f32x16& p0, const f32x16& p1) {
    float a = fmaxf(fmaxf(p0[0], p0[1]), p1[0]), b = fmaxf(fmaxf(p0[2], p0[3]), p1[1]); a = fmaxf(fmaxf(a, p1[2]), p1[3]);
#pragma unroll
    for (int r = 4; r < 16; r += 4) { a = fmaxf(fmaxf(a, p0[r]), p0[r + 1]); b = fmaxf(fmaxf(b, p0[r + 2]), p0[r + 3]); a = fmaxf(fmaxf(a, p1[r]), p1[r + 1]); b = fmaxf(fmaxf(b, p1[r + 2]), p1[r + 3]); }
    const float m = fmaxf(a, b);
    auto rr = __builtin_amdgcn_permlane32_swap(__float_as_uint(m), __float_as_uint(m), false, false);
    return fmaxf(__uint_as_float(rr[0]), __uint_as_float(rr[1]));
}
__device__ __forceinline__ float bf16r(float x) { return __uint_as_float(cvtpk(x, 0.f) << 16); }
__device__ __forceinline__ s16x4 bias_frag(float v, int hi) { typedef unsigned u32x2b __attribute__((ext_vector_type(2))); u32x2b w = {hi ? 0u : (cvtpk(v, 0.f) & 0xffffu), 0u}; return __builtin_bit_cast(s16x4, w); }
template <bool FIRST>
__device__ __forceinline__ void partialSM(f32x16& p0, f32x16& p1, float& mhat, float& alpha, s16x4& q7, int hi) {
    const float rm = rowmax(p0, p1);
    alpha = 1.f;
    if (FIRST) { mhat = bf16r(rm); q7 = bias_frag(-mhat, hi);
#pragma unroll
        for (int r = 0; r < 16; ++r) { p0[r] -= mhat; p1[r] -= mhat; } }
    else if (__builtin_expect(__any(rm > THRL), 0)) { const float mn = bf16r(mhat + fmaxf(rm, 0.f)), dd = mn - mhat; alpha = __builtin_amdgcn_exp2f(-dd); mhat = mn; q7 = bias_frag(-mhat, hi);
#pragma unroll
        for (int r = 0; r < 16; ++r) { p0[r] -= dd; p1[r] -= dd; } }
#pragma unroll
    for (int r = 0; r < 16; ++r) p0[r] = __builtin_amdgcn_exp2f(p0[r]);
}
__device__ __forceinline__ void finishSM(f32x16& p0, f32x16& p1, float alpha, float& l_reg, bf16x8& pa0, bf16x8& pa1, bf16x8& pa2, bf16x8& pa3) {
#pragma unroll
    for (int r = 0; r < 16; ++r) p1[r] = __builtin_amdgcn_exp2f(p1[r]);
    float s0 = 0.f, s1 = 0.f;
#pragma unroll
    for (int r = 0; r < 16; ++r) { s0 += p0[r]; s1 += p1[r]; }
    float ps = s0 + s1;
    { auto rr = __builtin_amdgcn_permlane32_swap(__float_as_uint(ps), __float_as_uint(ps), false, false); ps = __uint_as_float(rr[0]) + __uint_as_float(rr[1]); }
    l_reg = l_reg * alpha + ps;
#define PK8(P, B_, OUT) do { u32x4 w = {cvtpk(P[B_+0], P[B_+1]), cvtpk(P[B_+2], P[B_+3]), cvtpk(P[B_+4], P[B_+5]), cvtpk(P[B_+6], P[B_+7])}; OUT = *reinterpret_cast<bf16x8*>(&w); } while (0)
    PK8(p0, 0, pa0); PK8(p0, 8, pa1); PK8(p1, 0, pa2); PK8(p1, 8, pa3);
#undef PK8
}
struct KFr { bf16x8 f0[6], f1[6]; };
#ifndef QK_AH_B
#define QK_AH_B 3
#endif
#define QK_ADDR(Ks, d0) ((Ks) + ((d0) < 4 ? KSWZ(r32, (((d0) & 3) * 16 + hi * 8) * 2) : (KSWZ(r32, ((((d0) - 4) & 3) * 16 + hi * 8) * 2) ^ 128)))
#define QK_RD(F, Ks, d0) do { const char* a_ = QK_ADDR(Ks, d0); (F).f0[d0] = *reinterpret_cast<const bf16x8*>(a_); (F).f1[d0] = *reinterpret_cast<const bf16x8*>(a_ + 32 * 256); } while (0)
#define QK_MM(F, d0) do { p0 = __builtin_amdgcn_mfma_f32_32x32x16_bf16((F).f0[d0], qr[d0], p0, 0, 0, 0); p1 = __builtin_amdgcn_mfma_f32_32x32x16_bf16((F).f1[d0], qr[d0], p1, 0, 0, 0); } while (0)
template <int AH> __device__ __forceinline__ void qkt_rd(KFr& F, const char* Ks, int r32, int hi) { QK_RD(F, Ks, 0); if (AH >= 2) QK_RD(F, Ks, 1); if (AH >= 3) QK_RD(F, Ks, 2); SBAR(); }
template <int AH> __device__ __forceinline__ void qkt_mm(KFr& F, f32x16& p0, f32x16& p1, const char* Ks, int r32, int hi, const bf16x8* qr, s16x4 kone, s16x4 q7) {
    p0 = __builtin_amdgcn_mfma_f32_32x32x8bf16_1k(kone, q7, f32x16{}, 0, 0, 0); p1 = __builtin_amdgcn_mfma_f32_32x32x8bf16_1k(kone, q7, f32x16{}, 0, 0, 0);
    if (AH == 1) { QK_RD(F, Ks, 1); QK_RD(F, Ks, 2); SBAR(); }
    if (AH == 2) { QK_RD(F, Ks, 2); SBAR(); }
    QK_MM(F, 0); QK_RD(F, Ks, 3); SBAR();
    QK_MM(F, 1); QK_RD(F, Ks, 4); SBAR();
    QK_MM(F, 2); QK_RD(F, Ks, 5); SBAR();
    QK_MM(F, 3); QK_MM(F, 4); QK_MM(F, 5);
}
__device__ __forceinline__ void qkt(f32x16& p0, f32x16& p1, const char* Ks, int r32, int hi, const bf16x8* qr, s16x4 kone, s16x4 q7) { KFr F; qkt_rd<3>(F, Ks, r32, hi); qkt_mm<3>(F, p0, p1, Ks, r32, hi, qr, kone, q7); }
#undef QK_RD
#undef QK_MM
#undef QK_ADDR
typedef short v4i16_t __attribute__((ext_vector_type(4)));
__device__ __forceinline__ s16x4 vtr(int addr) { return __builtin_bit_cast(s16x4, __builtin_amdgcn_ds_read_tr16_b64_v4i16((__attribute__((address_space(3))) v4i16_t*)(uintptr_t)(unsigned)addr)); }
struct VFr { s16x4 l[2][4], h[2][4]; };
#define PV_RD(F, d_, k_) do { (F).l[d_][k_] = vtr(vb + v_rd_off(d_, 0, 0) + 2048 * (k_)); (F).h[d_][k_] = vtr(vb + v_rd_off(d_, 0, 0) + 2048 * (k_) + 1024); } while (0)
#define PV_MM(F, d_, k_, P_) o[d_] = __builtin_amdgcn_mfma_f32_32x32x16_bf16((bf16x8){(F).l[d_][k_][0], (F).l[d_][k_][1], (F).l[d_][k_][2], (F).l[d_][k_][3], (F).h[d_][k_][0], (F).h[d_][k_][1], (F).h[d_][k_][2], (F).h[d_][k_][3]}, P_, o[d_], 0, 0, 0)
__device__ __forceinline__ void pv_rd(VFr& F, int vb) { PV_RD(F, 0, 0); PV_RD(F, 0, 1); PV_RD(F, 0, 2); PV_RD(F, 0, 3); SBAR(); }
__device__ __forceinline__ void pv_mm(VFr& F, f32x16* o, int vb, bf16x8 pa0, bf16x8 pa1, bf16x8 pa2, bf16x8 pa3) {
    PV_MM(F, 0, 0, pa0); PV_RD(F, 1, 0); SBAR();
    PV_MM(F, 0, 1, pa1); PV_RD(F, 1, 1); SBAR();
    PV_MM(F, 0, 2, pa2); PV_RD(F, 1, 2); SBAR();
    PV_MM(F, 0, 3, pa3); PV_RD(F, 1, 3); SBAR();
    PV_MM(F, 1, 0, pa0); PV_MM(F, 1, 1, pa1); PV_MM(F, 1, 2, pa2); PV_MM(F, 1, 3, pa3);
}
__device__ __forceinline__ void pv_tile(f32x16* o, int vb, bf16x8 pa0, bf16x8 pa1, bf16x8 pa2, bf16x8 pa3) { VFr F; pv_rd(F, vb); pv_mm(F, o, vb, pa0, pa1, pa2, pa3); }
#undef PV_RD
#undef PV_MM
struct BlockRef { const bf16_t* Q; const bf16_t* K; const bf16_t* V; bf16_t* O; float* SS; const int* pos; int P0; };
struct Seam { bf16x8 qr[6]; float pf; };
#define VMW() asm volatile("s_waitcnt vmcnt(0)" ::: "memory")
#define VMWN(n) asm volatile("s_waitcnt vmcnt(%0)" :: "i"(n) : "memory")
#define GLDS16(gp, ldsb) __builtin_amdgcn_global_load_lds((const unsigned*)(gp), (__attribute__((address_space(3))) unsigned*)(uintptr_t)(unsigned)(uintptr_t)(ldsb), 16, 0, 0)
#define DMA_IDX() const int krow_ = 4 * wid + (lane >> 4), kcc_ = (lane & 15) ^ (krow_ & 15); \
                  const size_t kof_ = (size_t)krow_ * KS + (kcc_ < 12 ? kcc_ : 0) * 8, vof_ = (size_t)(8 * wid + ((lane & 31) >> 2)) * VS + 32 * (lane >> 5) + 8 * (lane & 3)
#define DMA_K(Kp, k0, sl) do { GLDS16((Kp) + (size_t)(k0) * KS + kof_, K_lds + (sl) * SHM_K + (4 * wid) * 256); GLDS16((Kp) + (size_t)((k0) + 32) * KS + kof_, K_lds + (sl) * SHM_K + (32 + 4 * wid) * 256); } while (0)
#define DMA_V(Vp, k0, sl) GLDS16((Vp) + (size_t)(k0) * VS + vof_, V_lds + (sl) * SHM_V + wid * 1024)
__device__ __forceinline__ void prime(const BlockRef& cur, char* lds, Seam& S) {
    const int tid = otid(), wid = __builtin_amdgcn_readfirstlane(tid >> 6), lane = tid & 63, r32 = lane & 31, hi = lane >> 5;
    DMA_IDX(); (void)vof_; char* K_lds = lds + NSLOT * SHM_V;
#pragma unroll
    for (int d0 = 0; d0 < 6; ++d0) S.qr[d0] = load8(cur.Q + (size_t)(wid * QBLK + r32) * QS + d0 * 16 + hi * 8);
    S.pf = (float)cur.pos[wid * QBLK + r32];
    DMA_K(cur.K, 0, 0); VMW();
    LDS_BARRIER();
}
__device__ __forceinline__ void block(const BlockRef& cur, const BlockRef& nxt, char* lds, Seam& S, const float* g_qn) {
    const int tid = otid(), wid = __builtin_amdgcn_readfirstlane(tid >> 6), lane = tid & 63, r32 = lane & 31, hi = lane >> 5;
    { const float pf = S.pf;
      float x[6][8]; float ss = 0.f;
#pragma unroll
      for (int d0 = 0; d0 < 6; ++d0) { const u32x4 w = __builtin_bit_cast(u32x4, S.qr[d0]);
#pragma unroll
          for (int j = 0; j < 4; ++j) { x[d0][2 * j] = __uint_as_float(w[j] << 16); x[d0][2 * j + 1] = __uint_as_float(w[j] & 0xffff0000u); ss += x[d0][2 * j] * x[d0][2 * j] + x[d0][2 * j + 1] * x[d0][2 * j + 1]; } }
      { auto rr = __builtin_amdgcn_permlane32_swap(__float_as_uint(ss), __float_as_uint(ss), false, false); ss = __uint_as_float(rr[0]) + __uint_as_float(rr[1]); }
      const float rn = rsqrtf(ss * (1.f / DQ) + 1e-6f);
#pragma unroll
      for (int d0 = 0; d0 < 6; ++d0) { const float* gt_ = (const float*)(lds + O_WSF) + 64 + 16 * d0 + 8 * hi; const f32x4v g0 = *(const f32x4v*)gt_, g1 = *(const f32x4v*)(gt_ + 4);
#pragma unroll
          for (int e = 0; e < 4; ++e) { x[d0][e] *= rn * g0[e]; x[d0][4 + e] *= rn * g1[e]; } }
#pragma unroll
      for (int e = 0; e < 8; ++e) { const float invf = ((const float*)(lds + O_WSF))[8 * hi + e];
          const float rev = __builtin_amdgcn_fractf(pf * invf * 0.15915494309189535f); const float cs = __builtin_amdgcn_cosf(rev), sn = __builtin_amdgcn_sinf(rev);
          const float a = x[4][e], b = x[5][e]; x[4][e] = a * cs - b * sn; x[5][e] = b * cs + a * sn; }
      constexpr float C2q = 0.10206207261596577f * 1.4426950408889634f;
#pragma unroll
      for (int d0 = 0; d0 < 6; ++d0) { u32x4 w = {cvtpk(x[d0][0] * C2q, x[d0][1] * C2q), cvtpk(x[d0][2] * C2q, x[d0][3] * C2q), cvtpk(x[d0][4] * C2q, x[d0][5] * C2q), cvtpk(x[d0][6] * C2q, x[d0][7] * C2q)};
          S.qr[d0] = __builtin_bit_cast(bf16x8, w); } }
    const bool grpB = wid >= 4;
    const int NT = cur.P0 / KVBLK + QB / KVBLK;
    const int qlo = cur.P0 + wid * QBLK, qm = qlo + r32 - 4 * hi;
    char* V_lds = lds; char* K_lds = lds + NSLOT * SHM_V;
    float mhat = 0.f, l_reg = 0; f32x16 o[2] = {};
    DMA_IDX();
    const int vb0 = (int)(uintptr_t)V_lds + v_rd_base(lane);
    const bf16_t* Kh = cur.K; const bf16_t* Vh = cur.V;
#define RESC(a) do { if (__any((a) < 1.f)) { \
                     _Pragma("unroll") for (int d_ = 0; d_ < 2; ++d_) _Pragma("unroll") for (int r = 0; r < 16; ++r) o[d_][r] *= (a); } } while (0)
#define KBASE(t) ((t) * KVBLK)
#define MASKT(P0_, P1_, t) do { const int kb_ = KBASE(t); if (__builtin_amdgcn_readfirstlane(kb_ + KVBLK - 1 > qlo)) { asm volatile("; diagonal tile" ::); mask_tile(P0_, P1_, qm - kb_); } } while (0)
    constexpr int NQL = 7;
    f32x16 pA0, pA1, pB0, pB1; float alA, alB; bf16x8 pa0, pa1, pa2, pa3;
    DMA_V(Vh, 0, 0); DMA_K(Kh, KBASE(1), 1); DMA_V(Vh, KBASE(1), 1);
    const s16x4 kone = bias_frag(1.0f, hi); s16x4 q7 = s16x4{0, 0, 0, 0};
    SBAR(); qkt(pA0, pA1, K_lds, r32, hi, S.qr, kone, q7);
    MASKT(pA0, pA1, 0); partialSM<true>(pA0, pA1, mhat, alA, q7, hi);
    VMW();
    LDS_BARRIER();
    int s0 = 0, s1 = 1, s2 = 2;
#define ROT() do { const int t_ = s0; s0 = s1; s1 = s2; s2 = t_; } while (0)
#define STEP(PX0, PX1, alX, PY0, PY1, alY, t) do { \
        if ((t) + 1 < NT) { DMA_K(Kh, KBASE((t) + 1), s2); DMA_V(Vh, KBASE((t) + 1), s2); } SBAR(); \
        if (!grpB) { \
            qkt(PX0, PX1, K_lds + s1 * SHM_K, r32, hi, S.qr, kone, q7); \
            finishSM(PY0, PY1, alY, l_reg, pa0, pa1, pa2, pa3); \
            pv_tile(o, vb0 + s0 * SHM_V, pa0, pa1, pa2, pa3); \
            MASKT(PX0, PX1, (t)); partialSM<false>(PX0, PX1, mhat, alX, q7, hi); \
            VMW(); \
        } else { \
            KFr kf_; qkt_rd<QK_AH_B>(kf_, K_lds + s1 * SHM_K, r32, hi); \
            finishSM(PY0, PY1, alY, l_reg, pa0, pa1, pa2, pa3); SBAR(); \
            qkt_mm<QK_AH_B>(kf_, PX0, PX1, K_lds + s1 * SHM_K, r32, hi, S.qr, kone, q7); \
            VFr vf_; pv_rd(vf_, vb0 + s0 * SHM_V); \
            MASKT(PX0, PX1, (t)); partialSM<false>(PX0, PX1, mhat, alX, q7, hi); SBAR(); \
            pv_mm(vf_, o, vb0 + s0 * SHM_V, pa0, pa1, pa2, pa3); \
            VMW(); \
        } \
        RESC(alX); LDS_BARRIER(); ROT(); } while (0)
    for (int t = 1; t + 1 < NT; t += 2) {
        STEP(pB0, pB1, alB, pA0, pA1, alA, t);
        STEP(pA0, pA1, alA, pB0, pB1, alB, t + 1);
    }
    STEP(pB0, pB1, alB, pA0, pA1, alA, NT - 1);
    DMA_K(nxt.K, 0, 0); SBAR();
#pragma unroll
    for (int d0 = 0; d0 < 6; ++d0) S.qr[d0] = load8(nxt.Q + (size_t)(wid * QBLK + r32) * QS + d0 * 16 + hi * 8);
    S.pf = (float)nxt.pos[wid * QBLK + r32];
    SBAR();
    finishSM(pB0, pB1, alB, l_reg, pa0, pa1, pa2, pa3); SBAR();
    pv_tile(o, vb0 + s0 * SHM_V, pa0, pa1, pa2, pa3);
    SBAR(); VMWN(NQL); SBAR();
    { const float rl = __builtin_amdgcn_rcpf(l_reg);
      { float ss = 0.f;
#pragma unroll
        for (int d0 = 0; d0 < 2; ++d0)
#pragma unroll
            for (int r = 0; r < 16; ++r) { const float v_ = o[d0][r] * rl; ss += v_ * v_; }
        auto rr = __builtin_amdgcn_permlane32_swap(__float_as_uint(ss), __float_as_uint(ss), false, false); ss = __uint_as_float(rr[0]) + __uint_as_float(rr[1]);
        if (hi == 0) cur.SS[(size_t)(wid * QBLK + r32) * 8] = ss; }
      bf16_t* Ow = cur.O + (size_t)(wid * QBLK + r32) * OS + 8 * hi;
#pragma unroll
      for (int d0 = 0; d0 < 2; ++d0)
#pragma unroll
          for (int gp = 0; gp < 2; ++gp) { const int ra = 8 * gp, rb = 8 * gp + 4;
              const unsigned a0 = cvtpk(o[d0][ra] * rl, o[d0][ra + 1] * rl), a1 = cvtpk(o[d0][ra + 2] * rl, o[d0][ra + 3] * rl);
              const unsigned b0 = cvtpk(o[d0][rb] * rl, o[d0][rb + 1] * rl), b1 = cvtpk(o[d0][rb + 2] * rl, o[d0][rb + 3] * rl);
              auto s0_ = __builtin_amdgcn_permlane32_swap(a0, b0, false, false); auto s1_ = __builtin_amdgcn_permlane32_swap(a1, b1, false, false);
              u32x4 w = {s0_[0], s1_[0], s0_[1], s1_[1]};
              *(u32x4*)(Ow + d0 * 32 + 16 * gp) = w; } }
    LDS_BARRIER();
#undef RESC
#undef KBASE
#undef MASKT
#undef STEP
#undef ROT
}
#undef VMW
#undef VMWN
#undef GLDS16
#undef DMA_IDX
#undef DMA_K
#undef DMA_V
constexpr int NITEM = NQB * 4;
__device__ __forceinline__ BlockRef ref_of(int label, int j, const bf16_t* Q, const bf16_t* K, const bf16_t* V, bf16_t* O, float* SSQ, const int* pos) {
    const int qb = NQB - 1 - (j >> 2), bh = label + 8 * (j & 3), b = bh / H, h = bh % H;
    BlockRef r; const size_t row0 = (size_t)b * S;
    r.Q = Q + (row0 + (size_t)qb * QB) * QS + h * DQ; r.O = O + (row0 + (size_t)qb * QB) * OS + h * DV;
    r.K = K + row0 * KS + h * DQ; r.V = V + row0 * VS + h * DV; r.P0 = qb * QB; r.SS = SSQ + (row0 + (size_t)qb * QB) * 8 + h; r.pos = pos + row0 + (size_t)qb * QB;
    return r;
}
__device__ __forceinline__ int pull(unsigned* ctr, char* lds, int slot) {
    volatile int* w = (volatile int*)(lds + LDS_BYTES) + slot;
    if (threadIdx.x == 0) *w = (int)__hip_atomic_fetch_add(ctr, 1u, __ATOMIC_RELAXED, __HIP_MEMORY_SCOPE_AGENT);
    LDS_BARRIER();
    return __builtin_amdgcn_readfirstlane(*w);
}
__device__ __forceinline__ void phase(char* lds, unsigned* qctr  , const bf16_t* Q, const bf16_t* K, const bf16_t* V, bf16_t* O, float* SSQ, const int* pos, const float* g_qn) {
    const int label = (int)blockIdx.x & 7; unsigned* ctr = qctr + 64 * label;
    if (threadIdx.x < 16) ((float*)(lds + O_WSF))[threadIdx.x] = 1.0f / powf(10000.0f, (float)threadIdx.x / 16.0f);
    if (threadIdx.x < 64) { ((float*)(lds + O_WSF))[64 + threadIdx.x] = g_qn[threadIdx.x]; if (threadIdx.x < DQ - 64) ((float*)(lds + O_WSF))[128 + threadIdx.x] = g_qn[64 + threadIdx.x]; }
    int n = 0;
    int cj = pull(ctr, lds, (n++) & 3); if (cj >= NITEM) return;
    BlockRef cur = ref_of(label, cj, Q, K, V, O, SSQ, pos);
    Seam Sm;
    prime(cur, lds, Sm);
    for (;;) {
        const int nj = pull(ctr, lds, (n++) & 3);
        const bool last = nj >= NITEM;
        const BlockRef nxt = last ? cur : ref_of(label, nj, Q, K, V, O, SSQ, pos);
        block(cur, nxt, lds, Sm, g_qn);
        if (last) break;
        cur = nxt;
    }
}
#undef KSWZ
#undef SBAR
}

struct Params {
    const float* x; const int* pos;
    const float *g_mix, *w_in, *g_cq, *w_uq, *g_ckv, *w_uk, *w_uv, *g_qn, *g_kn, *g_mla_out;
    const float *rw_mu, *rw_w0, *rw_w2, *rw_a0, *rw_a2, *rw_g2, *rw_k_k, *rw_k_a, *rw_r_k, *rw_lnx_g, *rw_lnx_b;
    const float *w_o, *g_ffn, *w_group, *b_group, *w_expert, *b_expert, *w_gate, *w_up, *w_down;
    float* out; unsigned char* ws;
    int ph_lo, ph_hi;
};
constexpr size_t MiB = 1u << 20;
constexpr size_t WS_CTL = 0, CTL_ZERO_BYTES = 64 * 1024;
constexpr size_t WS_SMALL = 1 * MiB;
constexpr size_t WS_PROJ = 4 * MiB;
constexpr size_t WS_MIX = 148 * MiB;
constexpr size_t WS_RX = 212 * MiB;
constexpr size_t WS_WO = 502 * MiB;
constexpr int CW_BAR = 4096, CW_ATTQ = 2048;

__device__ __forceinline__ void ph_mla_prep(const bf16_t* PROJ, bf16_t* Q, const bf16_t* KN, bf16_t* K, bf16_t* V, const int* pos, const float* g_qn, const float* g_kn) {
    const int otid_ = otid();
    const int lane = otid_ & 63, gw = blockIdx.x * 8 + (otid_ >> 6), NGW = gridDim.x * 8;
    const int h = lane >> 3, sub = lane & 7;
    typedef unsigned u32x2_t __attribute__((ext_vector_type(2)));
    float invf[4];
#pragma unroll
    for (int q = 0; q < 4; ++q) invf[q] = 1.0f / powf(10000.0f, (float)((4 * sub + q) & 15) / 16.0f);
    float gq[3][4], gk[3][4];
#pragma unroll
    for (int m = 0; m < 3; ++m) { const f32x4 a = *(const f32x4*)(g_qn + 32 * m + 4 * sub), b2 = *(const f32x4*)(g_kn + 32 * m + 4 * sub);
        gq[m][0] = a.x; gq[m][1] = a.y; gq[m][2] = a.z; gq[m][3] = a.w; gk[m][0] = b2.x; gk[m][1] = b2.y; gk[m][2] = b2.z; gk[m][3] = b2.w; }
#define UNPK4(u, f) do { f[0] = __uint_as_float((u).x << 16); f[1] = __uint_as_float((u).x & 0xffff0000u); f[2] = __uint_as_float((u).y << 16); f[3] = __uint_as_float((u).y & 0xffff0000u); } while (0)
    for (int t0 = gw; t0 < T; t0 += 4 * NGW) {
        u32x2_t kn0[4], kn1[4], kr[4]; int ps[4];
#pragma unroll
        for (int k = 0; k < 4; ++k) { const int t = t0 + k * NGW; const bf16_t* knp = KN + (size_t)t * 512 + h * NOPE + 4 * sub;
            kn0[k] = *(const u32x2_t*)knp; kn1[k] = *(const u32x2_t*)(knp + 32); kr[k] = *(const u32x2_t*)(PROJ + (size_t)t * PW + 384 + 4 * sub); ps[k] = pos[t]; }
        __builtin_amdgcn_sched_barrier(0);
#pragma unroll
        for (int k = 0; k < 4; ++k) { const int t = t0 + k * NGW;
            const float pf = (float)ps[k];
            float cs[4], sn[4];
#pragma unroll
            for (int q = 0; q < 4; ++q) { const float rev = __builtin_amdgcn_fractf(pf * invf[q] * 0.15915494309189535f); cs[q] = __builtin_amdgcn_cosf(rev); sn[q] = __builtin_amdgcn_sinf(rev); }
            float x[3][4]; UNPK4(kn0[k], x[0]); UNPK4(kn1[k], x[1]); UNPK4(kr[k], x[2]);
            float ss = 0.f;
#pragma unroll
            for (int m = 0; m < 3; ++m)
#pragma unroll
                for (int q = 0; q < 4; ++q) ss += x[m][q] * x[m][q];
            ss += __int_as_float(__builtin_amdgcn_update_dpp(0, __float_as_int(ss), 0xB1, 0xF, 0xF, true));
            ss += __int_as_float(__builtin_amdgcn_update_dpp(0, __float_as_int(ss), 0x4E, 0xF, 0xF, true));
            ss += __int_as_float(__builtin_amdgcn_update_dpp(0, __float_as_int(ss), 0x141, 0xF, 0xF, true));
            const float rn = rsqrtf(ss * (1.f / QK) + 1e-6f);
#pragma unroll
            for (int m = 0; m < 3; ++m)
#pragma unroll
                for (int q = 0; q < 4; ++q) x[m][q] = x[m][q] * rn * gk[m][q];
            float oth[4];
#pragma unroll
            for (int q = 0; q < 4; ++q) oth[q] = __shfl_xor(x[2][q], 4);
#pragma unroll
            for (int q = 0; q < 4; ++q) x[2][q] = (sub < 4) ? (x[2][q] * cs[q] - oth[q] * sn[q]) : (x[2][q] * cs[q] + oth[q] * sn[q]);
            bf16_t* kp = K + (size_t)t * 768 + h * QK + 4 * sub;
#pragma unroll
            for (int m = 0; m < 3; ++m) { u32x2_t o; o.x = pk2(x[m][0], x[m][1]); o.y = pk2(x[m][2], x[m][3]); *(u32x2_t*)(kp + 32 * m) = o; } }
    }
#undef UNPK4
}

__device__ __forceinline__ float wave_sum_dpp(float x) {
    x += __int_as_float(__builtin_amdgcn_update_dpp(0, __float_as_int(x), 0xB1, 0xF, 0xF, true));
    x += __int_as_float(__builtin_amdgcn_update_dpp(0, __float_as_int(x), 0x4E, 0xF, 0xF, true));
    x += __int_as_float(__builtin_amdgcn_update_dpp(0, __float_as_int(x), 0x141, 0xF, 0xF, true));
    x += __int_as_float(__builtin_amdgcn_update_dpp(0, __float_as_int(x), 0x140, 0xF, 0xF, true));
    x += __int_as_float(__builtin_amdgcn_ds_swizzle(__float_as_int(x), 0x401F));
    auto rr = __builtin_amdgcn_permlane32_swap(__float_as_uint(x), __float_as_uint(x), false, false);
    return __uint_as_float(rr[0]) + __uint_as_float(rr[1]);
}
__device__ __forceinline__ void ph_mla_norm(bf16_t* MIX, const float* g, int gw, int NGW) {
    const int otid_ = otid();
    const int lane = otid_ & 63;
    const f32x4 g0 = *(const f32x4*)(g + lane * 8), g1 = *(const f32x4*)(g + lane * 8 + 4);
    for (int row0 = gw; row0 < T; row0 += 4 * NGW) {
        v4u u[4];
#pragma unroll
        for (int k = 0; k < 4; ++k) u[k] = *((const v4u*)(MIX + (size_t)(row0 + k * NGW) * 1024) + lane);
        __builtin_amdgcn_sched_barrier(0);
#pragma unroll
        for (int k = 0; k < 4; ++k) { float v[8];
            v[0] = __uint_as_float(u[k].x << 16); v[1] = __uint_as_float(u[k].x & 0xffff0000u); v[2] = __uint_as_float(u[k].y << 16); v[3] = __uint_as_float(u[k].y & 0xffff0000u);
            v[4] = __uint_as_float(u[k].z << 16); v[5] = __uint_as_float(u[k].z & 0xffff0000u); v[6] = __uint_as_float(u[k].w << 16); v[7] = __uint_as_float(u[k].w & 0xffff0000u);
            float s = 0.f;
            _Pragma("unroll") for (int i = 0; i < 8; ++i) s += v[i] * v[i];
            const float r = rsqrtf(wave_sum_dpp(s) * (1.f / 512.f) + 1e-6f);
            v4u o; o.x = pk2(v[0] * r * g0.x, v[1] * r * g0.y); o.y = pk2(v[2] * r * g0.z, v[3] * r * g0.w); o.z = pk2(v[4] * r * g1.x, v[5] * r * g1.y); o.w = pk2(v[6] * r * g1.z, v[7] * r * g1.w);
            *((v4u*)(MIX + (size_t)(row0 + k * NGW) * 1024) + lane) = o; }
    }
}

__device__ __forceinline__ void ph_rw_prep1(const bf16_t* PROJ, const float* mu, bf16_t* LIN) {
    const int otid_ = otid();
    const int lane = otid_ & 63, gw = blockIdx.x * 8 + (otid_ >> 6), NGW = gridDim.x * 8;
    typedef unsigned u32x2_t __attribute__((ext_vector_type(2)));
    const int c = 1536 + 4 * lane; const f32x4 m4 = *(const f32x4*)(mu + c);
    for (int t0 = gw; t0 < T; t0 += 4 * NGW) {
        u32x2_t fcv[4], fpv[4];
#pragma unroll
        for (int k = 0; k < 4; ++k) { const int t = t0 + k * NGW; const bf16_t* cur = PROJ + (size_t)t * PW + MLA_IN + c;
            fcv[k] = *(const u32x2_t*)cur; fpv[k] = *(const u32x2_t*)(cur - ((t % S) ? PW : 0)); if ((t % S) == 0) { fpv[k].x = 0u; fpv[k].y = 0u; } }
        __builtin_amdgcn_sched_barrier(0);
#pragma unroll
        for (int k = 0; k < 4; ++k) { const int t = t0 + k * NGW; const u32x2_t fc = fcv[k], fp = fpv[k];
            float f[4] = {__uint_as_float(fc.x << 16), __uint_as_float(fc.x & 0xffff0000u), __uint_as_float(fc.y << 16), __uint_as_float(fc.y & 0xffff0000u)};
            const float q[4] = {__uint_as_float(fp.x << 16), __uint_as_float(fp.x & 0xffff0000u), __uint_as_float(fp.y << 16), __uint_as_float(fp.y & 0xffff0000u)};
            f[0] += (q[0] - f[0]) * m4.x; f[1] += (q[1] - f[1]) * m4.y; f[2] += (q[2] - f[2]) * m4.z; f[3] += (q[3] - f[3]) * m4.w;
            if (lane < 16 || lane >= 32) { const float sc_ = lane < 16 ? -2.8853900817779268f : -1.4426950408889634f;
                _Pragma("unroll") for (int e = 0; e < 4; ++e) { const float sg = __builtin_amdgcn_rcpf(1.f + __builtin_amdgcn_exp2f(f[e] * sc_)); f[e] = lane < 16 ? 2.f * sg - 1.f : sg; } }
            u32x2_t o; o.x = pk2(f[0], f[1]); o.y = pk2(f[2], f[3]);
            *(u32x2_t*)(LIN + (size_t)t * 256 + 4 * lane) = o; }
    }
}

constexpr int RC = 64, NCH = S / RC, NCHUNK = NB * RH * NCH;
typedef short rw_bf16x8 __attribute__((ext_vector_type(8)));
typedef float rw_f32x16 __attribute__((ext_vector_type(16)));
typedef float rw_f32x2 __attribute__((ext_vector_type(2)));
typedef __bf16 rw_bf16x2 __attribute__((ext_vector_type(2)));
__device__ __forceinline__ unsigned rw_cvtpk(float lo, float hi) { rw_f32x2 v = {lo, hi}; rw_bf16x2 b = __builtin_convertvector(v, rw_bf16x2); return __builtin_bit_cast(unsigned, b); }
__device__ __forceinline__ int rw_crow(int r, int hi) { return (r & 3) + 8 * (r >> 2) + 4 * hi; }

template <int KIND>
__device__ __forceinline__ void rw_chunk_task(LAS float* shw, int cid, int lane, const bf16_t* R, const bf16_t* K1, const bf16_t* V1, const bf16_t* KK, const bf16_t* BB, const float* DEC,
                                              bf16_t* OutT  , bf16_t* YT  ) {
    constexpr int PB = 4, SLOT = 384;
    const int bh = cid / NCH, c = cid % NCH, b = bh / RH, h = bh % RH;
    float st[64];
    _Pragma("unroll") for (int j = 0; j < 64; ++j) st[j] = (KIND == 0 && j == lane) ? 1.f : 0.f;
    const size_t base = ((size_t)b * S + (size_t)c * RC) * 512 + h * 64 + lane;
    bf16_t* yo = YT + (size_t)cid * 4096 + lane;
    float pr[PB], pk[PB], pkk[PB], pb[PB], pd[PB], pv[PB];
#define RW_LOAD_BLK(s0) do { _Pragma("unroll") for (int u = 0; u < PB; ++u) { const size_t a_ = base + (size_t)((s0) + u) * 512; \
        pr[u] = bf2f(R[a_]); pk[u] = bf2f(K1[a_]); pkk[u] = bf2f(KK[a_]); pb[u] = bf2f(BB[a_]); pd[u] = DEC[a_]; pv[u] = KIND ? bf2f(V1[a_]) : 0.f; } } while (0)
#define RW_WRITE_BLK(hf) do { _Pragma("unroll") for (int u = 0; u < PB; ++u) { LAS float* d_ = shw + ((hf) * PB + u) * SLOT + lane; \
        d_[0] = pr[u]; d_[64] = pk[u]; d_[128] = pkk[u]; d_[192] = pb[u]; d_[256] = pd[u]; d_[320] = pv[u]; } } while (0)
    RW_LOAD_BLK(0); RW_WRITE_BLK(0);
    for (int n = 0; n < RC / PB; ++n) {
        const int hf = n & 1;
        if (n + 1 < RC / PB) RW_LOAD_BLK((n + 1) * PB);
        WAVE_SYNC();
#pragma unroll 1
        for (int u = 0; u < PB; ++u) {
            const LAS float* o_ = shw + (hf * PB + u) * SLOT;
            const float vv = KIND ? o_[320 + lane] : 0.f;
            float sa0 = 0.f, sa1 = 0.f;
            _Pragma("unroll") for (int j = 0; j < 64; j += 2) { sa0 += st[j] * o_[128 + j]; sa1 += st[j + 1] * o_[129 + j]; }
            const float sa = -(sa0 + sa1);
            float y0 = 0.f, y1 = 0.f;
            _Pragma("unroll") for (int j = 0; j < 64; j += 2) {
                _Pragma("unroll") for (int q = 0; q < 2; ++q) { float v = st[j + q] * o_[256 + j + q] + sa * o_[192 + j + q]; if (KIND) v += vv * o_[64 + j + q]; st[j + q] = v; }
                y0 += st[j] * o_[j]; y1 += st[j + 1] * o_[j + 1]; }
            yo[(n * PB + u) * 64] = f2bf(y0 + y1);
        }
        if (n + 1 < RC / PB) RW_WRITE_BLK(hf ^ 1);
    }
#undef RW_LOAD_BLK
#undef RW_WRITE_BLK
    WAVE_SYNC();
    if (KIND == 0) { bf16_t* po = OutT + (size_t)cid * 4096 + lane;
        _Pragma("unroll") for (int j = 0; j < 64; ++j) po[j * 64] = f2bf(st[j]); }
    else { unsigned* lo = (unsigned*)(OutT + (size_t)cid * 4096 + lane * 64);
        _Pragma("unroll") for (int j = 0; j < 64; j += 2) lo[j >> 1] = rw_cvtpk(st[j], st[j + 1]); }
}
__device__ __forceinline__ void ph_rw_chunk(LAS unsigned char* lds, const bf16_t* R, const bf16_t* K1, const bf16_t* V1, const bf16_t* KK, const bf16_t* BB, const float* DEC,
                                            bf16_t* PcT, bf16_t* LcB, bf16_t* QcT, bf16_t* YlT) {
    const int lane = threadIdx.x & 63, wid = threadIdx.x >> 6;
    LAS float* shw = (LAS float*)(lds + wid * 12288);
    const int gw = blockIdx.x * 8 + wid, NGW = gridDim.x * 8;
    for (int task = gw; task < NCHUNK * 2; task += NGW) {
        const int cid = task >> 1;
        if (task & 1) rw_chunk_task<1>(shw, cid, lane, R, K1, V1, KK, BB, DEC, LcB, YlT);
        else rw_chunk_task<0>(shw, cid, lane, R, K1, V1, KK, BB, DEC, PcT, QcT);
    }
}

namespace ch {
typedef short bf16x8 __attribute__((ext_vector_type(8)));
typedef short s16x4 __attribute__((ext_vector_type(4)));
typedef float f32x16 __attribute__((ext_vector_type(16)));
typedef unsigned u32x2 __attribute__((ext_vector_type(2)));
constexpr int P = 72, MBY = 64 * P * 2;
constexpr int O_AB = 0 * MBY, O_RB = 1 * MBY, O_BB = 2 * MBY, O_KB = 3 * MBY, O_BT = 4 * MBY, O_KT = 5 * MBY, O_VT = 6 * MBY, O_PA = 7 * MBY, O_PB = 8 * MBY, O_TA = 9 * MBY, O_TB = 10 * MBY,
              O_MAK = 11 * MBY, O_MBR = 12 * MBY, O_W1 = O_BB, O_A2 = O_KB, O_GC = O_PA, O_HC = O_PB, O_SCR = 13 * MBY  , O_GCV = O_SCR + 4096  ;
static_assert(O_GCV + 256 <= 131072, "chunk phase LDS");
__device__ __forceinline__ int crow(int r, int hi) { return (r & 3) + 8 * (r >> 2) + 4 * hi; }
__device__ __forceinline__ unsigned cvtpk(float lo, float hi) { typedef float f2 __attribute__((ext_vector_type(2))); typedef __bf16 b2 __attribute__((ext_vector_type(2))); f2 v = {lo, hi}; b2 b = __builtin_convertvector(v, b2); return __builtin_bit_cast(unsigned, b); }
__device__ __forceinline__ bf16x8 frag_kc(const LAS unsigned char* M, int i0, int k0, int l31, int hi) { return *(const LAS bf16x8*)(M + ((i0 + l31) * P + k0 + 8 * hi) * 2); }
typedef short v4i16_t __attribute__((ext_vector_type(4)));
__device__ __forceinline__ bf16x8 frag_ks(const LAS unsigned char* M, int i0, int k0, int lane) {
    const LAS unsigned char* a = M + ((k0 + 8 * (lane >> 5) + ((lane >> 2) & 3)) * P + i0 + 16 * ((lane >> 4) & 1) + 4 * (lane & 3)) * 2;
    const s16x4 lo = __builtin_bit_cast(s16x4, __builtin_amdgcn_ds_read_tr16_b64_v4i16((LAS v4i16_t*)a));
    const s16x4 h4 = __builtin_bit_cast(s16x4, __builtin_amdgcn_ds_read_tr16_b64_v4i16((LAS v4i16_t*)(a + 4 * P * 2)));
    return (bf16x8){lo[0], lo[1], lo[2], lo[3], h4[0], h4[1], h4[2], h4[3]};
}
#define CH_MFMA(a, b, c) __builtin_amdgcn_mfma_f32_32x32x16_bf16((a), (b), (c), 0, 0, 0)
#define CH_PROD4(acc, FA, FB) do { bf16x8 fa_[4], fb_[4]; \
        _Pragma("unroll") for (int ks = 0; ks < 4; ++ks) { fa_[ks] = FA; fb_[ks] = FB; } \
        __builtin_amdgcn_sched_barrier(0); \
        _Pragma("unroll") for (int ks = 0; ks < 4; ++ks) acc = CH_MFMA(fa_[ks], fb_[ks], acc); } while (0)
#define CH_PROD2(acc, FA, FB, K0) do { bf16x8 fa_[2], fb_[2]; \
        _Pragma("unroll") for (int kq = 0; kq < 2; ++kq) { const int ks = (K0) + kq; fa_[kq] = FA; fb_[kq] = FB; } \
        __builtin_amdgcn_sched_barrier(0); \
        _Pragma("unroll") for (int kq = 0; kq < 2; ++kq) acc = CH_MFMA(fa_[kq], fb_[kq], acc); } while (0)
__device__ __forceinline__ float red32(float x) {
    x += __int_as_float(__builtin_amdgcn_update_dpp(0, __float_as_int(x), 0xB1, 0xF, 0xF, true));
    x += __int_as_float(__builtin_amdgcn_update_dpp(0, __float_as_int(x), 0x4E, 0xF, 0xF, true));
    x += __int_as_float(__builtin_amdgcn_update_dpp(0, __float_as_int(x), 0x141, 0xF, 0xF, true));
    x += __int_as_float(__builtin_amdgcn_update_dpp(0, __float_as_int(x), 0x140, 0xF, 0xF, true));
    x += __int_as_float(__builtin_amdgcn_ds_swizzle(__float_as_int(x), 0x401F));
    return x;
}
__device__ __forceinline__ void st_lds(LAS unsigned char* ZT, const f32x16& a, int wr, int wc, int l31, int hi) {
#pragma unroll
    for (int g = 0; g < 4; ++g) { u32x2 w; w.x = cvtpk(a[4 * g], a[4 * g + 1]); w.y = cvtpk(a[4 * g + 2], a[4 * g + 3]); *(LAS u32x2*)(ZT + ((32 * wc + l31) * P + 32 * wr + 8 * g + 4 * hi) * 2) = w; }
}
__device__ __forceinline__ void st_glb(bf16_t* G, const f32x16& a, int wr, int wc, int l31, int hi) {
    typedef unsigned u32x4g __attribute__((ext_vector_type(4)));
#pragma unroll
    for (int gp = 0; gp < 2; ++gp) { const unsigned a0 = cvtpk(a[8 * gp], a[8 * gp + 1]), a1 = cvtpk(a[8 * gp + 2], a[8 * gp + 3]), b0 = cvtpk(a[8 * gp + 4], a[8 * gp + 5]), b1 = cvtpk(a[8 * gp + 6], a[8 * gp + 7]);
        auto s0 = __builtin_amdgcn_permlane32_swap(a0, b0, false, false); auto s1 = __builtin_amdgcn_permlane32_swap(a1, b1, false, false);
        u32x4g w = {s0[0], s1[0], s0[1], s1[1]};
        *(u32x4g*)(G + (32 * wc + l31) * 64 + 32 * wr + 8 * (2 * gp + hi)) = w; }
}
__device__ __forceinline__ void mask_tile(f32x16& a, int wr, int wc, int l31, int hi, bool inclusive) {
    const int col = 32 * wc + l31;
#pragma unroll
    for (int r = 0; r < 16; ++r) { const int row = 32 * wr + crow(r, hi); const bool keep = inclusive ? (row <= col) : (row < col); if (!keep) a[r] = 0.f; }
}
struct In { const bf16_t *PROJ, *WA; const float *mu, *w0, *a0, *k_k, *k_a, *r_k; float* BON; bf16_t* V1S; };
struct Pre { unsigned kp[5], rr[5], vv[5], wp[4], ap[4]; };
__device__ __forceinline__ void load_pre(Pre& q, const In& in, int cid, int tid) {
    const int bh = cid / NCH, c = cid % NCH, b = bh / RH, h = bh % RH, kp = tid & 31, tg = tid >> 5;
    const size_t row = (size_t)b * S + (size_t)c * RC + 4 * tg; const int ch = h * 64 + 2 * kp;
    const bool seq_start = (c == 0 && tg == 0);
#pragma unroll
    for (int u = 0; u < 5; ++u) { const size_t a0 = (row + u - ((u == 0 && seq_start) ? 0 : 1)) * PW + MLA_IN + ch;
        q.rr[u] = *(const unsigned*)(in.PROJ + a0); q.kp[u] = *(const unsigned*)(in.PROJ + a0 + 512); q.vv[u] = *(const unsigned*)(in.PROJ + a0 + 1024); }
    if (seq_start) { q.rr[0] = 0u; q.kp[0] = 0u; q.vv[0] = 0u; }
#pragma unroll
    for (int u = 0; u < 4; ++u) { const size_t a1 = (row + u) * 1024 + ch; q.wp[u] = *(const unsigned*)(in.WA + a1); q.ap[u] = *(const unsigned*)(in.WA + a1 + 512); }
}
__device__ __forceinline__ float lo16(unsigned w) { return __uint_as_float(w << 16); }
__device__ __forceinline__ float hi16(unsigned w) { return __uint_as_float(w & 0xffff0000u); }

__device__ __forceinline__ void phase(LAS unsigned char* lds, const In in, bf16_t* PcTa, bf16_t* PcTb  , bf16_t* LcB, bf16_t* QcT, bf16_t* YlT) {
    const int tid = otid(), lane = tid & 63, wid = __builtin_amdgcn_readfirstlane(tid >> 6), l31 = lane & 31, hi = lane >> 5;
    const int grp = wid >> 2, tp = wid & 3, wr = tp >> 1, wc = tp & 1, kpr = tid & 31, tg = tid >> 5;
    typedef float f32x2v __attribute__((ext_vector_type(2)));
    LAS float* scr = (LAS float*)(lds + O_SCR); LAS float* gcv = (LAS float*)(lds + O_GCV);
    const int xl = blockIdx.x & 7, rr = blockIdx.x >> 3, NPB = NCHUNK / (int)gridDim.x;
    auto cid_of = [&](int i) { const int m = i * 32 + rr; return (xl + 8 * (m & 3)) * NCH + (NCH - 1 - (m >> 2)); };
    if (gridDim.x != 256) return;
    const int tri = (wr == wc) ? (wr ? 2 : 1) : (wr < wc ? 0 : 3);
    if (grp == 0 && tri == 3) { f32x16 z = f32x16{}; st_lds(lds + O_TB, z, wr, wc, l31, hi); }
    int it = 0; int cid = cid_of(0);
    Pre pq; load_pre(pq, in, cid, tid);
    float ckk0, ckk1, cka0, cka1, crk0, crk1, ca00, ca01, cw00, cw01, mr0, mr1, mk0, mk1, mv0, mv1;
    float nkk0[4], nkk1[4], nbb0[4], nbb1[4], nkq0[4], nkq1[4], nld0[4], nld1[4], nrs0[4], nrs1[4]; unsigned nvsh[4];
    auto ld_consts = [&](int dcid) { const int hc_ = ((dcid / NCH) % RH) * 64 + 2 * kpr;
          const f32x2v c0_ = *(const f32x2v*)(in.k_k + hc_), c1_ = *(const f32x2v*)(in.k_a + hc_), c2_ = *(const f32x2v*)(in.r_k + hc_), c3_ = *(const f32x2v*)(in.a0 + hc_), c4_ = *(const f32x2v*)(in.w0 + hc_);
          const f32x2v m0_ = *(const f32x2v*)(in.mu + hc_), m1_ = *(const f32x2v*)(in.mu + 512 + hc_), m2_ = *(const f32x2v*)(in.mu + 1024 + hc_);
          ckk0 = c0_.x; ckk1 = c0_.y; cka0 = c1_.x; cka1 = c1_.y; crk0 = c2_.x; crk1 = c2_.y; ca00 = c3_.x; ca01 = c3_.y; cw00 = c4_.x; cw01 = c4_.y;
          mr0 = m0_.x; mr1 = m0_.y; mk0 = m1_.x; mk1 = m1_.y; mv0 = m2_.x; mv1 = m2_.y; };
    auto derive = [&](const int u, int dcid) {
            const int bh_ = dcid / NCH, cc_ = dcid % NCH, b_ = bh_ / RH, h_ = bh_ % RH;
            float k0 = lo16(pq.kp[u + 1]), k1 = hi16(pq.kp[u + 1]); k0 += (lo16(pq.kp[u]) - k0) * mk0; k1 += (hi16(pq.kp[u]) - k1) * mk1;
            float r0_ = lo16(pq.rr[u + 1]), r1_ = hi16(pq.rr[u + 1]); r0_ += (lo16(pq.rr[u]) - r0_) * mr0; r1_ += (hi16(pq.rr[u]) - r1_) * mr1; nrs0[u] = r0_; nrs1[u] = r1_;
            float v0_ = lo16(pq.vv[u + 1]), v1_ = hi16(pq.vv[u + 1]); v0_ += (lo16(pq.vv[u]) - v0_) * mv0; v1_ += (hi16(pq.vv[u]) - v1_) * mv1; nvsh[u] = cvtpk(v0_, v1_);
            *(unsigned*)(in.V1S + ((size_t)b_ * S + (size_t)cc_ * RC + 4 * tg + u) * 512 + h_ * 64 + 2 * kpr) = nvsh[u];
            const float q0 = k0 * ckk0, q1 = k1 * ckk1; float ss = q0 * q0 + q1 * q1;
            ss = red32(ss);
            const float inv = rsqrtf(ss + 1e-12f);
            const float a0v = __builtin_amdgcn_rcpf(1.f + __expf(-(ca00 + lo16(pq.ap[u])))), a1v = __builtin_amdgcn_rcpf(1.f + __expf(-(ca01 + hi16(pq.ap[u]))));
            const float w0v = -__logf(1.f + __expf(-(cw00 + lo16(pq.wp[u])))) - 0.5f, w1v = -__logf(1.f + __expf(-(cw01 + hi16(pq.wp[u])))) - 0.5f;
            nld0[u] = -__expf(w0v); nld1[u] = -__expf(w1v);
            nkk0[u] = q0 * inv; nkk1[u] = q1 * inv; nbb0[u] = nkk0[u] * a0v; nbb1[u] = nkk1[u] * a1v;
            nkq0[u] = k0 * (1.f + (a0v - 1.f) * cka0); nkq1[u] = k1 * (1.f + (a1v - 1.f) * cka1);
            float bon = nrs0[u] * nkq0[u] * crk0 + nrs1[u] * nkq1[u] * crk1;
            bon = red32(bon);
            if (kpr == 0) in.BON[((size_t)b_ * S + (size_t)cc_ * RC + 4 * tg + u) * RH + h_] = bon; };
    ld_consts(cid);
#pragma unroll
    for (int u = 0; u < 4; ++u) derive(u, cid);
    for (; it < NPB; ++it, cid = (it < NPB ? cid_of(it) : 0)) {
        float kk0[4], kk1[4], bb0[4], bb1[4], kq0[4], kq1[4], ld0[4], ld1[4], rs0[4], rs1[4]; unsigned vsh[4];
#pragma unroll
        for (int u = 0; u < 4; ++u) { kk0[u] = nkk0[u]; kk1[u] = nkk1[u]; bb0[u] = nbb0[u]; bb1[u] = nbb1[u]; kq0[u] = nkq0[u]; kq1[u] = nkq1[u]; ld0[u] = nld0[u]; ld1[u] = nld1[u]; rs0[u] = nrs0[u]; rs1[u] = nrs1[u]; vsh[u] = nvsh[u]; }
        float cl0[4], cl1[4]; { float a0 = 0.f, a1 = 0.f;
#pragma unroll
            for (int u = 0; u < 4; ++u) { a0 += ld0[u]; a1 += ld1[u]; cl0[u] = a0; cl1[u] = a1; } }
        *(LAS f32x2v*)(scr + tg * 64 + 2 * kpr) = (f32x2v){cl0[3], cl1[3]};
        LDS_BARRIER();
        float off0 = 0.f, off1 = 0.f, tot0 = 0.f, tot1 = 0.f;
#pragma unroll
        for (int q = 0; q < 16; ++q) { const f32x2v v = *(const LAS f32x2v*)(scr + q * 64 + 2 * kpr); tot0 += v.x; tot1 += v.y; if (q < tg) { off0 += v.x; off1 += v.y; } }
        if (tg == 0) *(LAS f32x2v*)(gcv + 2 * kpr) = (f32x2v){__expf(tot0), __expf(tot1)};
#pragma unroll
        for (int u = 0; u < 4; ++u) {
            const int t = 4 * tg + u; const float ci0 = off0 + cl0[u], ci1 = off1 + cl1[u];
            const float ex0 = __expf(ci0 - ld0[u]), ei0 = __expf(ci0), en0 = __expf(-ci0), et0 = __expf(tot0 - ci0);
            const float ex1 = __expf(ci1 - ld1[u]), ei1 = __expf(ci1), en1 = __expf(-ci1), et1 = __expf(tot1 - ci1);
            const int o = (t * P + 2 * kpr) * 2;
            *(LAS unsigned*)(lds + O_AB + o) = cvtpk(-kk0[u] * ex0, -kk1[u] * ex1); *(LAS unsigned*)(lds + O_RB + o) = cvtpk(rs0[u] * ei0, rs1[u] * ei1);
            *(LAS unsigned*)(lds + O_BB + o) = cvtpk(bb0[u] * en0, bb1[u] * en1); *(LAS unsigned*)(lds + O_KB + o) = cvtpk(kq0[u] * en0, kq1[u] * en1);
            *(LAS unsigned*)(lds + O_BT + o) = cvtpk(bb0[u] * et0, bb1[u] * et1); *(LAS unsigned*)(lds + O_KT + o) = cvtpk(kq0[u] * et0, kq1[u] * et1);
            *(LAS unsigned*)(lds + O_VT + o) = vsh[u];
        }
        const int cur = cid;
        const bool more = it + 1 < NPB; const int ncid = more ? cid_of(it + 1) : 0;
        if (more) { load_pre(pq, in, ncid, tid); if (((ncid / NCH) % RH) != ((cur / NCH) % RH)) ld_consts(ncid); }
        LDS_BARRIER();
        const size_t cb = (size_t)cur * 4096;
        int l31o = l31, hio = hi; asm volatile("" : "+v"(l31o), "+v"(hio));
        f32x16 keep;
        { f32x16 a0 = f32x16{}, a1 = f32x16{};
          const LAS unsigned char* Am = lds + (grp == 0 ? O_BB : O_KB);
          bf16x8 af[4], b0[4], b1[4];
#pragma unroll
          for (int ks = 0; ks < 4; ++ks) { af[ks] = frag_kc(Am, 32 * wr, 16 * ks, l31, hi); b0[ks] = frag_kc(lds + O_AB, 32 * wc, 16 * ks, l31, hi); b1[ks] = frag_kc(lds + O_RB, 32 * wc, 16 * ks, l31, hi); }
          __builtin_amdgcn_sched_barrier(0);
#pragma unroll
          for (int ks = 0; ks < 4; ++ks) { a0 = CH_MFMA(af[ks], b0[ks], a0); a1 = CH_MFMA(af[ks], b1[ks], a1); }
          if (tri == 3) { a0 = f32x16{}; a1 = f32x16{}; }
          else if (tri != 0) { mask_tile(a0, wr, wc, l31o, hio, false); mask_tile(a1, wr, wc, l31o, hio, true); }
          if (grp == 0) { st_lds(lds + O_PA, a0, wr, wc, l31, hi); st_lds(lds + O_MBR, a1, wr, wc, l31, hi);
              keep = a0;
#pragma unroll
              for (int r = 0; r < 16; ++r) if (wr == wc && crow(r, hio) == l31o) keep[r] += 1.f;
              st_lds(lds + O_TA, keep, wr, wc, l31, hi); }
          else { st_lds(lds + O_MAK, a0, wr, wc, l31, hi); keep = a1; } }
        LDS_BARRIER();
#pragma unroll
        for (int st = 0; st < 6; ++st) {
            const LAS unsigned char* Pc_ = lds + ((st & 1) ? O_PB : O_PA); LAS unsigned char* Pn_ = lds + ((st & 1) ? O_PA : O_PB);
            const LAS unsigned char* Tc_ = lds + ((st & 1) ? O_TA : O_TB); LAS unsigned char* Tn_ = lds + ((st & 1) ? O_TB : O_TA);
            if (grp == 0) { if (st >= 1 && tri != 3) {
                if (tri == 0) CH_PROD4(keep, frag_ks(Tc_, 32 * wr, 16 * ks, lane), frag_kc(Pc_, 32 * wc, 16 * ks, l31, hi));
                else if (tri == 1) CH_PROD2(keep, frag_ks(Tc_, 32 * wr, 16 * ks, lane), frag_kc(Pc_, 32 * wc, 16 * ks, l31, hi), 0);
                else CH_PROD2(keep, frag_ks(Tc_, 32 * wr, 16 * ks, lane), frag_kc(Pc_, 32 * wc, 16 * ks, l31, hi), 2);
                st_lds(Tn_, keep, wr, wc, l31, hi); } }
            else if (st < 5) { f32x16 a = f32x16{};
                if (tri == 0) CH_PROD4(a, frag_ks(Pc_, 32 * wr, 16 * ks, lane), frag_kc(Pc_, 32 * wc, 16 * ks, l31, hi));
                else if (tri == 1) CH_PROD2(a, frag_ks(Pc_, 32 * wr, 16 * ks, lane), frag_kc(Pc_, 32 * wc, 16 * ks, l31, hi), 0);
                else if (tri == 2) CH_PROD2(a, frag_ks(Pc_, 32 * wr, 16 * ks, lane), frag_kc(Pc_, 32 * wc, 16 * ks, l31, hi), 2);
                if (tri != 3 || st == 0) st_lds(Pn_, a, wr, wc, l31, hi); }
            if (st >= 2 && more) derive(st - 2, ncid);
            LDS_BARRIER();
        }
        const LAS unsigned char* TmT = lds + O_TB;
        { f32x16 a = f32x16{}; const LAS unsigned char* Am = lds + (grp == 0 ? O_MAK : O_AB);
          if (wc == 0) CH_PROD2(a, frag_ks(Am, 32 * wr, 16 * ks, lane), frag_kc(TmT, 32 * wc, 16 * ks, l31, hi), 0);
          else CH_PROD4(a, frag_ks(Am, 32 * wr, 16 * ks, lane), frag_kc(TmT, 32 * wc, 16 * ks, l31, hi));
          st_lds(lds + (grp == 0 ? O_W1 : O_A2), a, wr, wc, l31, hi); }
        LDS_BARRIER();
        { f32x16 a0, a1;
          if (grp == 1) { a0 = keep; a1 = f32x16{}; }
          else { a1 = f32x16{};
#pragma unroll
              for (int g = 0; g < 4; ++g) { const u32x2 w = *(const LAS u32x2*)(lds + O_RB + ((32 * wc + l31) * P + 32 * wr + 8 * g + 4 * hi) * 2);
                  a0[4 * g] = lo16(w.x); a0[4 * g + 1] = hi16(w.x); a0[4 * g + 2] = lo16(w.y); a0[4 * g + 3] = hi16(w.y); }
              const float gc = gcv[32 * wc + l31];
#pragma unroll
              for (int r = 0; r < 16; ++r) if (wr == wc && crow(r, hio) == l31o) a1[r] = gc; }
          const LAS unsigned char* Am = lds + (grp == 1 ? O_W1 : O_A2);
          { bf16x8 af[4], b0[4], b1[4], kt[2];
#pragma unroll
            for (int ks = 0; ks < 4; ++ks) { af[ks] = frag_ks(Am, 32 * wr, 16 * ks, lane); b0[ks] = frag_kc(lds + O_MBR, 32 * wc, 16 * ks, l31, hi); b1[ks] = frag_ks(lds + O_BT, 32 * wc, 16 * ks, lane); }
            if (grp == 1) { kt[0] = frag_ks(lds + O_KT, 32 * wc, 32 * wr, lane); kt[1] = frag_ks(lds + O_KT, 32 * wc, 32 * wr + 16, lane); }
            __builtin_amdgcn_sched_barrier(0);
#pragma unroll
            for (int ks = 0; ks < 4; ++ks) { a0 = CH_MFMA(af[ks], b0[ks], a0); a1 = CH_MFMA(af[ks], b1[ks], a1); }
            if (grp == 1) {
#pragma unroll
                for (int i = 0; i < 2; ++i) { bf16x8 idf;
#pragma unroll
                    for (int j = 0; j < 8; ++j) idf[j] = (16 * i + 8 * hio + j == l31o) ? (short)0x3F80 : (short)0;
                    a1 = CH_MFMA(idf, kt[i], a1); } } }
          if (grp == 1) {
              st_lds(lds + O_GC, a0, wr, wc, l31, hi); st_lds(lds + O_HC, a1, wr, wc, l31, hi); }
          else { st_glb(QcT + cb, a0, wr, wc, l31, hi); st_glb(cur < NCHUNK / 2 ? PcTa + cb : PcTb + (cb - (size_t)(NCHUNK / 2) * 4096), a1, wr, wc, l31, hi); } }
        LDS_BARRIER();
        { f32x16 a = f32x16{};
          if (grp == 0) {
              CH_PROD4(a, frag_ks(lds + O_VT, 32 * wr, 16 * ks, lane), frag_kc(lds + O_GC, 32 * wc, 16 * ks, l31, hi));
              st_glb(YlT + cb, a, wr, wc, l31, hi); }
          else {
              CH_PROD4(a, frag_kc(lds + O_HC, 32 * wr, 16 * ks, l31, hi), frag_ks(lds + O_VT, 32 * wc, 16 * ks, lane));
              st_glb(LcB + cb, a, wr, wc, l31, hi); } }
        LDS_BARRIER();
    }
}
#undef CH_MFMA
#undef CH_PROD4
#undef CH_PROD2
}

constexpr int SQ_DEPTH = 8, SQ_NSLOT = SQ_DEPTH + 2, SQ_SLOT = 12288;
__device__ __forceinline__ void rw_glds16(const void* gsrc, unsigned lds_dst) { unsigned keep;
    asm volatile("s_mov_b32 %0, m0\n\ts_mov_b32 m0, %2\n\ts_nop 0\n\tglobal_load_lds_dwordx4 %1, off\n\ts_mov_b32 m0, %0" : "=&s"(keep) : "v"(gsrc), "s"(lds_dst) : "memory"); }
__device__ __forceinline__ void ph_rw_seq(LAS unsigned char* lds, const bf16_t* PcTa, const bf16_t* PcTb, const bf16_t* LcB, bf16_t* SC) {
    const bf16_t* PcT = (blockIdx.x & 7) + 8 * ((blockIdx.x >> 3) >> 1) < NB * RH / 2 ? PcTa : PcTb - (size_t)(NCHUNK / 2) * 4096;
    const int otid_ = otid();
    if (blockIdx.x >= NB * RH * 2) return;
    const int lane = otid_ & 63, wid = __builtin_amdgcn_readfirstlane(otid_ >> 6), l31 = lane & 31, hi = lane >> 5;
    const int xl_ = blockIdx.x & 7, j_ = blockIdx.x >> 3, bh = xl_ + 8 * (j_ >> 1), vh = j_ & 1, v = 32 * vh + l31;
    typedef unsigned rw_u32x2 __attribute__((ext_vector_type(2)));
    typedef unsigned rw_u32x4 __attribute__((ext_vector_type(4)));
    const unsigned lds0 = (unsigned)(uintptr_t)lds;
#define SQ_PIECE(c_, p_) do { const size_t cb_ = ((size_t)bh * NCH + (c_)) * 4096; const unsigned sl_ = lds0 + (unsigned)((c_) % SQ_NSLOT) * SQ_SLOT; \
        const bf16_t* src_ = ((p_) < 8) ? (PcT + cb_ + (p_) * 512 + lane * 8) : (LcB + cb_ + (size_t)(32 * vh) * 64 + ((p_) - 8) * 512 + lane * 8); \
        rw_glds16(src_, (unsigned)__builtin_amdgcn_readfirstlane(sl_ + (p_) * 1024)); } while (0)
#define SQ_ISSUE(c_) do { SQ_PIECE(c_, wid); if (wid < 4) SQ_PIECE(c_, wid + 8); } while (0)
    rw_f32x16 acc[2]; acc[0] = rw_f32x16{}; acc[1] = rw_f32x16{};
#pragma unroll
    for (int c = 0; c < SQ_DEPTH; ++c) SQ_ISSUE(c);
    for (int c = 0; c < NCH - 1; ++c) {
        if (c + SQ_DEPTH < NCH) {
            SQ_ISSUE(c + SQ_DEPTH);
            if (wid < 4) asm volatile("s_waitcnt vmcnt(%0)" :: "i"(SQ_DEPTH * 2) : "memory"); else asm volatile("s_waitcnt vmcnt(%0)" :: "i"(SQ_DEPTH) : "memory");
        } else asm volatile("s_waitcnt vmcnt(0)" ::: "memory");
        asm volatile("s_waitcnt lgkmcnt(0)\n\ts_barrier" ::: "memory");
        if (wid == 0) {
            const size_t cb = ((size_t)bh * NCH + c) * 4096;
            const LAS unsigned char* sl = lds + (c % SQ_NSLOT) * SQ_SLOT;
            rw_u32x2 lw[2][4], af[2][2][2][2];
            _Pragma("unroll") for (int wr = 0; wr < 2; ++wr) { const LAS unsigned char* prow = sl + (32 * wr + l31) * 128;
                _Pragma("unroll") for (int t = 0; t < 2; ++t) _Pragma("unroll") for (int sx = 0; sx < 2; ++sx) {
                    af[wr][t][sx][0] = *(const LAS rw_u32x2*)(prow + (32 * t + 16 * sx + 4 * hi) * 2); af[wr][t][sx][1] = *(const LAS rw_u32x2*)(prow + (32 * t + 16 * sx + 8 + 4 * hi) * 2); } }
            _Pragma("unroll") for (int wr = 0; wr < 2; ++wr) _Pragma("unroll") for (int g = 0; g < 4; ++g) lw[wr][g] = *(const LAS rw_u32x2*)(sl + 8192 + l31 * 128 + (32 * wr + 8 * g + 4 * hi) * 2);
            __builtin_amdgcn_sched_barrier(0);
            rw_bf16x8 bfr[2][2];
            _Pragma("unroll") for (int t = 0; t < 2; ++t) _Pragma("unroll") for (int sx = 0; sx < 2; ++sx) {
                rw_u32x4 pk = {rw_cvtpk(acc[t][8 * sx], acc[t][8 * sx + 1]), rw_cvtpk(acc[t][8 * sx + 2], acc[t][8 * sx + 3]), rw_cvtpk(acc[t][8 * sx + 4], acc[t][8 * sx + 5]), rw_cvtpk(acc[t][8 * sx + 6], acc[t][8 * sx + 7])};
                bfr[t][sx] = __builtin_bit_cast(rw_bf16x8, pk);
                *(rw_u32x2*)(SC + cb + v * 64 + 32 * t + 16 * sx + 4 * hi) = (rw_u32x2){pk.x, pk.y}; *(rw_u32x2*)(SC + cb + v * 64 + 32 * t + 16 * sx + 8 + 4 * hi) = (rw_u32x2){pk.z, pk.w}; }
            rw_f32x16 nacc[2];
            _Pragma("unroll") for (int wr = 0; wr < 2; ++wr) {
                _Pragma("unroll") for (int g = 0; g < 4; ++g) { const rw_u32x2 w = lw[wr][g];
                    nacc[wr][4 * g] = __uint_as_float(w.x << 16); nacc[wr][4 * g + 1] = __uint_as_float(w.x & 0xffff0000u); nacc[wr][4 * g + 2] = __uint_as_float(w.y << 16); nacc[wr][4 * g + 3] = __uint_as_float(w.y & 0xffff0000u); }
                _Pragma("unroll") for (int t = 0; t < 2; ++t) _Pragma("unroll") for (int sx = 0; sx < 2; ++sx) {
                    const rw_u32x2 a0 = af[wr][t][sx][0], a1 = af[wr][t][sx][1];
                    rw_u32x4 pk = {a0.x, a0.y, a1.x, a1.y};
                    nacc[wr] = __builtin_amdgcn_mfma_f32_32x32x16_bf16(__builtin_bit_cast(rw_bf16x8, pk), bfr[t][sx], nacc[wr], 0, 0, 0); }
            }
            acc[0] = nacc[0]; acc[1] = nacc[1];
        }
    }
    if (wid == 0) {
        const size_t cb = ((size_t)bh * NCH + (NCH - 1)) * 4096;
        _Pragma("unroll") for (int t = 0; t < 2; ++t) _Pragma("unroll") for (int g = 0; g < 4; ++g) {
            rw_u32x2 w; w.x = rw_cvtpk(acc[t][4 * g], acc[t][4 * g + 1]); w.y = rw_cvtpk(acc[t][4 * g + 2], acc[t][4 * g + 3]);
            *(rw_u32x2*)(SC + cb + v * 64 + 32 * t + 8 * g + 4 * hi) = w; }
    }
    LDS_BARRIER();
#undef SQ_PIECE
#undef SQ_ISSUE
}

__device__ __forceinline__ void ph_rw_out(const bf16_t* SC, const bf16_t* QcT, const bf16_t* YlT, const bf16_t* V1, const bf16_t* LOUT, const float* BON,
                                          const float* lnx_g, const float* lnx_b, bf16_t* MIX, const float* SSQ, float* RSTD) {
    const int otid_ = otid();
    const int lane = otid_ & 63, l31 = lane & 31, hi = lane >> 5;
    const int gw = blockIdx.x * 8 + (otid_ >> 6), NGW = gridDim.x * 8;
    typedef unsigned rw_u32x2 __attribute__((ext_vector_type(2)));
    f32x4 lgr[2][4], lbr[2][4]; int hc = -1;
    for (int task = gw; task < NCHUNK * 2; task += NGW) {
        const int cid = task >> 1, th = task & 1, bh = cid / NCH, c = cid % NCH, b = bh / RH, h = bh % RH;
        const size_t cb = (size_t)cid * 4096;
        const int tl = 32 * th + l31;
        const size_t trow = (size_t)b * S + (size_t)c * RC + tl;
        rw_f32x16 acc[2];
        _Pragma("unroll") for (int u = 0; u < 2; ++u) _Pragma("unroll") for (int g = 0; g < 4; ++g) { const rw_u32x2 w = *(const rw_u32x2*)(YlT + cb + tl * 64 + 32 * u + 8 * g + 4 * hi);
            acc[u][4 * g] = __uint_as_float(w.x << 16); acc[u][4 * g + 1] = __uint_as_float(w.x & 0xffff0000u); acc[u][4 * g + 2] = __uint_as_float(w.y << 16); acc[u][4 * g + 3] = __uint_as_float(w.y & 0xffff0000u); }
        rw_bf16x8 bq[4], as[2][4];
        _Pragma("unroll") for (int ks = 0; ks < 4; ++ks) { bq[ks] = *(const rw_bf16x8*)(QcT + cb + tl * 64 + 16 * ks + 8 * hi);
            _Pragma("unroll") for (int u = 0; u < 2; ++u) as[u][ks] = *(const rw_bf16x8*)(SC + cb + (32 * u + l31) * 64 + 16 * ks + 8 * hi); }
        rw_u32x2 vvr[2][4], ggr[2][4];
        _Pragma("unroll") for (int u = 0; u < 2; ++u) _Pragma("unroll") for (int g = 0; g < 4; ++g) { const int c0 = h * 64 + 32 * u + 8 * g + 4 * hi;
            vvr[u][g] = *(const rw_u32x2*)(V1 + trow * 512 + c0); ggr[u][g] = *(const rw_u32x2*)(LOUT + trow * 512 + c0); }
        const float bon = BON[trow * RH + h];
        const f32x4 sq0 = *(const f32x4*)(SSQ + trow * 8), sq1 = *(const f32x4*)(SSQ + trow * 8 + 4);
        if (h != hc) { hc = h;
            _Pragma("unroll") for (int u = 0; u < 2; ++u) _Pragma("unroll") for (int g = 0; g < 4; ++g) { const int c0 = h * 64 + 32 * u + 8 * g + 4 * hi;
                lgr[u][g] = *(const f32x4*)(lnx_g + c0); lbr[u][g] = *(const f32x4*)(lnx_b + c0); } }
        __builtin_amdgcn_sched_barrier(0);
        _Pragma("unroll") for (int ks = 0; ks < 4; ++ks)
            _Pragma("unroll") for (int u = 0; u < 2; ++u) acc[u] = __builtin_amdgcn_mfma_f32_32x32x16_bf16(as[u][ks], bq[ks], acc[u], 0, 0, 0);
        float sm = 0.f;
        _Pragma("unroll") for (int u = 0; u < 2; ++u) _Pragma("unroll") for (int r = 0; r < 16; ++r) sm += acc[u][r];
        { auto rr = __builtin_amdgcn_permlane32_swap(__float_as_uint(sm), __float_as_uint(sm), false, false); sm = __uint_as_float(rr[0]) + __uint_as_float(rr[1]); }
        const float mean = sm * (1.f / 64.f);
        float sq = 0.f;
        _Pragma("unroll") for (int u = 0; u < 2; ++u) _Pragma("unroll") for (int r = 0; r < 16; ++r) { const float dd = acc[u][r] - mean; sq += dd * dd; }
        { auto rr = __builtin_amdgcn_permlane32_swap(__float_as_uint(sq), __float_as_uint(sq), false, false); sq = __uint_as_float(rr[0]) + __uint_as_float(rr[1]); }
        const float rstd = rsqrtf(sq * (1.f / 64.f) + 64e-5f);
        const float msq = (((sq0.x + sq0.y) + (sq0.z + sq0.w)) + ((sq1.x + sq1.y) + (sq1.z + sq1.w))) * (1.f / 512.f) + 1e-6f;
        const float inv_rs = sqrtf(msq);
        if (h == 0 && hi == 0) RSTD[trow] = rsqrtf(msq);
        _Pragma("unroll") for (int u = 0; u < 2; ++u) _Pragma("unroll") for (int g = 0; g < 4; ++g) {
            const int v0 = 32 * u + 8 * g + 4 * hi, c0 = h * 64 + v0;
            const f32x4 lg = lgr[u][g], lb = lbr[u][g];
            const rw_u32x2 vv = vvr[u][g], gg = ggr[u][g];
            const float o0 = ((acc[u][4 * g] - mean) * rstd * lg.x + lb.x + bon * __uint_as_float(vv.x << 16)) * __uint_as_float(gg.x << 16) * inv_rs;
            const float o1 = ((acc[u][4 * g + 1] - mean) * rstd * lg.y + lb.y + bon * __uint_as_float(vv.x & 0xffff0000u)) * __uint_as_float(gg.x & 0xffff0000u) * inv_rs;
            const float o2 = ((acc[u][4 * g + 2] - mean) * rstd * lg.z + lb.z + bon * __uint_as_float(vv.y << 16)) * __uint_as_float(gg.y << 16) * inv_rs;
            const float o3 = ((acc[u][4 * g + 3] - mean) * rstd * lg.w + lb.w + bon * __uint_as_float(vv.y & 0xffff0000u)) * __uint_as_float(gg.y & 0xffff0000u) * inv_rs;
            rw_u32x2 w; w.x = rw_cvtpk(o0, o1); w.y = rw_cvtpk(o2, o3);
            *(rw_u32x2*)(MIX + trow * 1024 + 512 + c0) = w; }
    }
}

template <int COL0, int WIDTH>
__device__ __forceinline__ void ph_row_stats(LAS float* tab, const bf16_t* PROJ, const pg8::StaticOrder& so) {
    const int otid_ = otid();
    const int row = otid_ >> 1, hf = otid_ & 1;
    for (int i = 0; i < 2; ++i) { pg8::Unit u; if (!so.next(i, u)) break;
        const v4u* p = (const v4u*)(PROJ + (size_t)(u.pm * 256 + row) * PW + COL0 + (WIDTH / 2) * hf);
        float s = 0.f;
#pragma unroll
        for (int k = 0; k < WIDTH / 16; ++k) { const v4u w = p[k];
            const float a0 = __uint_as_float(w.x << 16), a1 = __uint_as_float(w.x & 0xffff0000u), a2 = __uint_as_float(w.y << 16), a3 = __uint_as_float(w.y & 0xffff0000u);
            const float a4 = __uint_as_float(w.z << 16), a5 = __uint_as_float(w.z & 0xffff0000u), a6 = __uint_as_float(w.w << 16), a7 = __uint_as_float(w.w & 0xffff0000u);
            s += ((a0 * a0 + a1 * a1) + (a2 * a2 + a3 * a3)) + ((a4 * a4 + a5 * a5) + (a6 * a6 + a7 * a7)); }
        s += __int_as_float(__builtin_amdgcn_update_dpp(0, __float_as_int(s), 0xB1, 0xF, 0xF, true));
        if (hf == 0) tab[256 * i + row] = rsqrtf(s * (1.f / WIDTH) + 1e-6f); }
    __syncthreads();
}

constexpr int N_PHASES = 13;
__global__ void __launch_bounds__(NTHR, 2) mk_fwd(Params p) {
    extern __shared__ __attribute__((aligned(16))) unsigned char lds_raw[];
    LAS unsigned char* lds = (LAS unsigned char*)lds_raw;
    volatile LAS unsigned* MISC = (volatile LAS unsigned*)(lds + 131072 + 320);
    { int u0 = threadIdx.x; asm volatile("" : "+v"(u0));
      for (int u = u0; u < (LDS_BYTES - 131072) / 4; u += NTHR) ((LAS unsigned*)(lds + 131072))[u] = 0u; }
    __syncthreads();
    unsigned* ctl = (unsigned*)(p.ws + WS_CTL);
    XcdBarrier bar; bar.bar = ctl + CW_BAR; bar.x = 0; bar.st = nullptr;
    if (!MK_PER_PHASE) bar = xcd_barrier_post(ctl + CW_BAR, MISC + 8);
#define GRID_BAR() do { if (!MK_PER_PHASE) xcd_barrier(bar); } while (0)
#define IN(k) (p.ph_lo <= (k) && (k) < p.ph_hi)
#define BOTH(k) (IN(k) && IN((k) + 1))
    unsigned char* ws = p.ws; unsigned char* ob = (unsigned char*)p.out;
    float* small = (float*)(ws + WS_SMALL);
    float* RSF = small + 3 * T; float* EW = small + 4 * T; int* EID = (int*)(small + 6 * T);
    int* POS = (int*)(small + 8 * T); float* ROWW = small + 10 * T; int* CNT = (int*)(small + 13 * T); int* TILE_E = (int*)(small + 13 * T + 8192);
    float* BON = small + 16 * T;
    bf16_t* PROJ = (bf16_t*)(ws + 4 * MiB);
    bf16_t* QcT = (bf16_t*)(ws + 148 * MiB); bf16_t* YlT = (bf16_t*)(ws + 180 * MiB);
    bf16_t* V1S = (bf16_t*)(ws + 212 * MiB);
    bf16_t* LIN = (bf16_t*)(ws + 244 * MiB);
    bf16_t* KN = (bf16_t*)(ws + 260 * MiB);
    bf16_t* PcTa = (bf16_t*)(ws + 244 * MiB); bf16_t* PcTb = (bf16_t*)(ws + 260 * MiB);
    bf16_t* WA = (bf16_t*)(ws + 292 * MiB);
    bf16_t* SC = (bf16_t*)(ws + 292 * MiB);
    bf16_t* GOUT = (bf16_t*)(ws + 356 * MiB);
    bf16_t* MIX = (bf16_t*)(ws + 388 * MiB);
    bf16_t* LcB = (bf16_t*)(ws + 452 * MiB);
    bf16_t* Wgu_t = (bf16_t*)(ws + 104 * MiB);
    bf16_t* Wd_t = (bf16_t*)(ws + 484 * MiB);
    bf16_t* W_o_t = (bf16_t*)(ws + 502 * MiB); bf16_t* W_uq_t = (bf16_t*)(ws + 504 * MiB); bf16_t* W_ukv_t = (bf16_t*)(ws + 504 * MiB + 512 * 1024); bf16_t* W_lora_t = (bf16_t*)(ws + 505 * MiB);
    float* SSQ = (float*)(ws + 500 * MiB); float* RSTD = (float*)(ws + 501 * MiB);
    float* WrT = (float*)(ws + 506 * MiB);
    bf16_t* XN = (bf16_t*)ob; bf16_t* W_in_t = (bf16_t*)(ob + 64 * MiB);
    bf16_t* Qb = (bf16_t*)ob; bf16_t* Kb = (bf16_t*)(ob + 48 * MiB); bf16_t* Vb = (bf16_t*)(ob + 96 * MiB);
    bf16_t* H2 = (bf16_t*)(ws + 36 * MiB);
    int* SRC = (int*)(ws + 100 * MiB); float* ROWRS = (float*)(ws + 101 * MiB);
    bf16_t* HID = (bf16_t*)(ws + 196 * MiB);
    bf16_t* YS = (bf16_t*)(ws + 232 * MiB);
    const int G = (int)gridDim.x, bx = (int)blockIdx.x;

    if (IN(0)) { ProW w{p.x, p.w_in, p.g_mix, p.w_o, p.w_uq, p.g_cq, p.w_uk, p.w_uv, p.g_ckv, p.rw_w2, p.rw_a2, p.rw_g2, p.w_group, p.w_expert, p.g_ffn, p.g_mla_out, XN, W_in_t, W_o_t, W_uq_t, W_ukv_t, W_lora_t, WrT};
        ph_prologue(lds, w); if (BOTH(0)) GRID_BAR(); }
    if (IN(1)) {
        pg8::Gemm g{XN, W_in_t, T, PW, D, D, D, nullptr}; pg8::StaticOrder So; So.init(T, PW, G, bx);
        pg8::EpiBf16<0> E{PROJ, PW, nullptr, 0, 0, 1.f};
        pg8::gemm_phase<pg8::EpiBf16<0>, pg8::StaticOrder, PG8_ALIGN, PG8_SP2, D, D, D>(lds, g, So, E);
        if (BOTH(1)) GRID_BAR(); }
    if (IN(2)) {
        { pg8::Gemm g{PROJ, W_uq_t, T, 768, QR, PW, QR, nullptr}; pg8::TagOrder So; So.so.init(T, 768, G, bx);
          LAS float* cq_rs = (LAS float*)(lds + 131072 + 4096);
          ph_row_stats<0, QR>(cq_rs, PROJ, So.so);
          pg8::EpiBf16RS E{Qb, 768, nullptr, 0, 0, 0, cq_rs};
          pg8::gemm_phase<pg8::EpiBf16RS, pg8::TagOrder, PG8_ALIGN, PG8_SP2, QR, PW, QR>(lds, g, So, E); }
        { pg8::Gemm g{PROJ + QR, W_ukv_t, T, 1024, KVR, PW, KVR, nullptr}; pg8::TagOrder So; So.so.init(T, 1024, G, bx);
          LAS float* ckv_rs = (LAS float*)(lds + 131072 + 4096);
          ph_row_stats<QR, KVR>(ckv_rs, PROJ, So.so);
          pg8::EpiBf16RS E{KN, 512, nullptr, 512, (size_t)(Vb - KN), 0, ckv_rs};
          pg8::gemm_phase<pg8::EpiBf16RS, pg8::TagOrder, PG8_ALIGN, PG8_SP2, KVR, PW, KVR>(lds, g, So, E); }
        ph_rw_prep1(PROJ, p.rw_mu, LIN);
        if (BOTH(2)) GRID_BAR(); }
    if (IN(3)) {
          ph_mla_prep(PROJ, Qb, KN, Kb, Vb, p.pos, p.g_qn, p.g_kn);
        { pg8::Gemm g{LIN, W_lora_t, T, 1536, 128, 256, 128, nullptr}; pg8::LoraOrder So; So.so.init(T, 1536, G, bx);
          pg8::EpiBf16RS E{WA, 1024, nullptr, 1024, (size_t)(GOUT - WA), 512};
          pg8::gemm_phase<pg8::EpiBf16RS, pg8::LoraOrder, PG8_ALIGN, PG8_SP2, 128, 256, 128>(lds, g, So, E); }
        if (BOTH(3)) GRID_BAR(); }
    if (IN(4)) {
        { ch::In cin{PROJ, WA, p.rw_mu, p.rw_w0, p.rw_a0, p.rw_k_k, p.rw_k_a, p.rw_r_k, BON, V1S}; ch::phase(lds, cin, PcTa, PcTb, LcB, QcT, YlT); }
        if (BOTH(4)) GRID_BAR(); }
    if (IN(5)) {
        if (bx < NB * RH * 2) ph_rw_seq(lds, PcTa, PcTb, LcB, SC);
        else if (bx < NB * RH * 2 + 16) { ph_moe_wgu_part(lds, p.g_ffn, p.w_gate, p.w_up, Wgu_t, NB * RH * 2, 16); LDS_BARRIER(); }
        att::phase((char*)lds_raw, (unsigned*)ctl + CW_ATTQ, Qb, Kb, Vb, MIX, SSQ, p.pos, p.g_qn);
        if (BOTH(5)) GRID_BAR(); }
    if (IN(6)) { ph_rw_out(SC, QcT, YlT, V1S, GOUT, BON, p.rw_lnx_g, p.rw_lnx_b, MIX, SSQ, RSTD);
        if (BOTH(6)) GRID_BAR(); }
    if (IN(7)) {
        pg8::Gemm g{MIX, W_o_t, T, D, D, D, D, nullptr}; pg8::StaticOrder So; So.init(T, D, G, bx);
        pg8::EpiF32Res E{p.x, nullptr, D, H2, RSTD};
        pg8::gemm_phase<pg8::EpiF32Res, pg8::StaticOrder, PG8_ALIGN, PG8_SP2, D, D, D>(lds, g, So, E);
        if (BOTH(7)) GRID_BAR(); }
    if (IN(8)) { ph_moe_route(lds, H2, p.g_ffn, WrT, p.b_group, p.b_expert, EID, EW, RSF, CNT); if (BOTH(8)) GRID_BAR(); }
    if (IN(9)) { ph_moe_scatter(lds, RSF, EID, EW, CNT, POS, ROWW, SRC, ROWRS, TILE_E); if (BOTH(9)) GRID_BAR(); }
    if (IN(10)) {
        const int ntiles = TILE_E[MOE_MAXT];
        pg8::Gemm g{H2, Wgu_t, 0, 0, D, D, D, SRC}; pg8::MoeOrder<2> So{TILE_E, ntiles * 2, G, bx};
        pg8::EpiSwiGLU E{HID, ROWW, ROWRS};
        pg8::gemm_phase<pg8::EpiSwiGLU, pg8::MoeOrder<2>, PG8_ALIGN, PG8_SP2, D, D, D, true>(lds, g, So, E);
        ph_moe_wd_part(lds, p.w_down, Wd_t, 64);
        if (BOTH(10)) GRID_BAR(); }
    if (IN(11)) {
        const int ntiles = TILE_E[MOE_MAXT];
        pg8::Gemm g{HID, Wd_t, 0, 0, DE, DE, DE, nullptr}; pg8::MoeOrder<4> So{TILE_E, ntiles * 4, G, bx};
        pg8::EpiBf16Mod<4> E{YS, D};
        pg8::gemm_phase<pg8::EpiBf16Mod<4>, pg8::MoeOrder<4>, PG8_ALIGN, PG8_SP2, DE, DE, DE>(lds, g, So, E);
        if (BOTH(11)) GRID_BAR(); }
    if (IN(12)) { ph_moe_combine(p.out, H2, YS, POS); }
}

extern "C" void kernel_launch(void* const* d_in, const int* in_sizes, int n_in, void* d_out, int out_size, void* d_ws, size_t ws_size, hipStream_t stream) {
    static int grid = 0;
    if (grid == 0) {
        if (n_in != 32 || out_size != T * D || ws_size < 512 * MiB) { fprintf(stderr, "kernel_launch: unexpected shapes (n_in %d out %d ws %zu)\n", n_in, out_size, ws_size); grid = -1; return; }
        int dev = 0, cus = 0, per_cu = 0;
        if (hipGetDevice(&dev) != hipSuccess || hipDeviceGetAttribute(&cus, hipDeviceAttributeMultiprocessorCount, dev) != hipSuccess) { grid = -1; return; }
        if (hipFuncSetAttribute((const void*)mk_fwd, hipFuncAttributeMaxDynamicSharedMemorySize, LDS_BYTES) != hipSuccess) { fprintf(stderr, "kernel_launch: hipFuncSetAttribute failed\n"); grid = -1; return; }
        if (hipOccupancyMaxActiveBlocksPerMultiprocessor(&per_cu, (const void*)mk_fwd, NTHR, LDS_BYTES) != hipSuccess || per_cu < 1) { fprintf(stderr, "kernel_launch: occupancy query says %d blocks/CU\n", per_cu); grid = -1; (void)hipGetLastError(); return; }
        grid = cus;
        if (T % grid != 0 || (T / grid) * 2 > NTHR) { fprintf(stderr, "kernel_launch: unsupported CU count %d\n", cus); grid = -1; return; }
    }
    if (grid < 0) return;
    (void)hipMemsetAsync((char*)d_ws + WS_CTL, 0, CTL_ZERO_BYTES, stream);
    Params p{};
    p.x = (const float*)d_in[0]; p.pos = (const int*)d_in[1];
    p.g_mix = (const float*)d_in[2]; p.w_in = (const float*)d_in[3]; p.g_cq = (const float*)d_in[4]; p.w_uq = (const float*)d_in[5];
    p.g_ckv = (const float*)d_in[6]; p.w_uk = (const float*)d_in[7]; p.w_uv = (const float*)d_in[8]; p.g_qn = (const float*)d_in[9];
    p.g_kn = (const float*)d_in[10]; p.g_mla_out = (const float*)d_in[11]; p.rw_mu = (const float*)d_in[12]; p.rw_w0 = (const float*)d_in[13];
    p.rw_w2 = (const float*)d_in[14]; p.rw_a0 = (const float*)d_in[15]; p.rw_a2 = (const float*)d_in[16]; p.rw_g2 = (const float*)d_in[17];
    p.rw_k_k = (const float*)d_in[18]; p.rw_k_a = (const float*)d_in[19]; p.rw_r_k = (const float*)d_in[20]; p.rw_lnx_g = (const float*)d_in[21];
    p.rw_lnx_b = (const float*)d_in[22]; p.w_o = (const float*)d_in[23]; p.g_ffn = (const float*)d_in[24]; p.w_group = (const float*)d_in[25];
    p.b_group = (const float*)d_in[26]; p.w_expert = (const float*)d_in[27]; p.b_expert = (const float*)d_in[28]; p.w_gate = (const float*)d_in[29];
    p.w_up = (const float*)d_in[30]; p.w_down = (const float*)d_in[31];
    p.out = (float*)d_out; p.ws = (unsigned char*)d_ws;
#if MK_PER_PHASE
    for (int k = 0; k < N_PHASES; ++k) { p.ph_lo = k; p.ph_hi = k + 1; hipLaunchKernelGGL(mk_fwd, dim3(grid), dim3(NTHR), LDS_BYTES, stream, p); }
#else
    p.ph_lo = 0; p.ph_hi = N_PHASES;
    hipLaunchKernelGGL(mk_fwd, dim3(grid), dim3(NTHR), LDS_BYTES, stream, p);
#endif
}
```
